# Optimizing an MI355X kernel written in HIP

```python
import math
import jax, jax.numpy as jnp
from jax import lax
import numpy as np

D_MODEL = 2048
BATCH = 4
SEQ = 2048
DEPTH = 2
DEC_BATCH = 8
DEC_SEQ = 8
PAST_LEN = 16384
PAGE_SIZE = 128

D_MIX = D_MODEL
D_LRU = D_MIX // 4
LRU_BLOCKS = 8
LRU_BW = D_LRU // LRU_BLOCKS
LRU_C = 8.0
CONV_W = 4
D_SB = D_MIX // 4
SB_HEADS = 8
SB_HEAD_DIM = D_SB // SB_HEADS
SB_BLOCK = 128
SB_BIAS_HI = -5.0
SB_BIAS_LO = -10.0
D_GDN = D_MIX // 2
GDN_HEADS = 8
GDN_HEAD_DIM = D_GDN // GDN_HEADS
GDN_CHUNK = 64
D_FF = ((8 * D_MODEL // 3) + 255) // 256 * 256
FFN_CONV_W = 3
N_MOD = 6
EPS = 1e-6
SPLIT_SIZES = (D_LRU, D_LRU, D_SB, D_SB, D_SB, 3 * D_GDN, D_GDN, GDN_HEADS, GDN_HEADS)
D_IN = 2 * D_LRU + 3 * D_SB + 4 * D_GDN + 2 * GDN_HEADS

kernel_name = 'hymba_lru_stickbreak_gdn_convffn_step'

F32 = jnp.float32


def rmsnorm(x, g):
    xf = x.astype(F32)
    y = xf * lax.rsqrt(jnp.mean(xf * xf, axis=-1, keepdims=True) + EPS)
    return (y * g.astype(F32)).astype(x.dtype)


def l2norm(x):
    xf = x.astype(F32)
    return xf * lax.rsqrt(jnp.sum(xf * xf, axis=-1, keepdims=True) + EPS)


def split_columns(a, sizes):
    out, start = [], 0
    for s in sizes:
        out.append(a[..., start:start + s])
        start += s
    return out


def causal_dwconv(x, buf, w, b=None):
    width = w.shape[0]
    t = x.shape[1]
    xp = jnp.concatenate([buf.astype(x.dtype), x], axis=1)
    y = xp[:, 0:t] * w[0]
    for i in range(1, width):
        y = y + xp[:, i:i + t] * w[i]
    if b is not None:
        y = y + b
    return y, xp[:, t:]


def _lin_combine(left, right):
    a_l, u_l = left
    a_r, u_r = right
    return a_l * a_r, a_r * u_l + u_r


def rglru(x, h0, w_r, b_r, w_i, b_i, lam):
    bsz, t, _ = x.shape
    xb = x.reshape(bsz, t, LRU_BLOCKS, LRU_BW)
    r = jax.nn.sigmoid((jnp.einsum('btnc,ncd->btnd', xb, w_r).reshape(bsz, t, D_LRU) + b_r).astype(F32))
    i = jax.nn.sigmoid((jnp.einsum('btnc,ncd->btnd', xb, w_i).reshape(bsz, t, D_LRU) + b_i).astype(F32))
    log_a = LRU_C * r * jax.nn.log_sigmoid(lam.astype(F32))
    a = jnp.exp(log_a)
    u = jnp.sqrt(-jnp.expm1(2.0 * log_a)) * (i * x.astype(F32))
    a_cum, u_cum = lax.associative_scan(_lin_combine, (a, u), axis=1)
    h = a_cum * h0.astype(F32)[:, None, :] + u_cum
    return h, h[:, -1]


def stick_breaking(q, k, v, q_pos, k_pos, bias):
    bsz, tq, nh, dh = q.shape
    blk = min(SB_BLOCK, tq)
    nb = -(-tq // blk)
    pad = nb * blk - tq
    q = jnp.pad(q, ((0, 0), (0, pad), (0, 0), (0, 0)))
    q_pos = jnp.pad(q_pos, (0, pad), mode='edge')
    qb = q.reshape(bsz, nb, blk, nh, dh).transpose(1, 0, 2, 3, 4)
    pb = q_pos.reshape(nb, blk)
    scale = dh ** -0.5
    bias_f = bias.astype(F32)[None, :, None, None]

    def one_block(args):
        qi, pi = args
        z = jnp.einsum('bqhd,bkhd->bhqk', qi, k).astype(F32) * scale + bias_f
        causal = k_pos[None, :] < pi[:, None]
        log_keep = jnp.where(causal, jax.nn.log_sigmoid(-z), 0.0)
        shifted = jnp.concatenate([log_keep[..., 1:], jnp.zeros_like(log_keep[..., :1])], axis=-1)
        after = lax.cumsum(shifted, axis=3, reverse=True)
        w = jnp.where(causal, jnp.exp(jax.nn.log_sigmoid(z) + after), 0.0)
        return jnp.einsum('bhqk,bkhd->bqhd', w.astype(v.dtype), v)

    o = lax.map(one_block, (qb, pb))
    return o.transpose(1, 0, 2, 3, 4).reshape(bsz, nb * blk, nh, dh)[:, :tq]


def gated_delta(q, k, v, g, beta, s0):
    bsz, t, nh, dk = q.shape
    dv = v.shape[-1]
    c = GDN_CHUNK
    n = -(-t // c)
    pad = n * c - t

    def chunk4(a):
        a = jnp.pad(a, ((0, 0), (0, pad), (0, 0), (0, 0)))
        return a.reshape(bsz, n, c, nh, a.shape[-1]).transpose(1, 0, 3, 2, 4)

    def chunk3(a):
        a = jnp.pad(a, ((0, 0), (0, pad), (0, 0)))
        return a.reshape(bsz, n, c, nh).transpose(1, 0, 3, 2)

    q = chunk4(q) * dk ** -0.5
    k = chunk4(k)
    v = chunk4(v)
    g = lax.cumsum(chunk3(g), axis=3)
    beta = chunk3(beta)
    idx = jnp.arange(c)
    incl = idx[:, None] >= idx[None, :]
    strict = idx[:, None] > idx[None, :]
    decay = jnp.exp(jnp.where(incl, g[..., :, None] - g[..., None, :], -jnp.inf))
    kb = k * beta[..., None]
    lmat = jnp.where(strict, jnp.einsum('nbhcd,nbhed->nbhce', kb, k) * decay, 0.0)
    eye = jnp.eye(c, dtype=F32)
    rhs = jnp.concatenate([v * beta[..., None], kb * jnp.exp(g)[..., None]], axis=-1)
    sol = lax.linalg.triangular_solve(eye + lmat, rhs, left_side=True, lower=True, unit_diagonal=True)
    u, w = sol[..., :dv], sol[..., dv:]
    qk = jnp.einsum('nbhcd,nbhed->nbhce', q, k) * decay

    def step(s, inp):
        q_i, k_i, u_i, w_i, g_i, qk_i = inp
        v_new = u_i - jnp.einsum('bhcd,bhde->bhce', w_i, s)
        o = (jnp.einsum('bhcd,bhde->bhce', q_i * jnp.exp(g_i)[..., None], s)
             + jnp.einsum('bhce,bhef->bhcf', qk_i, v_new))
        g_last = g_i[..., -1]
        s = (s * jnp.exp(g_last)[..., None, None]
             + jnp.einsum('bhcd,bhce->bhde', k_i * jnp.exp(g_last[..., None] - g_i)[..., None], v_new))
        return s, o

    s, o = lax.scan(step, s0.astype(F32), (q, k, u, w, g, qk))
    o = o.transpose(1, 0, 3, 2, 4).reshape(bsz, n * c, nh, dv)[:, :t]
    return o, s


def trunk_layer(x, c, k_past, v_past, lru_buf, lru_h, gdn_buf, gdn_s, ffn_buf, p):
    bsz, t, _ = x.shape
    past = k_past.shape[1]
    dt = x.dtype
    mod = (jax.nn.silu(c) @ p['w_ada'] + p['b_ada']).reshape(bsz, N_MOD, 1, D_MODEL)
    shift_m, scale_m, gate_m, shift_f, scale_f, gate_f = (mod[:, j] for j in range(N_MOD))

    h = rmsnorm(x, p['g_pre_mix']) * (1.0 + scale_m) + shift_m
    proj = h @ p['w_in']
    a_x, a_g, b_q, b_k, b_v, c_qkv, c_z, c_b, c_a = split_columns(proj, SPLIT_SIZES)

    a_xc, lru_buf_new = causal_dwconv(a_x, lru_buf, p['conv_lru_w'], p['conv_lru_b'])
    a_h, h_last = rglru(a_xc, lru_h, p['w_lru_r'], p['b_lru_r'], p['w_lru_i'], p['b_lru_i'], p['lru_lambda'])
    y_a = rmsnorm((a_h * jax.nn.gelu(a_g.astype(F32))).astype(dt), p['g_grp_lru'])

    q = b_q.reshape(bsz, t, SB_HEADS, SB_HEAD_DIM)
    k_new = b_k.reshape(bsz, t, SB_HEADS, SB_HEAD_DIM)
    v_new = b_v.reshape(bsz, t, SB_HEADS, SB_HEAD_DIM)
    k_all = jnp.concatenate([k_past.astype(dt), k_new], axis=1)
    v_all = jnp.concatenate([v_past.astype(dt), v_new], axis=1)
    pos_k = jnp.arange(past + t, dtype=jnp.int32)
    pos_q = past + jnp.arange(t, dtype=jnp.int32)
    y_b = stick_breaking(q, k_all, v_all, pos_q, pos_k, p['sb_bias']).reshape(bsz, t, D_SB)
    y_b = rmsnorm(y_b, p['g_grp_sb'])

    c_qkv_c, gdn_buf_new = causal_dwconv(c_qkv, gdn_buf, p['conv_gdn_w'])
    c_qkv_c = jax.nn.silu(c_qkv_c)
    cq, ck, cv = jnp.split(c_qkv_c, 3, axis=-1)
    heads = lambda a: a.reshape(bsz, t, GDN_HEADS, GDN_HEAD_DIM)
    beta = jax.nn.sigmoid(c_b.astype(F32))
    g = -jnp.exp(p['gdn_a_log'].astype(F32)) * jax.nn.softplus(c_a.astype(F32) + p['gdn_dt_bias'].astype(F32))
    o_c, s_new = gated_delta(l2norm(heads(cq)), l2norm(heads(ck)), heads(cv).astype(F32), g, beta, gdn_s)
    o_c = rmsnorm(o_c, p['g_gdn_norm']) * jax.nn.silu(heads(c_z).astype(F32))
    y_c = o_c.astype(dt).reshape(bsz, t, D_GDN)

    mix = jnp.concatenate([y_a, y_b, y_c], axis=-1) @ p['w_out']
    x = x + gate_m * rmsnorm(mix, p['g_post_mix'])

    h = rmsnorm(x, p['g_pre_ffn']) * (1.0 + scale_f) + shift_f
    up = h @ p['w_ffn_up']
    gate, val = up[..., :D_FF], up[..., D_FF:]
    gate_c, ffn_buf_new = causal_dwconv(gate, ffn_buf, p['conv_ffn_w'], p['conv_ffn_b'])
    f = (jax.nn.silu(gate_c) * val) @ p['w_ffn_down']
    x = x + gate_f * rmsnorm(f, p['g_post_ffn'])
    return (x, k_new, v_new, lru_buf_new, h_last.astype(lru_h.dtype), gdn_buf_new,
            s_new.astype(gdn_s.dtype), ffn_buf_new)


def setup_inputs(seed: int = 0) -> dict:
    key = jax.random.key(seed)
    ks = iter(jax.random.split(key, 64))

    def nrm(shape, scale):
        return scale * jax.random.normal(next(ks), shape, F32)

    n_pages = PAST_LEN // PAGE_SIZE
    n_pool = (5 * DEC_BATCH * n_pages + 3) // 4
    page_table = jax.random.permutation(next(ks), n_pool)[: DEC_BATCH * n_pages].reshape(DEC_BATCH, n_pages).astype(jnp.int32)
    a_c = jax.random.uniform(next(ks), (DEPTH, D_LRU), F32, minval=0.9, maxval=0.999)
    a_base = a_c ** (1.0 / LRU_C)
    lru_lambda = jnp.log(a_base) - jnp.log1p(-a_base)
    gdn_a_log = jnp.log(jax.random.uniform(next(ks), (DEPTH, GDN_HEADS), F32, minval=1.0, maxval=16.0))
    dt0 = jnp.exp(jax.random.uniform(next(ks), (DEPTH, GDN_HEADS), F32, minval=math.log(1e-3), maxval=math.log(1e-1)))
    gdn_dt_bias = dt0 + jnp.log(-jnp.expm1(-dt0))
    sb_bias = jnp.linspace(SB_BIAS_HI, SB_BIAS_LO, SB_HEADS, dtype=F32)[None, :] + nrm((DEPTH, SB_HEADS), 0.1)
    gain = lambda shape: 1.0 + nrm(shape, 0.02)
    return {
        'x_prompt': nrm((BATCH, SEQ, D_MODEL), 1.0),
        'x_sample': nrm((DEC_BATCH, DEC_SEQ, D_MODEL), 1.0),
        'c_prompt': nrm((BATCH, D_MODEL), 1.0),
        'c_sample': nrm((DEC_BATCH, D_MODEL), 1.0),
        'cache_sb_k': nrm((DEPTH, n_pool, PAGE_SIZE, SB_HEADS, SB_HEAD_DIM), 1.0),
        'cache_sb_v': nrm((DEPTH, n_pool, PAGE_SIZE, SB_HEADS, SB_HEAD_DIM), 1.0),
        'page_table': page_table,
        'state_lru_conv': nrm((DEPTH, DEC_BATCH, CONV_W - 1, D_LRU), 1.0),
        'state_lru_h': nrm((DEPTH, DEC_BATCH, D_LRU), 0.5),
        'state_gdn_conv': nrm((DEPTH, DEC_BATCH, CONV_W - 1, 3 * D_GDN), 1.0),
        'state_gdn': nrm((DEPTH, DEC_BATCH, GDN_HEADS, GDN_HEAD_DIM, GDN_HEAD_DIM), 0.1),
        'state_ffn_conv': nrm((DEPTH, DEC_BATCH, FFN_CONV_W - 1, D_FF), 1.0),
        'w_ada': nrm((DEPTH, D_MODEL, N_MOD * D_MODEL), 0.5 * D_MODEL ** -0.5),
        'b_ada': nrm((DEPTH, N_MOD * D_MODEL), 0.01),
        'g_pre_mix': gain((DEPTH, D_MODEL)),
        'g_post_mix': gain((DEPTH, D_MODEL)),
        'g_pre_ffn': gain((DEPTH, D_MODEL)),
        'g_post_ffn': gain((DEPTH, D_MODEL)),
        'w_in': nrm((DEPTH, D_MODEL, D_IN), D_MODEL ** -0.5),
        'conv_lru_w': nrm((DEPTH, CONV_W, D_LRU), CONV_W ** -0.5),
        'conv_lru_b': nrm((DEPTH, D_LRU), 0.01),
        'w_lru_r': nrm((DEPTH, LRU_BLOCKS, LRU_BW, LRU_BW), LRU_BW ** -0.5),
        'b_lru_r': nrm((DEPTH, D_LRU), 0.01),
        'w_lru_i': nrm((DEPTH, LRU_BLOCKS, LRU_BW, LRU_BW), LRU_BW ** -0.5),
        'b_lru_i': nrm((DEPTH, D_LRU), 0.01),
        'lru_lambda': lru_lambda,
        'g_grp_lru': gain((DEPTH, D_LRU)),
        'g_grp_sb': gain((DEPTH, D_SB)),
        'sb_bias': sb_bias,
        'conv_gdn_w': nrm((DEPTH, CONV_W, 3 * D_GDN), CONV_W ** -0.5),
        'gdn_a_log': gdn_a_log,
        'gdn_dt_bias': gdn_dt_bias,
        'g_gdn_norm': gain((DEPTH, GDN_HEAD_DIM)),
        'w_out': nrm((DEPTH, D_MIX, D_MODEL), D_MIX ** -0.5),
        'w_ffn_up': nrm((DEPTH, D_MODEL, 2 * D_FF), D_MODEL ** -0.5),
        'conv_ffn_w': nrm((DEPTH, FFN_CONV_W, D_FF), FFN_CONV_W ** -0.5),
        'conv_ffn_b': nrm((DEPTH, D_FF), 0.01),
        'w_ffn_down': nrm((DEPTH, D_FF, D_MODEL), D_FF ** -0.5),
    }


def reference(x_prompt, x_sample, c_prompt, c_sample, cache_sb_k, cache_sb_v, page_table,
              state_lru_conv, state_lru_h, state_gdn_conv, state_gdn, state_ffn_conv,
              w_ada, b_ada, g_pre_mix, g_post_mix, g_pre_ffn, g_post_ffn, w_in,
              conv_lru_w, conv_lru_b, w_lru_r, b_lru_r, w_lru_i, b_lru_i, lru_lambda,
              g_grp_lru, g_grp_sb, sb_bias, conv_gdn_w, gdn_a_log, gdn_dt_bias, g_gdn_norm, w_out,
              w_ffn_up, conv_ffn_w, conv_ffn_b, w_ffn_down):
    bp = x_prompt.shape[0]
    bs = x_sample.shape[0]
    n_pages = page_table.shape[1]
    dt = x_prompt.dtype
    names = ('kp', 'vp', 'ks', 'vs', 'lcp', 'lcs', 'lhp', 'lhs', 'gcp', 'gcs', 'gsp', 'gss', 'fcp', 'fcs')
    new = {nm: [] for nm in names}
    xp, xs = x_prompt, x_sample
    for l in range(DEPTH):
        prm = {
            'w_ada': w_ada[l], 'b_ada': b_ada[l], 'g_pre_mix': g_pre_mix[l], 'g_post_mix': g_post_mix[l],
            'g_pre_ffn': g_pre_ffn[l], 'g_post_ffn': g_post_ffn[l], 'w_in': w_in[l],
            'conv_lru_w': conv_lru_w[l], 'conv_lru_b': conv_lru_b[l], 'w_lru_r': w_lru_r[l], 'b_lru_r': b_lru_r[l],
            'w_lru_i': w_lru_i[l], 'b_lru_i': b_lru_i[l], 'lru_lambda': lru_lambda[l],
            'g_grp_lru': g_grp_lru[l], 'g_grp_sb': g_grp_sb[l], 'sb_bias': sb_bias[l], 'conv_gdn_w': conv_gdn_w[l],
            'gdn_a_log': gdn_a_log[l], 'gdn_dt_bias': gdn_dt_bias[l], 'g_gdn_norm': g_gdn_norm[l],
            'w_out': w_out[l], 'w_ffn_up': w_ffn_up[l], 'conv_ffn_w': conv_ffn_w[l], 'conv_ffn_b': conv_ffn_b[l],
            'w_ffn_down': w_ffn_down[l],
        }
        kv0 = jnp.zeros((bp, 0, SB_HEADS, SB_HEAD_DIM), dt)
        xp, kp, vp, lcp, lhp, gcp, gsp, fcp = trunk_layer(
            xp, c_prompt, kv0, kv0,
            jnp.zeros((bp, CONV_W - 1, D_LRU), dt), jnp.zeros((bp, D_LRU), dt),
            jnp.zeros((bp, CONV_W - 1, 3 * D_GDN), dt),
            jnp.zeros((bp, GDN_HEADS, GDN_HEAD_DIM, GDN_HEAD_DIM), dt),
            jnp.zeros((bp, FFN_CONV_W - 1, D_FF), dt), prm)
        k_past = cache_sb_k[l][page_table].reshape(bs, n_pages * PAGE_SIZE, SB_HEADS, SB_HEAD_DIM)
        v_past = cache_sb_v[l][page_table].reshape(bs, n_pages * PAGE_SIZE, SB_HEADS, SB_HEAD_DIM)
        xs, ks_, vs_, lcs, lhs, gcs, gss, fcs = trunk_layer(
            xs, c_sample, k_past, v_past, state_lru_conv[l], state_lru_h[l],
            state_gdn_conv[l], state_gdn[l], state_ffn_conv[l], prm)
        for nm, arr in (('kp', kp), ('vp', vp), ('ks', ks_), ('vs', vs_), ('lcp', lcp), ('lcs', lcs),
                        ('lhp', lhp), ('lhs', lhs), ('gcp', gcp), ('gcs', gcs), ('gsp', gsp), ('gss', gss),
                        ('fcp', fcp), ('fcs', fcs)):
            new[nm].append(arr)
    return (xp, xs,
            jnp.stack(new['kp']), jnp.stack(new['vp']), jnp.stack(new['ks']), jnp.stack(new['vs']),
            jnp.stack(new['lcp']), jnp.stack(new['lcs']), jnp.stack(new['lhp']), jnp.stack(new['lhs']),
            jnp.stack(new['gcp']), jnp.stack(new['gcs']), jnp.stack(new['gsp']), jnp.stack(new['gss']),
            jnp.stack(new['fcp']), jnp.stack(new['fcs']))
```

```cpp
#include <hip/hip_runtime.h>
#include <cstdio>
#include <cstdint>
namespace pg8 {
#define PG8_LAS __attribute__((address_space(3)))
typedef unsigned short bf16_t;
typedef short bf16x8 __attribute__((ext_vector_type(8)));
typedef float f32x4 __attribute__((ext_vector_type(4)));
typedef unsigned u32x4 __attribute__((ext_vector_type(4)));
constexpr int BM = 256, BK = 64, HALF = 128, HTB = HALF * BK * 2  , STAGE_BYTES = 8 * HTB, NXCD = 8, WGM = 8;

__host__ __device__ __forceinline__ int lds_byte(int r, int c) { const int st = (r >> 4) * 2 + (c >> 5), rr = r & 15, cc = c & 31, ob = rr * 64 + cc * 2; return st * 1024 + (ob ^ (((ob >> 9) & 1) << 5)); }
__host__ __device__ __forceinline__ void stage_rc(int b, int& R, int& C) { const int st = b / 1024, sb = b % 1024, swz = sb ^ (((sb >> 9) & 1) << 5); R = (st >> 1) * 16 + swz / 64; C = (st & 1) * 32 + (swz % 64) / 2; }
__host__ __device__ __forceinline__ int perm32(int rho) { const int n = rho >> 4, i = rho & 15; return 8 * (i >> 2) + 4 * n + (i & 3); }

struct Unit { int pm, pn; };
struct Gemm { const bf16_t* A; const bf16_t* Bt; int M, N, K; };

struct StaticOrder {
    int nM, nN, nwg, G, c, rep;
    __host__ __device__ void init(int M, int N, int G_, int c_) { nM = M / BM; nN = N / BM; nwg = nM * nN; G = G_; c = c_; rep = 1; }
    __host__ __device__ bool next(int i, Unit& u) const {
        const long L = (long)i * G + c; if (L >= (long)nwg * rep) return false;
        int wgid = (int)(L % nwg); { const int q = nwg / NXCD, r = nwg % NXCD, xcd = wgid % NXCD, off = wgid / NXCD; wgid = (xcd < r ? xcd * (q + 1) : r * (q + 1) + (xcd - r) * q) + off; }
        const int nig = WGM * nN, gid = wgid / nig, fm = gid * WGM, gsz = (nM - fm) < WGM ? (nM - fm) : WGM;
        u.pm = fm + ((wgid % nig) % gsz); u.pn = (wgid % nig) / gsz; return true;
    }
    __device__ __forceinline__ void a_ready(const Unit&) const {}
    __device__ __forceinline__ void done(const Unit&) const {}
};

__device__ __forceinline__ unsigned cvt_pk_bf16(float lo, float hi) { unsigned r; asm volatile("v_cvt_pk_bf16_f32 %0, %1, %2" : "=v"(r) : "v"(lo), "v"(hi)); return r; }
typedef float f32x2 __attribute__((ext_vector_type(2)));
template <class Epi, class Sched, bool ALIGN_EPI = false, bool SP2 = false>
__device__ __forceinline__ void gemm_phase(PG8_LAS unsigned char* lds, const Gemm g, const Sched& S, const Epi& E) {
    int tid_ = threadIdx.x; asm volatile("" : "+v"(tid_)); const int tid = tid_, wid = __builtin_amdgcn_readfirstlane(tid >> 6), lane = tid & 63, wr = wid >> 2, wc = wid & 3, fr = lane & 15, fq = lane >> 4;
    const int K = g.K, nt = K / BK;
    unsigned voffA[2], voffB[2];
#pragma unroll
    for (int i = 0; i < 2; ++i) { int R, C; stage_rc(tid * 16 + i * 8192, R, C); const int Rb = Epi::PERM ? ((R & ~31) + perm32(R & 31)) : R;
        voffA[i] = (unsigned)(R * K + C) * 2u; voffB[i] = (unsigned)(Rb * K + C) * 2u; }
    const size_t kstep = (size_t)(BK * 2);
    const size_t hstep = (size_t)HALF * K * 2;
    const size_t tstep = 2 * hstep;
    const unsigned ldsw = (unsigned)wid * 1024u;
    const int aoff = lds_byte(wr * 64 + fr, fq * 8), boff = lds_byte(wc * 32 + fr, fq * 8);
#define PG8_SA(b, h) (((b) * 2 + (h)) * HTB)
#define PG8_SB(b, h) ((4 + (b) * 2 + (h)) * HTB)
#define PG8_STAGE(bufoff, gbase, voff) do { _Pragma("unroll") for (int _i = 0; _i < 2; ++_i) \
        __builtin_amdgcn_global_load_lds((const unsigned*)((const char*)(gbase) + (voff)[_i]), (PG8_LAS unsigned*)(lds + (bufoff) + ldsw + _i * 8192), 16, 0, 0); } while (0)
#define PG8_LDA(dst, b, h) do { _Pragma("unroll") for (int m = 0; m < 4; ++m) _Pragma("unroll") for (int k = 0; k < 2; ++k) dst[m][k] = *(const PG8_LAS bf16x8*)(lds + PG8_SA(b, h) + aoff + m * 2048 + k * 1024); } while (0)
#define PG8_LDB(dst, b, h) do { _Pragma("unroll") for (int n = 0; n < 2; ++n) _Pragma("unroll") for (int k = 0; k < 2; ++k) dst[n][k] = *(const PG8_LAS bf16x8*)(lds + PG8_SB(b, h) + boff + n * 2048 + k * 1024); } while (0)
#define PG8_MMA(ai, bj, At, Bt) do { __builtin_amdgcn_s_setprio(1); _Pragma("unroll") for (int m = 0; m < 4; ++m) _Pragma("unroll") for (int n = 0; n < 2; ++n) _Pragma("unroll") for (int k = 0; k < 2; ++k) \
        acc[ai][bj][m][n] = __builtin_amdgcn_mfma_f32_16x16x32_bf16(Bt[n][k], At[m][k], acc[ai][bj][m][n], 0, 0, 0); __builtin_amdgcn_s_setprio(0); } while (0)
#define PG8_WAIT_V(n) asm volatile("s_waitcnt vmcnt(" #n ")" ::: "memory")
#define PG8_WAIT_L(n) asm volatile("s_waitcnt lgkmcnt(" #n ")" ::: "memory")
#define PG8_BAR __builtin_amdgcn_s_barrier()
#define PG8_SCHED __builtin_amdgcn_sched_barrier(0)
    Unit cur, nxt; int ui = 0;
    if (!S.next(0, cur)) return;
    f32x4 acc[2][2][4][2];
#pragma unroll
    for (int a = 0; a < 2; ++a)
#pragma unroll
        for (int b = 0; b < 2; ++b)
#pragma unroll
            for (int m = 0; m < 4; ++m)
#pragma unroll
                for (int n = 0; n < 2; ++n) acc[a][b][m][n] = (f32x4){0.f, 0.f, 0.f, 0.f};
    bf16x8 At[4][2], B0[2][2], B1[2][2];
    const char* cA = (const char*)g.A + (size_t)cur.pm * tstep; const char* cB = (const char*)g.Bt + (size_t)cur.pn * tstep;
    S.a_ready(cur);
    if constexpr (SP2) {
        PG8_STAGE(PG8_SB(0, 0), cB, voffB); PG8_STAGE(PG8_SB(0, 1), cB + hstep, voffB); PG8_STAGE(PG8_SA(0, 0), cA, voffA); PG8_STAGE(PG8_SA(0, 1), cA + hstep, voffA);
        if (wr == 1) PG8_BAR;
        PG8_WAIT_V(2); PG8_BAR;
        PG8_STAGE(PG8_SB(1, 0), cB + kstep, voffB); PG8_STAGE(PG8_SA(1, 0), cA + kstep, voffA); PG8_STAGE(PG8_SB(1, 1), cB + hstep + kstep, voffB);
        PG8_WAIT_V(6); PG8_BAR;
    } else {
        PG8_STAGE(PG8_SB(0, 0), cB, voffB); PG8_STAGE(PG8_SA(0, 0), cA, voffA); PG8_STAGE(PG8_SB(0, 1), cB + hstep, voffB); PG8_STAGE(PG8_SA(0, 1), cA + hstep, voffA);
        if (wr == 1) PG8_BAR;
        PG8_WAIT_V(4); PG8_BAR;
        PG8_STAGE(PG8_SB(1, 0), cB + kstep, voffB); PG8_STAGE(PG8_SA(1, 0), cA + kstep, voffA); PG8_STAGE(PG8_SB(1, 1), cB + hstep + kstep, voffB);
        PG8_WAIT_V(6); PG8_BAR;
    }
    for (;;) {
        const bool has_next = S.next(ui + 1, nxt);
        const char* nA = has_next ? (const char*)g.A + (size_t)nxt.pm * tstep : cA; const char* nB = has_next ? (const char*)g.Bt + (size_t)nxt.pn * tstep : cB;
        for (int t = 0; t < nt; t += 2) {
            const bool last = (t == nt - 2);
            const char* a1 = cA + (size_t)(t + 1) * kstep;
            const char* a2 = last ? nA : cA + (size_t)(t + 2) * kstep; const char* b2 = last ? nB : cB + (size_t)(t + 2) * kstep;
            const char* a3 = a2 + kstep; const char* b3 = b2 + kstep;
            if (last && has_next) S.a_ready(nxt);
            if constexpr (SP2) {
            PG8_LDB(B0, 0, 0); PG8_LDB(B1, 0, 1); PG8_SCHED; PG8_LDA(At, 0, 0); PG8_STAGE(PG8_SA(1, 1), a1 + hstep, voffA);
            PG8_WAIT_V(8); PG8_WAIT_L(0); PG8_BAR; PG8_MMA(0, 0, At, B0); PG8_MMA(0, 1, At, B1); PG8_BAR; PG8_SCHED;
            PG8_LDA(At, 0, 1); PG8_STAGE(PG8_SB(0, 0), b2, voffB); PG8_STAGE(PG8_SB(0, 1), b2 + hstep, voffB); PG8_STAGE(PG8_SA(0, 0), a2, voffA);
            PG8_WAIT_V(8); PG8_WAIT_L(0); PG8_BAR; PG8_MMA(1, 0, At, B0); PG8_MMA(1, 1, At, B1); PG8_BAR; PG8_SCHED;
            PG8_LDB(B0, 1, 0); PG8_LDB(B1, 1, 1); PG8_SCHED; PG8_LDA(At, 1, 0); PG8_STAGE(PG8_SA(0, 1), a2 + hstep, voffA);
            PG8_WAIT_V(8); PG8_WAIT_L(0); PG8_BAR; PG8_MMA(0, 0, At, B0); PG8_MMA(0, 1, At, B1); PG8_BAR; PG8_SCHED;
            PG8_LDA(At, 1, 1); PG8_STAGE(PG8_SB(1, 0), b3, voffB); PG8_STAGE(PG8_SB(1, 1), b3 + hstep, voffB); PG8_STAGE(PG8_SA(1, 0), a3, voffA);
            PG8_WAIT_V(8); PG8_WAIT_L(0); PG8_BAR; PG8_MMA(1, 0, At, B0); PG8_MMA(1, 1, At, B1); PG8_BAR; PG8_SCHED;
            } else {
            PG8_LDB(B0, 0, 0); PG8_SCHED; PG8_LDA(At, 0, 0); PG8_STAGE(PG8_SA(1, 1), a1 + hstep, voffA);
            PG8_WAIT_L(8); PG8_BAR; PG8_WAIT_L(0); PG8_MMA(0, 0, At, B0); PG8_BAR; PG8_SCHED;
            PG8_LDB(B1, 0, 1); PG8_STAGE(PG8_SB(0, 0), b2, voffB);
            PG8_BAR; PG8_WAIT_L(0); PG8_MMA(0, 1, At, B1); PG8_BAR;
            PG8_LDA(At, 0, 1); PG8_STAGE(PG8_SA(0, 0), a2, voffA);
            PG8_BAR; PG8_WAIT_L(0); PG8_MMA(1, 0, At, B0); PG8_BAR; PG8_SCHED;
            PG8_STAGE(PG8_SB(0, 1), b2 + hstep, voffB);
            PG8_WAIT_V(6); PG8_BAR; PG8_MMA(1, 1, At, B1); PG8_BAR;
            PG8_LDB(B0, 1, 0); PG8_SCHED; PG8_LDA(At, 1, 0); PG8_STAGE(PG8_SA(0, 1), a2 + hstep, voffA);
            PG8_WAIT_L(8); PG8_BAR; PG8_WAIT_L(0); PG8_MMA(0, 0, At, B0); PG8_BAR; PG8_SCHED;
            PG8_LDB(B1, 1, 1); PG8_STAGE(PG8_SB(1, 0), b3, voffB);
            PG8_BAR; PG8_WAIT_L(0); PG8_MMA(0, 1, At, B1); PG8_BAR;
            PG8_LDA(At, 1, 1); PG8_STAGE(PG8_SA(1, 0), a3, voffA);
            PG8_BAR; PG8_WAIT_L(0); PG8_MMA(1, 0, At, B0); PG8_BAR; PG8_SCHED;
            PG8_STAGE(PG8_SB(1, 1), b3 + hstep, voffB);
            PG8_WAIT_V(6); PG8_BAR; PG8_MMA(1, 1, At, B1); PG8_BAR;
            }
        }
        if constexpr (ALIGN_EPI) { if (wr == 0) PG8_BAR; }
        if constexpr (!Epi::AFTER_DRAIN) { E(acc, cur, wr, wc, fr, fq); S.done(cur); }
        if (!has_next) break;
#pragma unroll
        for (int a = 0; a < 2; ++a)
#pragma unroll
            for (int b = 0; b < 2; ++b)
#pragma unroll
                for (int m = 0; m < 4; ++m)
#pragma unroll
                    for (int n = 0; n < 2; ++n) acc[a][b][m][n] = (f32x4){0.f, 0.f, 0.f, 0.f};
        cur = nxt; cA = nA; cB = nB; ++ui;
        if constexpr (ALIGN_EPI) { if (wr == 1) PG8_BAR; }
    }
    PG8_WAIT_V(0);
    if constexpr (!ALIGN_EPI) { if (wr == 0) PG8_BAR; }
    PG8_BAR;
    if constexpr (Epi::AFTER_DRAIN) { E.fused(acc, cur, wr, wc, fr, fq, lds, wid, lane); S.done(cur); }
#undef PG8_SA
#undef PG8_SB
#undef PG8_STAGE
#undef PG8_LDA
#undef PG8_LDB
#undef PG8_MMA
#undef PG8_WAIT_V
#undef PG8_WAIT_L
#undef PG8_BAR
#undef PG8_SCHED
}
}
#define LAS __attribute__((address_space(3)))
#define XB_TMO      128
#define XB_XCNT(j)  (256  + 64 * (j))
#define XB_XSUB(j)  (1280 + 64 * (j))
#define XB_XGEN(j)  (2304 + 64 * (j))
#define XB_TOP      3328
#define XB_TOPGEN   3392
#define XCD_BAR_WORDS 3456
#define XB_SPIN_CAP (1u << 18)

__device__ __forceinline__ unsigned xb_ld(unsigned* p)              { return __hip_atomic_load(p, __ATOMIC_RELAXED, __HIP_MEMORY_SCOPE_AGENT); }
__device__ __forceinline__ unsigned xb_add(unsigned* p, unsigned v) { return __hip_atomic_fetch_add(p, v, __ATOMIC_RELAXED, __HIP_MEMORY_SCOPE_AGENT); }
__device__ __forceinline__ unsigned xb_xcc_id() { return (unsigned)__builtin_amdgcn_s_getreg((3 << 11) | 20) & 0xFu; }
#define XB_SPIN(cond, bar) do { unsigned _sp = 0; while (cond) { __builtin_amdgcn_s_sleep(1); \
    if ((++_sp & 255u) == 0u) { if (xb_ld(&(bar)[XB_TMO])) break; if (_sp > XB_SPIN_CAP) { atomicAdd(&(bar)[XB_TMO], 1u); break; } } } } while (0)

struct XcdBarrier {
    unsigned* bar; unsigned x;
    volatile LAS unsigned* st;
};

__device__ __forceinline__ XcdBarrier xcd_barrier_post(unsigned* bar, volatile LAS unsigned* st) {
    XcdBarrier b; b.bar = bar; b.x = xb_xcc_id(); b.st = st;
    if (threadIdx.x == 0) (void)xb_add(&bar[XB_XCNT(b.x)], 1u);
    return b;
}
__device__ __forceinline__ void xcd_barrier_complete(unsigned* bar, unsigned x, unsigned& nloc, unsigned& nx) {
    const unsigned G = gridDim.x * gridDim.y * gridDim.z;
    unsigned sum, cnt, mine, sp = 0u;
    for (;;) {
        sum = 0u; cnt = 0u; mine = 0u;
#pragma unroll
        for (unsigned j = 0; j < 16; ++j) { const unsigned c = xb_ld(&bar[XB_XCNT(j)]); sum += c; cnt += (c > 0u) ? 1u : 0u; mine = (j == x) ? c : mine; }
        if (sum == G) break;
        __builtin_amdgcn_s_sleep(1);
        if ((++sp & 255u) == 0u) { if (xb_ld(&bar[XB_TMO])) break; if (sp > XB_SPIN_CAP) { atomicAdd(&bar[XB_TMO], 1u); break; } }
    }
    nloc = mine > 0u ? mine : 1u; nx = cnt > 0u ? cnt : 1u;
}

__device__ __forceinline__ void xcd_barrier(const XcdBarrier& b) {
    asm volatile("s_waitcnt vmcnt(0)" ::: "memory");
    __syncthreads();
    if (threadIdx.x == 0) {
        unsigned* bar = b.bar;
        __builtin_amdgcn_s_waitcnt(0);
        unsigned nloc = b.st[0], nx = b.st[1];
        if (nloc == 0u) { xcd_barrier_complete(bar, b.x, nloc, nx); b.st[0] = nloc; b.st[1] = nx; }
        const unsigned old = xb_add(&bar[XB_XSUB(b.x)], 1u);
        const unsigned gen = old / nloc;
        if (old + 1u == (gen + 1u) * nloc) {
            __builtin_amdgcn_fence(__ATOMIC_RELEASE, "agent");
            asm volatile("s_waitcnt vmcnt(0)" ::: "memory");
            const unsigned og = xb_add(&bar[XB_TOP], 1u);
            const unsigned tg = og / nx;
            if (og + 1u == (tg + 1u) * nx) xb_add(&bar[XB_TOPGEN], 1u);
            else XB_SPIN(xb_ld(&bar[XB_TOPGEN]) == tg, bar);
            __builtin_amdgcn_fence(__ATOMIC_ACQUIRE, "agent");
            xb_add(&bar[XB_XGEN(b.x)], 1u);
            asm volatile("s_waitcnt vmcnt(0)" ::: "memory");
        } else {
            XB_SPIN(xb_ld(&bar[XB_XGEN(b.x)]) == gen, bar);
            __builtin_amdgcn_fence(__ATOMIC_ACQUIRE, "agent");
            asm volatile("s_waitcnt vmcnt(0)" ::: "memory");
        }
    }
    __syncthreads();
}

#ifndef TP
#define TP 0xffff
#endif
#ifndef TAILCONV
#define TAILCONV 0
#endif
#ifndef REPMASK
#define REPMASK 0
#endif
#ifndef RN
#define RN 2
#endif
#define REPN(bit) (((REPMASK >> (bit)) & 1) ? RN : 1)
#define GAS __attribute__((address_space(1)))
#ifndef LAS
#define LAS __attribute__((address_space(3)))
#endif
typedef unsigned short bf16;
typedef unsigned v4u __attribute__((ext_vector_type(4)));
typedef unsigned v2u __attribute__((ext_vector_type(2)));
typedef float f32x4 __attribute__((ext_vector_type(4)));
typedef float f32x16 __attribute__((ext_vector_type(16)));
typedef short bf16x8 __attribute__((ext_vector_type(8)));

constexpr int NWAVES = 8, NTHR = 512;
constexpr int DM = 2048, MP = 8192, MS = 64, MR = 8256, MPAD = 8448;
constexpr int DINP = 6912, DFF = 5632, DUP = 11264, PP = 6912  ;
constexpr int C_AX = 0, C_AG = 512, C_Q = 1024, C_K = 1536, C_V = 2048, C_GQ = 2560, C_B = 5632, C_A = 5640, C_Z = 5888;
constexpr float EPS = 1e-6f;
constexpr float LOG2E = 1.4426950408889634f;
constexpr float QSCALE = 0.125f * LOG2E;

constexpr size_t O_Y = 0;
constexpr size_t O_KP = (size_t)MR * DM;
constexpr size_t O_VP = O_KP + (size_t)2 * 4 * 2048 * 512;
constexpr size_t O_KS = O_VP + (size_t)2 * 4 * 2048 * 512;
constexpr size_t O_VS = O_KS + (size_t)2 * 64 * 512;
constexpr size_t O_LCP = O_VS + (size_t)2 * 64 * 512;
constexpr size_t O_LCS = O_LCP + (size_t)2 * 4 * 3 * 512;
constexpr size_t O_LHP = O_LCS + (size_t)2 * 8 * 3 * 512;
constexpr size_t O_LHS = O_LHP + (size_t)2 * 4 * 512;
constexpr size_t O_GCP = O_LHS + (size_t)2 * 8 * 512;
constexpr size_t O_GCS = O_GCP + (size_t)2 * 4 * 3 * 3072;
constexpr size_t O_GP = O_GCS + (size_t)2 * 8 * 3 * 3072;
constexpr size_t O_GS = O_GP + (size_t)2 * 4 * 8 * 128 * 128;
constexpr size_t O_FCP = O_GS + (size_t)2 * 8 * 8 * 128 * 128;
constexpr size_t O_FCS = O_FCP + (size_t)2 * 4 * 2 * 5632;
constexpr size_t O_END = O_FCS + (size_t)2 * 8 * 2 * 5632;
static_assert(O_END == 37502976, "output size");

constexpr size_t MiB = 1u << 20;
constexpr size_t WS_CTL = 0, CTL_ZERO_BYTES = 65536;
constexpr size_t WS_WIN = 1 * MiB;
constexpr size_t WS_WOUT = 55 * MiB;
constexpr size_t WS_WUP = 71 * MiB;
constexpr size_t WS_WDN = 159 * MiB;
constexpr size_t WS_MODP = 203 * MiB;
constexpr size_t WS_MOD = 208 * MiB;
constexpr size_t WS_H = 210 * MiB;
constexpr size_t WS_PROJ = 243 * MiB;
constexpr size_t WS_LH = 355 * MiB;
constexpr size_t WS_LA = 372 * MiB;
constexpr size_t WS_CARRY = 389 * MiB;
constexpr size_t WS_WF = 391 * MiB;
constexpr size_t WS_QEF = 408 * MiB;
constexpr size_t WS_KDF = 425 * MiB;
constexpr size_t WS_QKF = 442 * MiB;
constexpr size_t WS_UF = 451 * MiB;
constexpr size_t WS_GL = 485 * MiB;
constexpr size_t WS_OGDN = 486 * MiB;
constexpr size_t WS_OATT = 519 * MiB;
constexpr size_t WS_SPO = 536 * MiB;
constexpr size_t WS_SPT = 541 * MiB;
constexpr size_t WS_MIX = 542 * MiB;
constexpr size_t WS_MIXO = 575 * MiB;
constexpr size_t WS_GV = 641 * MiB;
constexpr size_t WS_ACT = 823 * MiB;
constexpr size_t WS_TAILG = 914 * MiB;
constexpr size_t WS_HEADG = 920 * MiB;
constexpr size_t WS_HEADV = 926 * MiB;
constexpr size_t WS_END = 932 * MiB;
constexpr size_t WIN_L = (size_t)DINP * DM * 2, WOUT_L = (size_t)DM * DM * 2, WUP_L = (size_t)DUP * DM * 2, WDN_L = (size_t)DM * DFF * 2;

constexpr int CW_BAR = 4096;
constexpr int CW_QUEUE = 8192;

constexpr int LDS_MISC = 147456;
constexpr int LDS_BYTES = 148480;

constexpr int NPHASE = 23;
template <int CTRL> __device__ __forceinline__ float dppf(float x) { return __builtin_bit_cast(float, __builtin_amdgcn_mov_dpp(__builtin_bit_cast(int, x), CTRL, 0xf, 0xf, true)); }

#define LDS_WAIT() asm volatile("s_waitcnt lgkmcnt(0)" ::: "memory")
__device__ __forceinline__ float bf2f(unsigned short u) { return __uint_as_float((unsigned)u << 16); }
__device__ __forceinline__ float bflo(unsigned u) { return __uint_as_float(u << 16); }
__device__ __forceinline__ float bfhi(unsigned u) { return __uint_as_float(u & 0xffff0000u); }
__device__ __forceinline__ unsigned cvtpk(float lo, float hi) {
    typedef float f2_t __attribute__((ext_vector_type(2))); typedef __bf16 b2_t __attribute__((ext_vector_type(2)));
    f2_t v = {lo, hi}; b2_t b = __builtin_convertvector(v, b2_t); return __builtin_bit_cast(unsigned, b); }
__device__ __forceinline__ unsigned short f2bf(float f) { return (unsigned short)(cvtpk(f, 0.f) & 0xffffu); }
__device__ __forceinline__ float wave_sum(float v) {
#pragma unroll
    for (int o = 1; o < 64; o <<= 1) v += __shfl_xor(v, o);
    return v;
}
__device__ __forceinline__ float sigmoidf_(float x) { return __builtin_amdgcn_rcpf(1.0f + __builtin_amdgcn_exp2f(-1.4426950408889634f * x)); }
__device__ __forceinline__ float siluf_(float x) { return x * __builtin_amdgcn_rcpf(1.0f + __builtin_amdgcn_exp2f(-1.4426950408889634f * x)); }
__device__ __forceinline__ float softplusf_(float x) {
    const float t = __builtin_amdgcn_exp2f(-1.4426950408889634f * fabsf(x));
    const float series = t * (1.0f - t * (0.5f - t * (0.33333334f - t * (0.25f - 0.2f * t))));
    const float lg = 0.6931471805599453f * __builtin_amdgcn_logf(1.0f + t);
    return fmaxf(x, 0.f) + (t < 0.03125f ? series : lg);
}
__device__ __forceinline__ float gelu_tanh(float x) { const float u = 0.7978845608028654f * (x + 0.044715f * x * x * x); return x * sigmoidf_(2.0f * u); }
__device__ __forceinline__ int crow(int r, int hi) { return (r & 3) + 8 * (r >> 2) + 4 * hi; }
__device__ __forceinline__ int seq_row0(int s) { return s < 4 ? s * 2048 : 8192 + (s - 4) * 8; }

typedef const __attribute__((address_space(4))) unsigned long long* kptr_t;
struct Ctx {
    kptr_t kp;
    GAS float* out; GAS unsigned char* ws;
    LAS unsigned char* lds;
    int tid, lane, wave, G, bid;
    __device__ __forceinline__ const float* in(int i) const { return (const float*)(GAS const float*)kp[i]; }
};
#define KA_FRESH(C) do { asm volatile("" : "+s"((C).kp)); asm volatile("" : "+s"((C).ws)); asm volatile("" : "+s"((C).out)); asm volatile("" : "+v"((C).tid)); (C).lane = (C).tid & 63; (C).wave = __builtin_amdgcn_readfirstlane((C).tid >> 6); } while (0)
#define WSP(T, off) ((T*)(GAS T*)(C.ws + (off)))
#define OUTB ((float*)C.out)

__device__ __forceinline__ void tr_item(const float* __restrict__ W, int K, int Nsrc, int sc0, int nv, bf16* WT, int n0, int k0, LAS float* scr, int lane) {
    const float* src = W + (size_t)k0 * Nsrc + sc0 + lane;
    const bool ok = lane < nv;
#pragma unroll 32
    for (int i = 0; i < 64; ++i) { const float v = ok ? __builtin_nontemporal_load(src + (size_t)i * Nsrc) : 0.f; scr[i * 65 + lane] = v; }
    LDS_WAIT(); asm volatile("" ::: "memory");
    const int c = lane & 7;
#pragma unroll
    for (int j = 0; j < 8; ++j) { const int n = (lane >> 3) + 8 * j; const LAS float* s = scr + (8 * c) * 65 + n;
        v4u o; o.x = cvtpk(s[0 * 65], s[1 * 65]); o.y = cvtpk(s[2 * 65], s[3 * 65]); o.z = cvtpk(s[4 * 65], s[5 * 65]); o.w = cvtpk(s[6 * 65], s[7 * 65]);
        __builtin_nontemporal_store(o, (GAS v4u*)(WT + (size_t)(n0 + n) * K + k0 + 8 * c)); }
    LDS_WAIT(); asm volatile("" ::: "memory");
}

struct ConvItem { const float* src; size_t stride; bool ok; bf16* dst; int K; };
__device__ __forceinline__ ConvItem conv_item(Ctx& C, int l, int kind, int r, int lane) {
    ConvItem it;
    if (kind == 0) { const int nb = r % 108, kb = r / 108; const int n0 = nb * 64;
        int sc0, nv; if (n0 < 5632) { sc0 = n0; nv = 64; } else if (n0 == 5632) { sc0 = 6656; nv = 16; } else if (n0 < 5888) { sc0 = 0; nv = 0; } else { sc0 = 5632 + (n0 - 5888); nv = 64; }
        it.src = C.in(18) + (size_t)l * DM * 6672 + (size_t)(kb * 64) * 6672 + sc0 + lane; it.stride = 6672; it.ok = lane < nv; it.K = DM; it.dst = WSP(bf16, WS_WIN + l * WIN_L) + (size_t)n0 * DM + kb * 64;
    } else if (kind == 1) { const int nb = r & 31, kb = r >> 5;
        it.src = C.in(33) + (size_t)l * DM * DM + (size_t)(kb * 64) * DM + nb * 64 + lane; it.stride = DM; it.ok = true; it.K = DM; it.dst = WSP(bf16, WS_WOUT + l * WOUT_L) + (size_t)(nb * 64) * DM + kb * 64;
    } else if (kind == 2) { const int nb = r % 176, kb = r / 176; const int n0 = nb * 64; const int pn = n0 >> 8, bj = (n0 >> 7) & 1, c0 = n0 & 127;
        it.src = C.in(34) + (size_t)l * DM * DUP + (size_t)(kb * 64) * DUP + bj * DFF + pn * 128 + c0 + lane; it.stride = DUP; it.ok = true; it.K = DM; it.dst = WSP(bf16, WS_WUP + l * WUP_L) + (size_t)n0 * DM + kb * 64;
    } else { const int nb = r & 31, kb = r >> 5;
        it.src = C.in(37) + (size_t)l * DFF * DM + (size_t)(kb * 64) * DM + nb * 64 + lane; it.stride = DM; it.ok = true; it.K = DFF; it.dst = WSP(bf16, WS_WDN + l * WDN_L) + (size_t)(nb * 64) * DFF + kb * 64;
    }
    return it;
}
__device__ __forceinline__ void conv_weights(Ctx& C, int l, int kind, int wi, int wn) {
    KA_FRESH(C);
    LAS float* scr = (LAS float*)(C.lds + C.wave * 16640);
    const int lane = C.lane;
    const int nitems = kind == 0 ? 108 * 32 : kind == 1 ? 32 * 32 : kind == 2 ? 176 * 32 : 32 * 88;
    float v[64];
    ConvItem cur;
    if (wi < nitems) { cur = conv_item(C, l, kind, wi, lane);
#pragma unroll
        for (int i = 0; i < 64; ++i) v[i] = cur.ok ? __builtin_nontemporal_load(cur.src + (size_t)i * cur.stride) : 0.f; }
#pragma unroll 1
    for (int r = wi; r < nitems; r += wn) {
#pragma unroll
        for (int i = 0; i < 64; ++i) scr[i * 65 + lane] = v[i];
        asm volatile("" ::: "memory");
        bf16* dst = cur.dst; const int K = cur.K;
        if (r + wn < nitems) { cur = conv_item(C, l, kind, r + wn, lane);
#pragma unroll
            for (int i = 0; i < 64; ++i) v[i] = cur.ok ? __builtin_nontemporal_load(cur.src + (size_t)i * cur.stride) : 0.f; }
        const int c = lane & 7;
#pragma unroll
        for (int j = 0; j < 8; ++j) { const int n = (lane >> 3) + 8 * j; const LAS float* s = scr + (8 * c) * 65 + n;
            v4u o; o.x = cvtpk(s[0 * 65], s[1 * 65]); o.y = cvtpk(s[2 * 65], s[3 * 65]); o.z = cvtpk(s[4 * 65], s[5 * 65]); o.w = cvtpk(s[6 * 65], s[7 * 65]);
            __builtin_nontemporal_store(o, (GAS v4u*)(dst + (size_t)n * K + 8 * c)); }
        asm volatile("" ::: "memory");
    }
}
__device__ __forceinline__ void p0_weights(Ctx& C) {
    const int wi = C.bid * NWAVES + C.wave, wn = C.G * NWAVES;
#pragma unroll 1
    for (int l = 0; l < 2; ++l) { conv_weights(C, l, 0, wi, wn); conv_weights(C, l, 1, wi, wn); conv_weights(C, l, 2, wi, wn); if (l == 0 || !TAILCONV) conv_weights(C, l, 3, wi, wn); }
}

__device__ __forceinline__ void p0_ada(Ctx& C) {
    KA_FRESH(C);
    LAS float* sc = (LAS float*)C.lds;
    __syncthreads();
    for (int k = C.tid; k < DM; k += NTHR) {
#pragma unroll
        for (int r = 0; r < 12; ++r) { const float c = (r < 4) ? C.in(2)[r * DM + k] : C.in(3)[(r - 4) * DM + k]; sc[k * 16 + r] = siluf_(c); }
    }
    __syncthreads();
    const int gw = C.bid * NWAVES + C.wave, NGW = C.G * NWAVES;
    for (int task = gw; task < 2 * 192 * 4; task += NGW) {
        const int l = task / 768, rem = task % 768, nb = rem >> 2, ks = rem & 3;
        const int n = nb * 64 + C.lane;
        const float* w = C.in(12) + ((size_t)l * DM + ks * 512) * 12288 + n;
        typedef float f2a __attribute__((ext_vector_type(2)));
        f2a ac[6];
#pragma unroll
        for (int r = 0; r < 6; ++r) ac[r] = (f2a){0.f, 0.f};
#pragma unroll 8
        for (int k = 0; k < 512; ++k) {
            const float wv = w[(size_t)k * 12288]; const f2a w2 = {wv, wv};
            const LAS f32x4* s = (const LAS f32x4*)(sc + (ks * 512 + k) * 16);
            const f32x4 s0 = s[0], s1 = s[1], s2 = s[2];
            ac[0] = __builtin_elementwise_fma((f2a){s0.x, s0.y}, w2, ac[0]); ac[1] = __builtin_elementwise_fma((f2a){s0.z, s0.w}, w2, ac[1]);
            ac[2] = __builtin_elementwise_fma((f2a){s1.x, s1.y}, w2, ac[2]); ac[3] = __builtin_elementwise_fma((f2a){s1.z, s1.w}, w2, ac[3]);
            ac[4] = __builtin_elementwise_fma((f2a){s2.x, s2.y}, w2, ac[4]); ac[5] = __builtin_elementwise_fma((f2a){s2.z, s2.w}, w2, ac[5]);
        }
        float acc[12];
#pragma unroll
        for (int r = 0; r < 6; ++r) { acc[2 * r] = ac[r].x; acc[2 * r + 1] = ac[r].y; }
        float* mp = WSP(float, WS_MODP) + ((size_t)(l * 4 + ks) * 12) * 12288 + n;
#pragma unroll
        for (int r = 0; r < 12; ++r) mp[(size_t)r * 12288] = acc[r];
    }
    __syncthreads();
}

__device__ __forceinline__ void p0b_modreduce(Ctx& C) {
    KA_FRESH(C);
    const int gt = C.bid * NTHR + C.tid, NGT = C.G * NTHR;
    const float* mp = WSP(float, WS_MODP); float* md = WSP(float, WS_MOD);
    for (int e = gt; e < 2 * 12 * 12288; e += NGT) {
        const int l = e / (12 * 12288), rem = e % (12 * 12288), n = rem % 12288;
        float s = C.in(13)[l * 12288 + n];
#pragma unroll
        for (int ks = 0; ks < 4; ++ks) s += mp[(size_t)(l * 4 + ks) * 12 * 12288 + rem];
        md[e] = s;
    }
}

__device__ __forceinline__ void store_h_row(bf16* hrow, const f32x4 (&v)[8], float rs, const float* g, const float* scale, const float* shift, int lane) {
#pragma unroll
    for (int j = 0; j < 8; ++j) { const int e = 4 * lane + 256 * j;
        const f32x4 gg = *(const f32x4*)(g + e), sc = *(const f32x4*)(scale + e), sh = *(const f32x4*)(shift + e);
        const float a = v[j].x * rs * gg.x * (1.f + sc.x) + sh.x, b = v[j].y * rs * gg.y * (1.f + sc.y) + sh.y;
        const float c = v[j].z * rs * gg.z * (1.f + sc.z) + sh.z, d = v[j].w * rs * gg.w * (1.f + sc.w) + sh.w;
        v2u o; o.x = cvtpk(a, b); o.y = cvtpk(c, d); *(GAS v2u*)(hrow + e) = o; }
}
__device__ __forceinline__ int row_seq(int row) { return row < MP ? (row >> 11) : 4 + ((row - MP) >> 3); }

__device__ __forceinline__ void phase_n1(Ctx& C) {
    KA_FRESH(C);
    const int gw = C.bid * NWAVES + C.wave, NGW = C.G * NWAVES;
    f32x4 nx[8];
    if (gw < MR) { const float* xr = gw < MP ? C.in(0) + (size_t)gw * DM : C.in(1) + (size_t)(gw - MP) * DM;
#pragma unroll
        for (int j = 0; j < 8; ++j) nx[j] = *(const f32x4*)(xr + 4 * C.lane + 256 * j); }
    for (int row = gw; row < MR; row += NGW) {
        f32x4 v[8]; float ss = 0.f;
#pragma unroll
        for (int j = 0; j < 8; ++j) { v[j] = nx[j]; ss += v[j].x * v[j].x + v[j].y * v[j].y + v[j].z * v[j].z + v[j].w * v[j].w; }
        asm volatile("" ::: "memory");
        { const int nrow = row + NGW; if (nrow < MR) { const float* xr = nrow < MP ? C.in(0) + (size_t)nrow * DM : C.in(1) + (size_t)(nrow - MP) * DM;
#pragma unroll
            for (int j = 0; j < 8; ++j) nx[j] = *(const f32x4*)(xr + 4 * C.lane + 256 * j); } }
        const float rs = rsqrtf(wave_sum(ss) * (1.f / DM) + EPS);
        const float* md = WSP(float, WS_MOD) + (size_t)(0 * 12 + row_seq(row)) * 12288;
        store_h_row(WSP(bf16, WS_H) + (size_t)row * DM, v, rs, C.in(14), md + 1 * DM, md + 0 * DM, C.lane);
    }
}

constexpr size_t WS_X16 = WS_MIXO + 33 * MiB;
template <bool FIRST> struct ResidIn { v2u fp[8]; v2u xp[8]; };
template <> struct ResidIn<true> { v2u fp[8]; f32x4 xp[8]; };
template <bool FIRST>
__device__ __forceinline__ void resid_load(Ctx& C, int row, const bf16* src, const bf16* X16, ResidIn<FIRST>& in) {
#pragma unroll
    for (int j = 0; j < 8; ++j) in.fp[j] = *(const v2u*)(src + (size_t)row * DM + 4 * C.lane + 256 * j);
    if constexpr (FIRST) {
        const float* xin = row < MP ? C.in(0) + (size_t)row * DM : C.in(1) + (size_t)(row - MP) * DM;
#pragma unroll
        for (int j = 0; j < 8; ++j) in.xp[j] = *(const f32x4*)(xin + 4 * C.lane + 256 * j);
    } else {
#pragma unroll
        for (int j = 0; j < 8; ++j) in.xp[j] = *(const v2u*)(X16 + (size_t)row * DM + 4 * C.lane + 256 * j);
    }
}
template <bool FIRST>
__device__ __forceinline__ void resid_rows(Ctx& C, int l, int which, bool dry, int row_lo, int nrows) {
    const bf16* src = WSP(bf16, WS_MIXO);
    bf16* X16 = WSP(bf16, WS_X16);
    const bool last = (l == 1 && which == 1);
    const bool has_h = (which == 0) || (l == 0);
    const int s = row_seq(row_lo);
    const float* md = WSP(float, WS_MOD) + (size_t)(l * 12 + s) * 12288;
    f32x4 gg[8]; v2u hsp[8], hbp[8];
    {
        const float* gate = md + (which == 0 ? 2 : 5) * DM;
        const float* gpost = (which == 0 ? C.in(15) : C.in(17)) + l * DM;
        const float* gpre = (which == 0) ? C.in(16) + l * DM : C.in(14) + 1 * DM;
        const float* mdn = (which == 0) ? md : WSP(float, WS_MOD) + (size_t)(1 * 12 + s) * 12288;
        const float* scale = mdn + (which == 0 ? 4 : 1) * DM; const float* shift = mdn + (which == 0 ? 3 : 0) * DM;
#pragma unroll
        for (int j = 0; j < 8; ++j) { const int e = 4 * C.lane + 256 * j;
            gg[j] = *(const f32x4*)(gate + e) * *(const f32x4*)(gpost + e);
            if (has_h) { const f32x4 a = *(const f32x4*)(gpre + e) * (*(const f32x4*)(scale + e) + 1.0f), b = *(const f32x4*)(shift + e);
                hsp[j].x = cvtpk(a.x, a.y); hsp[j].y = cvtpk(a.z, a.w); hbp[j].x = cvtpk(b.x, b.y); hbp[j].y = cvtpk(b.z, b.w); } else { hsp[j] = (v2u){0u, 0u}; hbp[j] = hsp[j]; } }
    }
    ResidIn<FIRST> in;
    resid_load<FIRST>(C, row_lo, src, X16, in);
    bf16* Ho = dry ? WSP(bf16, WS_GV) : WSP(bf16, WS_H);
#pragma unroll 1
    for (int r = 0; r < nrows; ++r) {
        const int row = row_lo + r;
        f32x4 f[8], xv[8]; float ss = 0.f;
#pragma unroll
        for (int j = 0; j < 8; ++j) { f[j].x = bflo(in.fp[j].x); f[j].y = bfhi(in.fp[j].x); f[j].z = bflo(in.fp[j].y); f[j].w = bfhi(in.fp[j].y);
            if constexpr (FIRST) xv[j] = in.xp[j]; else { xv[j].x = bflo(in.xp[j].x); xv[j].y = bfhi(in.xp[j].x); xv[j].z = bflo(in.xp[j].y); xv[j].w = bfhi(in.xp[j].y); } }
        asm volatile("" ::: "memory");
        if constexpr (!FIRST) { if (r + 1 < nrows) resid_load<FIRST>(C, row + 1, src, X16, in); }
#pragma unroll
        for (int j = 0; j < 8; ++j) ss += f[j].x * f[j].x + f[j].y * f[j].y + f[j].z * f[j].z + f[j].w * f[j].w;
        const float rs = rsqrtf(wave_sum(ss) * (1.f / DM) + EPS);
        float ss2 = 0.f;
#pragma unroll
        for (int j = 0; j < 8; ++j) { const int e = 4 * C.lane + 256 * j;
            const f32x4 o = xv[j] + (f[j] * gg[j]) * rs;
            if (!dry) { if (last) *(f32x4*)(OUTB + O_Y + (size_t)row * DM + e) = o; else { v2u w; w.x = cvtpk(o.x, o.y); w.y = cvtpk(o.z, o.w); *(GAS v2u*)(X16 + (size_t)row * DM + e) = w; } }
            f[j] = o; ss2 += o.x * o.x + o.y * o.y + o.z * o.z + o.w * o.w; }
        if (has_h) {
            const float rs2 = rsqrtf(wave_sum(ss2) * (1.f / DM) + EPS);
#pragma unroll
            for (int j = 0; j < 8; ++j) { const int e = 4 * C.lane + 256 * j; const f32x4 hs = {bflo(hsp[j].x), bfhi(hsp[j].x), bflo(hsp[j].y), bfhi(hsp[j].y)}, hb = {bflo(hbp[j].x), bfhi(hbp[j].x), bflo(hbp[j].y), bfhi(hbp[j].y)};
                const f32x4 h = (f[j] * rs2) * hs + hb;
                v2u o; o.x = cvtpk(h.x, h.y); o.y = cvtpk(h.z, h.w); *(GAS v2u*)(Ho + (size_t)row * DM + e) = o; }
        }
        if constexpr (FIRST) { if (r + 1 < nrows) resid_load<FIRST>(C, row + 1, src, X16, in); }
    }
}
template <bool FIRST>
__device__ __forceinline__ void phase_resid_t(Ctx& C, int l, int which, bool dry) {
    KA_FRESH(C);
    const int gw = C.bid * NWAVES + C.wave, NGW = C.G * NWAVES;
#pragma unroll 1
    for (int r0 = 4 * gw; r0 < MP; r0 += 4 * NGW) resid_rows<FIRST>(C, l, which, dry, r0, 4);
    if (gw < MS) resid_rows<FIRST>(C, l, which, dry, MP + gw, 1);
}
__device__ __forceinline__ void phase_resid(Ctx& C, int l, int which, bool dry = false) {
    if (l == 0 && which == 0) phase_resid_t<true>(C, l, which, dry); else phase_resid_t<false>(C, l, which, dry);
}

struct EpiIn {
    static constexpr bool PERM = true, AFTER_DRAIN = false;
    bf16* P; float* out; int layer;
    __device__ __forceinline__ void operator()(const pg8::f32x4 (&acc)[2][2][4][2], const pg8::Unit& u, int wr, int wc, int fr, int fq) const {
        const int pn = u.pn; const int row0 = u.pm * 256 + wr * 64 + fr; const int col0 = pn * 256 + wc * 32 + 8 * fq;
        const float sc = (pn == 4 || pn == 5) ? QSCALE : 1.f;
        const bool kv = (pn >= 6 && pn <= 9); const bool isv = pn >= 8; const int cbase = isv ? C_V : C_K;
#pragma unroll
        for (int ai = 0; ai < 2; ++ai)
#pragma unroll
            for (int m = 0; m < 4; ++m) { const int row = row0 + ai * 128 + m * 16;
#pragma unroll
                for (int bj = 0; bj < 2; ++bj) { const int col = col0 + bj * 128;
                    const pg8::f32x4 v0 = acc[ai][bj][m][0] * sc, v1 = acc[ai][bj][m][1] * sc;
                    v4u w; w.x = cvtpk(v0[0], v0[1]); w.y = cvtpk(v0[2], v0[3]); w.z = cvtpk(v1[0], v1[1]); w.w = cvtpk(v1[2], v1[3]);
                    *(GAS v4u*)(P + (size_t)row * PP + col) = w;
                    if (kv && row < MR) {
                        float* o = (row < MP) ? out + (isv ? O_VP : O_KP) + (size_t)layer * 4194304 + (size_t)row * 512 + (col - cbase)
                                              : out + (isv ? O_VS : O_KS) + (size_t)layer * 32768 + (size_t)(row - MP) * 512 + (col - cbase);
                        *(pg8::f32x4*)o = v0; *(pg8::f32x4*)(o + 4) = v1; }
                } }
    }
};
struct EpiBf {
    static constexpr bool PERM = true, AFTER_DRAIN = false;
    bf16* O; int ldc;
    __device__ __forceinline__ void operator()(const pg8::f32x4 (&acc)[2][2][4][2], const pg8::Unit& u, int wr, int wc, int fr, int fq) const {
        const int row0 = u.pm * 256 + wr * 64 + fr; const int col0 = u.pn * 256 + wc * 32 + 8 * fq;
#pragma unroll
        for (int ai = 0; ai < 2; ++ai)
#pragma unroll
            for (int m = 0; m < 4; ++m) { const int row = row0 + ai * 128 + m * 16;
#pragma unroll
                for (int bj = 0; bj < 2; ++bj) { const int col = col0 + bj * 128;
                    const pg8::f32x4 v0 = acc[ai][bj][m][0], v1 = acc[ai][bj][m][1];
                    v4u w; w.x = cvtpk(v0[0], v0[1]); w.y = cvtpk(v0[2], v0[3]); w.z = cvtpk(v1[0], v1[1]); w.w = cvtpk(v1[2], v1[3]);
                    *(GAS v4u*)(O + (size_t)row * ldc + col) = w; } }
    }
};
struct EpiF32 {
    static constexpr bool PERM = true, AFTER_DRAIN = false;
    float* O; int ldc;
    __device__ __forceinline__ void operator()(const pg8::f32x4 (&acc)[2][2][4][2], const pg8::Unit& u, int wr, int wc, int fr, int fq) const {
        const int row0 = u.pm * 256 + wr * 64 + fr; const int col0 = u.pn * 256 + wc * 32 + 8 * fq;
#pragma unroll
        for (int ai = 0; ai < 2; ++ai)
#pragma unroll
            for (int m = 0; m < 4; ++m) { const int row = row0 + ai * 128 + m * 16;
#pragma unroll
                for (int bj = 0; bj < 2; ++bj) { float* o = O + (size_t)row * ldc + col0 + bj * 128;
                    *(pg8::f32x4*)o = acc[ai][bj][m][0]; *(pg8::f32x4*)(o + 4) = acc[ai][bj][m][1]; } }
    }
};

struct EpiAct {
    static constexpr bool PERM = true, AFTER_DRAIN = false;
    bf16* ACT; float* tailg; float* headg; float* headv; const float* cw; const float* cb;
    __device__ __forceinline__ void operator()(const pg8::f32x4 (&acc)[2][2][4][2], const pg8::Unit& u, int wr, int wc, int fr, int fq) const {
        const int j0 = u.pn * 128 + wc * 32 + 8 * fq;
        float w0[8], w1[8], w2[8], bb[8];
#pragma unroll
        for (int h = 0; h < 2; ++h) { const f32x4 a = *(const f32x4*)(cw + j0 + 4 * h), b = *(const f32x4*)(cw + DFF + j0 + 4 * h), c = *(const f32x4*)(cw + 2 * DFF + j0 + 4 * h), d = *(const f32x4*)(cb + j0 + 4 * h);
#pragma unroll
            for (int e = 0; e < 4; ++e) { w0[4 * h + e] = a[e]; w1[4 * h + e] = b[e]; w2[4 * h + e] = c[e]; bb[4 * h + e] = d[e]; } }
#pragma unroll
        for (int ai = 0; ai < 2; ++ai) {
            const int rbase = u.pm * 256 + ai * 128 + wr * 64; const int rb = rbase >> 6;
#pragma unroll
            for (int m = 0; m < 4; ++m) {
                const int row = rbase + 16 * m + fr;
                float o[8];
#pragma unroll
                for (int e = 0; e < 8; ++e) {
                    const float g = acc[ai][0][m][e >> 2][e & 3], v = acc[ai][1][m][e >> 2][e & 3];
                    const float gp = (m > 0) ? acc[ai][0][m > 0 ? m - 1 : 0][e >> 2][e & 3] : 0.f;
                    const float p1 = dppf<0x121>(g), p2 = dppf<0x122>(g), q1 = dppf<0x121>(gp), q2 = dppf<0x122>(gp);
                    const float g1 = fr >= 1 ? p1 : q1, g2 = fr >= 2 ? p2 : q2;
                    const float y = bb[e] + w0[e] * g2 + w1[e] * g1 + w2[e] * g;
                    o[e] = siluf_(y) * v;
                }
                if (m > 0 || fr >= 2) { v4u w; w.x = cvtpk(o[0], o[1]); w.y = cvtpk(o[2], o[3]); w.z = cvtpk(o[4], o[5]); w.w = cvtpk(o[6], o[7]); *(GAS v4u*)(ACT + (size_t)row * DFF + j0) = w; }
                if (m == 0 && fr < 2) { float* hg = headg + (size_t)(rb * 2 + fr) * DFF + j0; float* hv = headv + (size_t)(rb * 2 + fr) * DFF + j0;
                    *(pg8::f32x4*)hg = acc[ai][0][0][0]; *(pg8::f32x4*)(hg + 4) = acc[ai][0][0][1]; *(pg8::f32x4*)hv = acc[ai][1][0][0]; *(pg8::f32x4*)(hv + 4) = acc[ai][1][0][1]; }
                if (m == 3 && fr >= 14) { float* tg = tailg + (size_t)(rb * 2 + (fr - 14)) * DFF + j0; *(pg8::f32x4*)tg = acc[ai][0][3][0]; *(pg8::f32x4*)(tg + 4) = acc[ai][0][3][1]; }
            }
        }
    }
};

template <int MODE>
__device__ __forceinline__ void sample_gemm_unit(Ctx& C, const bf16* A  , const bf16* Bt  , int K, int n0, int layer) {
    const int lane = C.lane, m = lane & 31, kh = lane >> 5, wave = C.wave;
    const int kw = K >> 3;
    const bf16* a0 = A + (size_t)m * K + wave * kw + 8 * kh; const bf16* a1 = a0 + (size_t)32 * K;
    const bf16* b0 = Bt + (size_t)(n0 + m) * K + wave * kw + 8 * kh;
    f32x16 acc0, acc1;
#pragma unroll
    for (int r = 0; r < 16; ++r) { acc0[r] = 0.f; acc1[r] = 0.f; }
#pragma unroll 1
    for (int k = 0; k < kw; k += 256) {
        bf16x8 fa0[16], fa1[16], fb[16];
#pragma unroll
        for (int s = 0; s < 16; ++s) { const bool ok = k + 16 * s < kw; const int ko = ok ? k + 16 * s : 0;
            fa0[s] = *(const bf16x8*)(a0 + ko); fa1[s] = *(const bf16x8*)(a1 + ko); fb[s] = *(const bf16x8*)(b0 + ko);
            if (!ok) { fb[s] = (bf16x8){0, 0, 0, 0, 0, 0, 0, 0}; } }
#pragma unroll
        for (int s = 0; s < 16; ++s) { acc0 = __builtin_amdgcn_mfma_f32_32x32x16_bf16(fa0[s], fb[s], acc0, 0, 0, 0); acc1 = __builtin_amdgcn_mfma_f32_32x32x16_bf16(fa1[s], fb[s], acc1, 0, 0, 0); }
    }
    LAS float* red = (LAS float*)C.lds;
#pragma unroll
    for (int r = 0; r < 16; ++r) { red[(wave * 64 + crow(r, kh)) * 32 + m] = acc0[r]; red[(wave * 64 + 32 + crow(r, kh)) * 32 + m] = acc1[r]; }
    __syncthreads();
    const int row = C.tid >> 3, c4 = (C.tid & 7) * 4;
    f32x4 v = {0.f, 0.f, 0.f, 0.f};
#pragma unroll
    for (int w = 0; w < 8; ++w) { const f32x4 t = *(const LAS f32x4*)(red + (w * 64 + row) * 32 + c4); v += t; }
    const int n = n0 + c4; const int grow = MP + row;
    if (MODE == 0) {
        if (n >= C_Q && n < C_K) v *= QSCALE;
        v2u o; o.x = cvtpk(v.x, v.y); o.y = cvtpk(v.z, v.w);
        *(GAS v2u*)(WSP(bf16, WS_PROJ) + (size_t)grow * PP + n) = o;
        if (n >= C_K && n < C_GQ) { const bool isv = n >= C_V; float* op = OUTB + (isv ? O_VS : O_KS) + (size_t)layer * 32768 + (size_t)row * 512 + (n - (isv ? C_V : C_K)); *(f32x4*)op = v; }
    } else if (MODE == 1) {
        v2u o; o.x = cvtpk(v.x, v.y); o.y = cvtpk(v.z, v.w);
        *(GAS v2u*)(WSP(bf16, WS_MIXO) + (size_t)grow * DM + n) = o;
    } else {
        v2u o; o.x = cvtpk(v.x, v.y); o.y = cvtpk(v.z, v.w);
        *(GAS v2u*)(WSP(bf16, WS_GV) + (size_t)grow * DUP + n) = o;
    }
    __syncthreads();
}

__device__ __forceinline__ void lru_unit(Ctx& C, int l, int u) {
    KA_FRESH(C);
    int seq, t0, nt, T;
    if (u < 256) { seq = u >> 6; t0 = (u & 63) * 32; nt = 32; T = 2048; } else { seq = 4 + (u - 256); t0 = 0; nt = 8; T = 8; }
    const int d = C.tid, n = C.wave, dd = d & 63;
    const int row0 = seq_row0(seq);
    const bf16* P = WSP(bf16, WS_PROJ);
    LAS float* xs = (LAS float*)C.lds;
    const float cw0 = C.in(19)[(l * 4 + 0) * 512 + d], cw1 = C.in(19)[(l * 4 + 1) * 512 + d], cw2 = C.in(19)[(l * 4 + 2) * 512 + d], cw3 = C.in(19)[(l * 4 + 3) * 512 + d];
    const float cb = C.in(20)[l * 512 + d];
    float xm3, xm2, xm1;
    {
        float pre[3];
#pragma unroll
        for (int i = 0; i < 3; ++i) { const int tt = t0 - 3 + i;
            if (tt >= 0) pre[i] = bf2f(P[(size_t)(row0 + tt) * PP + C_AX + d]);
            else if (seq >= 4) pre[i] = C.in(7)[((size_t)(l * 8 + (seq - 4)) * 3 + (tt + 3)) * 512 + d];
            else pre[i] = 0.f; }
        xm3 = pre[0]; xm2 = pre[1]; xm1 = pre[2];
    }
    {
        float xv[32];
#pragma unroll
        for (int t = 0; t < 32; ++t) xv[t] = (t < nt) ? bf2f(P[(size_t)(row0 + t0 + t) * PP + C_AX + d]) : 0.f;
#pragma unroll
        for (int t = 0; t < 32; ++t) if (t < nt) {
            const float xt = xv[t];
            xs[t * 512 + d] = cb + cw0 * xm3 + cw1 * xm2 + cw2 * xm1 + cw3 * xt;
            xm3 = xm2; xm2 = xm1; xm1 = xt;
        }
    }
    if (t0 + nt == T) {
        float* o = (seq < 4) ? OUTB + O_LCP + (size_t)(l * 4 + seq) * 3 * 512 : OUTB + O_LCS + (size_t)(l * 8 + (seq - 4)) * 3 * 512;
        o[0 * 512 + d] = xm3; o[1 * 512 + d] = xm2; o[2 * 512 + d] = xm1;
    }
    const float br = C.in(22)[l * 512 + d], bi = C.in(24)[l * 512 + d];
    const float lam = C.in(25)[l * 512 + d];
    float L8L2 = -8.0f * softplusf_(-lam) * LOG2E;
    asm volatile("" : "+v"(L8L2) :: "memory");
    typedef float f2v __attribute__((ext_vector_type(2)));
    f2v wri[64];
    {
        const float* pr = C.in(21) + ((size_t)(l * 8 + n) * 64) * 64 + dd;
        const float* pi = C.in(23) + ((size_t)(l * 8 + n) * 64) * 64 + dd;
#pragma unroll
        for (int c = 0; c < 64; ++c) { wri[c].x = pr[c * 64]; wri[c].y = pi[c * 64]; }
    }
    __syncthreads();
    float h = 0.f, ap = 1.f;
    float* HL = WSP(float, WS_LH); float* AL = WSP(float, WS_LA);
    for (int t = 0; t < nt; ++t) {
        f2v a0 = {br, bi}, a1 = {0.f, 0.f};
        const LAS f32x4* xv = (const LAS f32x4*)(xs + t * 512 + n * 64);
#pragma unroll
        for (int c4 = 0; c4 < 16; ++c4) { const f32x4 v = xv[c4];
            a0 = __builtin_elementwise_fma((f2v){v.x, v.x}, wri[4 * c4], a0); a1 = __builtin_elementwise_fma((f2v){v.y, v.y}, wri[4 * c4 + 1], a1);
            a0 = __builtin_elementwise_fma((f2v){v.z, v.z}, wri[4 * c4 + 2], a0); a1 = __builtin_elementwise_fma((f2v){v.w, v.w}, wri[4 * c4 + 3], a1); }
        const float ar = a0.x + a1.x, ai = a0.y + a1.y;
        const float xc = xs[t * 512 + d];
        const float r = __builtin_amdgcn_rcpf(1.0f + __builtin_amdgcn_exp2f(-LOG2E * ar)), ig = __builtin_amdgcn_rcpf(1.0f + __builtin_amdgcn_exp2f(-LOG2E * ai));
        const float a = __builtin_amdgcn_exp2f(r * L8L2);
        const float uu = __builtin_amdgcn_sqrtf(fmaxf(1.0f - a * a, 0.f)) * (ig * xc);
        h = a * h + uu; ap *= a;
        const size_t off = (size_t)(row0 + t0 + t) * 512 + d;
        HL[off] = h; AL[off] = ap;
    }
    __syncthreads();
}

constexpr int GH_Q = 0, GH_K = 18224, GH_V = 36448, GH_L = 54672, GH_S = 72080, GH_BYTES = 73104;
static_assert(2 * GH_BYTES <= LDS_MISC, "gdn prep LDS");

__device__ __forceinline__ void gdn_prep_unit(Ctx& C, int l, int u) {
    KA_FRESH(C);
    int seq, chunk, hp, T;
    if (u < 512) { seq = u >> 7; chunk = (u >> 2) & 31; hp = u & 3; T = 2048; } else { const int v = u - 512; seq = 4 + (v >> 2); chunk = 0; hp = v & 3; T = 8; }
    const int hb = C.tid >> 8, ht = C.tid & 255, lane = C.lane;
    const int head = 2 * hp + hb;
    const int cid = (seq < 4) ? ((seq * 8 + head) * 32 + chunk) : (1024 + (seq - 4) * 8 + head);
    const int srow0 = seq_row0(seq);
    const int row0 = srow0 + chunk * 64;
    const int nvalid = (T - chunk * 64) < 64 ? (T - chunk * 64) : 64;
    const bf16* P = WSP(bf16, WS_PROJ);
    LAS unsigned char* hl = C.lds + hb * GH_BYTES;
    LAS bf16* Kimg = (LAS bf16*)(hl + GH_K); LAS bf16* Qimg = (LAS bf16*)(hl + GH_Q); LAS bf16* Vimg = (LAS bf16*)(hl + GH_V);
    LAS float* Lm = (LAS float*)(hl + GH_L);
    LAS float* s_gc = (LAS float*)(hl + GH_S); LAS float* s_beta = s_gc + 64; LAS float* s_eg = s_gc + 128;
    if (ht < 64) {
        const int t = ht; const bool valid = t < nvalid;
        float beta = 0.f, g = 0.f;
        if (valid) { const float cbv = bf2f(P[(size_t)(row0 + t) * PP + C_B + head]), cav = bf2f(P[(size_t)(row0 + t) * PP + C_A + head]);
            beta = sigmoidf_(cbv); g = -__expf(C.in(30)[l * 8 + head]) * softplusf_(cav + C.in(31)[l * 8 + head]); }
#pragma unroll
        for (int off = 1; off < 64; off <<= 1) { const float v = __shfl_up(g, off); if (lane >= off) g += v; }
        s_gc[t] = g; s_beta[t] = beta; s_eg[t] = __expf(g);
    }
    __syncthreads();
    const float gl = s_gc[63];
    {
        LAS float* wgt = (LAS float*)(hl + GH_L);
        {
            v4u xs[13];
#pragma unroll
            for (int i = 0; i < 13; ++i) {
                const int idx = ht + 256 * i; const int r = idx / 48, chn = idx % 48, part = chn >> 4, col = (chn & 15) * 8;
                const int tt = chunk * 64 - 3 + r;
                v4u x = {0u, 0u, 0u, 0u};
                if (idx < 67 * 48) {
                    if (tt >= 0) x = *(const v4u*)(P + (size_t)(srow0 + tt) * PP + C_GQ + part * 1024 + head * 128 + col);
                    else if (seq >= 4) { const float* bp = C.in(9) + ((size_t)(l * 8 + (seq - 4)) * 3 + (tt + 3)) * 3072 + part * 1024 + head * 128 + col;
                        x.x = cvtpk(bp[0], bp[1]); x.y = cvtpk(bp[2], bp[3]); x.z = cvtpk(bp[4], bp[5]); x.w = cvtpk(bp[6], bp[7]); }
                }
                xs[i] = x;
            }
#pragma unroll
            for (int i = 0; i < 13; ++i) {
                const int idx = ht + 256 * i; const int r = idx / 48, chn = idx % 48, part = chn >> 4, col = (chn & 15) * 8;
                if (idx < 67 * 48) *(LAS v4u*)((LAS bf16*)(hl + part * 18224) + r * 136 + col) = xs[i];
            }
        }
        for (int e = ht; e < 4 * 384; e += 256) { const int i = e / 384, cc = e % 384; wgt[e] = C.in(29)[(size_t)(l * 4 + i) * 3072 + (cc >> 7) * 1024 + head * 128 + (cc & 127)]; }
        __syncthreads();
        const int t = ht >> 2, cgp = ht & 3; const bool valid = t < nvalid;
#pragma unroll 1
        for (int part = 0; part < 3; ++part) {
            LAS bf16* reg = (LAS bf16*)(hl + part * 18224);
            float acc[32];
#pragma unroll
            for (int c = 0; c < 32; ++c) acc[c] = 0.f;
#pragma unroll
            for (int i = 0; i < 4; ++i) {
                const LAS v4u* rp = (const LAS v4u*)(reg + (t + i) * 136 + cgp * 32);
                const LAS f32x4* wp = (const LAS f32x4*)(wgt + i * 384 + part * 128 + cgp * 32);
#pragma unroll
                for (int q4 = 0; q4 < 4; ++q4) { const v4u x = rp[q4]; const f32x4 w0 = wp[2 * q4], w1 = wp[2 * q4 + 1];
                    acc[8 * q4 + 0] += w0.x * bflo(x.x); acc[8 * q4 + 1] += w0.y * bfhi(x.x); acc[8 * q4 + 2] += w0.z * bflo(x.y); acc[8 * q4 + 3] += w0.w * bfhi(x.y);
                    acc[8 * q4 + 4] += w1.x * bflo(x.z); acc[8 * q4 + 5] += w1.y * bfhi(x.z); acc[8 * q4 + 6] += w1.z * bflo(x.w); acc[8 * q4 + 7] += w1.w * bfhi(x.w); }
            }
            float ss = 0.f;
#pragma unroll
            for (int c = 0; c < 32; ++c) { const float v = valid ? siluf_(acc[c]) : 0.f; acc[c] = v; ss += v * v; }
            float scl = 1.f;
            if (part < 2) { ss += __shfl_xor(ss, 1); ss += __shfl_xor(ss, 2); scl = rsqrtf(ss + EPS); if (part == 0) scl *= 0.08838834764831845f; }
            v4u outp[4];
#pragma unroll
            for (int q4 = 0; q4 < 4; ++q4) {
                outp[q4].x = cvtpk(acc[8 * q4 + 0] * scl, acc[8 * q4 + 1] * scl); outp[q4].y = cvtpk(acc[8 * q4 + 2] * scl, acc[8 * q4 + 3] * scl);
                outp[q4].z = cvtpk(acc[8 * q4 + 4] * scl, acc[8 * q4 + 5] * scl); outp[q4].w = cvtpk(acc[8 * q4 + 6] * scl, acc[8 * q4 + 7] * scl); }
            __syncthreads();
#pragma unroll
            for (int q4 = 0; q4 < 4; ++q4) *(LAS v4u*)(reg + t * 136 + cgp * 32 + 8 * q4) = outp[q4];
        }
        if (chunk * 64 + 64 >= T) {
            float* o = (seq < 4) ? OUTB + O_GCP + (size_t)(l * 4 + seq) * 3 * 3072 : OUTB + O_GCS + (size_t)(l * 8 + (seq - 4)) * 3 * 3072;
            for (int e = ht; e < 3 * 384; e += 256) { const int i = e / 384, cc = e % 384, part = cc >> 7, c = cc & 127; const int col = part * 1024 + head * 128 + c;
                o[i * 3072 + col] = bf2f(P[(size_t)(srow0 + T - 3 + i) * PP + C_GQ + col]); }
        }
    }
    __syncthreads();
    {
        v4u* QEf = WSP(v4u, WS_QEF) + (size_t)cid * 1024; v4u* KDf = WSP(v4u, WS_KDF) + (size_t)cid * 1024;
#pragma unroll 1
        for (int f = 0; f < 4; ++f) {
            const int task = ht + 256 * f, frag = task >> 6, ln = task & 63, h = ln >> 5;
            {
                const int ti = frag >> 3, ks = frag & 7, tok = 32 * ti + (ln & 31), dkb = 32 * (ks >> 1) + 16 * (ks & 1) + 4 * h;
                const float sc = s_eg[tok];
                const v2u a = *(const LAS v2u*)(Qimg + tok * 136 + dkb), b = *(const LAS v2u*)(Qimg + tok * 136 + dkb + 8);
                v4u o; o.x = cvtpk(bflo(a.x) * sc, bfhi(a.x) * sc); o.y = cvtpk(bflo(a.y) * sc, bfhi(a.y) * sc); o.z = cvtpk(bflo(b.x) * sc, bfhi(b.x) * sc); o.w = cvtpk(bflo(b.y) * sc, bfhi(b.y) * sc);
                QEf[frag * 64 + ln] = o;
            }
            {
                const int dt = frag >> 2, ks2 = frag & 3, dk = 32 * dt + (ln & 31), tb = 32 * (ks2 >> 1) + 16 * (ks2 & 1) + 4 * h;
                float v[8];
#pragma unroll
                for (int j = 0; j < 8; ++j) { const int tok = tb + 8 * (j >> 2) + (j & 3); v[j] = bf2f(Kimg[tok * 136 + dk]) * __expf(gl - s_gc[tok]); }
                v4u o; o.x = cvtpk(v[0], v[1]); o.y = cvtpk(v[2], v[3]); o.z = cvtpk(v[4], v[5]); o.w = cvtpk(v[6], v[7]);
                KDf[frag * 64 + ln] = o;
            }
        }
    }
    {
        const int wv = ht >> 6, tj = wv >> 1, ti = wv & 1, m = lane & 31, kh = lane >> 5;
        f32x16 akk, aqk;
#pragma unroll
        for (int r = 0; r < 16; ++r) { akk[r] = 0.f; aqk[r] = 0.f; }
#pragma unroll
        for (int ks = 0; ks < 8; ++ks) {
            const bf16x8 a = *(const LAS bf16x8*)(Kimg + (32 * tj + m) * 136 + 16 * ks + 8 * kh);
            const bf16x8 bk = *(const LAS bf16x8*)(Kimg + (32 * ti + m) * 136 + 16 * ks + 8 * kh);
            const bf16x8 bq = *(const LAS bf16x8*)(Qimg + (32 * ti + m) * 136 + 16 * ks + 8 * kh);
            akk = __builtin_amdgcn_mfma_f32_32x32x16_bf16(a, bk, akk, 0, 0, 0);
            aqk = __builtin_amdgcn_mfma_f32_32x32x16_bf16(a, bq, aqk, 0, 0, 0);
        }
        const int i = 32 * ti + m; const float gci = s_gc[i], bi = s_beta[i];
        float lv[16], qv[16];
#pragma unroll
        for (int r = 0; r < 16; ++r) { const int j = 32 * tj + crow(r, kh); const float dec = __expf(fminf(gci - s_gc[j], 0.f));
            lv[r] = (i > j) ? bi * akk[r] * dec : 0.f; qv[r] = (i >= j) ? aqk[r] * dec : 0.f; }
#pragma unroll
        for (int rq = 0; rq < 4; ++rq) { f32x4 o; o.x = lv[4 * rq]; o.y = lv[4 * rq + 1]; o.z = lv[4 * rq + 2]; o.w = lv[4 * rq + 3];
            *(LAS f32x4*)(Lm + i * 68 + 32 * tj + 8 * rq + 4 * kh) = o; }
        v4u* QKf = WSP(v4u, WS_QKF) + (size_t)cid * 512;
#pragma unroll
        for (int s = 0; s < 2; ++s) { v4u o; o.x = cvtpk(qv[8 * s + 0], qv[8 * s + 1]); o.y = cvtpk(qv[8 * s + 2], qv[8 * s + 3]); o.z = cvtpk(qv[8 * s + 4], qv[8 * s + 5]); o.w = cvtpk(qv[8 * s + 6], qv[8 * s + 7]);
            QKf[(ti * 4 + 2 * tj + s) * 64 + lane] = o; }
    }
    __syncthreads();
    {
        const int c = ht;
        float sol[64];
#pragma unroll 1
        for (int r12 = 0; r12 < REPN(12); ++r12) {
        if (c < 128) {
#pragma unroll
            for (int i = 0; i < 64; ++i) sol[i] = bf2f(Vimg[i * 136 + c]) * s_beta[i];
        } else {
#pragma unroll
            for (int i = 0; i < 64; ++i) sol[i] = bf2f(Kimg[i * 136 + (c - 128)]) * (s_beta[i] * s_eg[i]);
        }
#pragma unroll
        for (int i = 1; i < 64; ++i) {
            float s = sol[i];
#pragma unroll
            for (int j4 = 0; j4 <= ((i - 1) >> 2); ++j4) { const f32x4 Lv = *(const LAS f32x4*)(Lm + i * 68 + 4 * j4);
                s -= Lv.x * sol[4 * j4]; if (4 * j4 + 1 < i) s -= Lv.y * sol[4 * j4 + 1]; if (4 * j4 + 2 < i) s -= Lv.z * sol[4 * j4 + 2]; if (4 * j4 + 3 < i) s -= Lv.w * sol[4 * j4 + 3]; }
            sol[i] = s;
        }
        }
        __syncthreads();
        if (c < 128) {
            const int ds = c >> 5, col = c & 31;
            bf16* Uf = WSP(bf16, WS_UF) + (size_t)cid * 8192;
#pragma unroll
            for (int a = 0; a < 8; ++a)
#pragma unroll
                for (int hi = 0; hi < 2; ++hi) { const int ti = a >> 2; v2u o; o.x = cvtpk(sol[8 * a + 4 * hi], sol[8 * a + 4 * hi + 1]); o.y = cvtpk(sol[8 * a + 4 * hi + 2], sol[8 * a + 4 * hi + 3]);
                    *(GAS v2u*)(Uf + ((size_t)((ds * 2 + ti) * 64 + col + 32 * hi)) * 16 + 4 * (a & 3)) = o; }
        } else {
            const int dk = c - 128;
#pragma unroll
            for (int i = 0; i < 64; ++i) Qimg[i * 136 + dk] = f2bf(-sol[i]);
        }
        if (ht == 0) WSP(float, WS_GL)[cid] = __expf(gl);
    }
    __syncthreads();
    {
        v4u* Wf = WSP(v4u, WS_WF) + (size_t)cid * 1024;
#pragma unroll 1
        for (int f = 0; f < 4; ++f) {
            const int task = ht + 256 * f, frag = task >> 6, ln = task & 63, h = ln >> 5;
            const int ti = frag >> 3, ks = frag & 7, tok = 32 * ti + (ln & 31), dkb = 32 * (ks >> 1) + 16 * (ks & 1) + 4 * h;
            const v2u a = *(const LAS v2u*)(Qimg + tok * 136 + dkb), b = *(const LAS v2u*)(Qimg + tok * 136 + dkb + 8);
            v4u o; o.x = a.x; o.y = a.y; o.z = b.x; o.w = b.y;
            Wf[frag * 64 + ln] = o;
        }
    }
    __syncthreads();
}

__device__ __forceinline__ void phase_act(Ctx& C, int l) {
    KA_FRESH(C);
    const bf16* GV = WSP(bf16, WS_GV); bf16* ACT = WSP(bf16, WS_ACT);
    const long gt = (long)C.bid * NTHR + C.tid, NGT = (long)C.G * NTHR;
    const float* cw = C.in(35) + (size_t)l * 3 * DFF; const float* cb = C.in(36) + (size_t)l * DFF;
    for (long it = gt; it < (long)MS * 704; it += NGT) {
        const int row = MP + (int)(it / 704), grp = (int)(it % 704);
        const int j0 = grp * 8; const int gcol = (j0 >> 7) * 256 + (j0 & 127);
        const int s = row_seq(row); const int t = row - seq_row0(s); const int T = 8;
        float x[3][8];
#pragma unroll
        for (int i = 0; i < 3; ++i) {
            const int tt = t - 2 + i;
            if (tt >= 0) { const v4u g = *(const v4u*)(GV + (size_t)(row - 2 + i) * DUP + gcol);
                x[i][0] = bflo(g.x); x[i][1] = bfhi(g.x); x[i][2] = bflo(g.y); x[i][3] = bfhi(g.y); x[i][4] = bflo(g.z); x[i][5] = bfhi(g.z); x[i][6] = bflo(g.w); x[i][7] = bfhi(g.w);
            } else { const float* bp = C.in(11) + ((size_t)(l * 8 + (s - 4)) * 2 + (tt + 2)) * DFF + j0;
#pragma unroll
                for (int e = 0; e < 8; ++e) x[i][e] = bp[e]; }
        }
        const v4u vv = *(const v4u*)(GV + (size_t)row * DUP + gcol + 128);
        const float val[8] = {bflo(vv.x), bfhi(vv.x), bflo(vv.y), bfhi(vv.y), bflo(vv.z), bfhi(vv.z), bflo(vv.w), bfhi(vv.w)};
        float o[8];
#pragma unroll
        for (int e = 0; e < 8; ++e) { const float y = cb[j0 + e] + cw[0 * DFF + j0 + e] * x[0][e] + cw[1 * DFF + j0 + e] * x[1][e] + cw[2 * DFF + j0 + e] * x[2][e]; o[e] = siluf_(y) * val[e]; }
        v4u w; w.x = cvtpk(o[0], o[1]); w.y = cvtpk(o[2], o[3]); w.z = cvtpk(o[4], o[5]); w.w = cvtpk(o[6], o[7]);
        *(GAS v4u*)(ACT + (size_t)row * DFF + j0) = w;
        if (t >= T - 2) {
            float* fo = OUTB + O_FCS + ((size_t)(l * 8 + (s - 4)) * 2 + (t - (T - 2))) * DFF + j0;
#pragma unroll
            for (int e = 0; e < 8; ++e) fo[e] = x[2][e];
        }
    }
    const float* TG = WSP(float, WS_TAILG); const float* HG = WSP(float, WS_HEADG); const float* HV = WSP(float, WS_HEADV);
    for (long it = gt; it < (long)256 * 704; it += NGT) {
        const int rr = (int)(it / 704), grp = (int)(it % 704), rb = rr >> 1, i = rr & 1, j0 = grp * 8;
        const bool first = (rb & 31) == 0;
        float g2[8], g1[8], g0[8], vv[8];
#pragma unroll
        for (int e = 0; e < 8; ++e) {
            const float t0 = first ? 0.f : TG[(size_t)((rb - 1) * 2 + 0) * DFF + j0 + e], t1 = first ? 0.f : TG[(size_t)((rb - 1) * 2 + 1) * DFF + j0 + e];
            const float h0 = HG[(size_t)(rb * 2 + 0) * DFF + j0 + e], h1 = HG[(size_t)(rb * 2 + 1) * DFF + j0 + e];
            g2[e] = i == 0 ? t0 : t1; g1[e] = i == 0 ? t1 : h0; g0[e] = i == 0 ? h0 : h1; vv[e] = HV[(size_t)(rb * 2 + i) * DFF + j0 + e];
        }
        float o[8];
#pragma unroll
        for (int e = 0; e < 8; ++e) { const float y = cb[j0 + e] + cw[0 * DFF + j0 + e] * g2[e] + cw[1 * DFF + j0 + e] * g1[e] + cw[2 * DFF + j0 + e] * g0[e]; o[e] = siluf_(y) * vv[e]; }
        v4u w; w.x = cvtpk(o[0], o[1]); w.y = cvtpk(o[2], o[3]); w.z = cvtpk(o[4], o[5]); w.w = cvtpk(o[6], o[7]);
        *(GAS v4u*)(ACT + (size_t)(rb * 64 + i) * DFF + j0) = w;
        if ((rb & 31) == 31) {
            float* fo = OUTB + O_FCP + ((size_t)(l * 4 + (rb >> 5)) * 2 + i) * DFF + j0;
#pragma unroll
            for (int e = 0; e < 8; ++e) fo[e] = TG[(size_t)(rb * 2 + i) * DFF + j0 + e];
        }
    }
}

struct FinIn { f32x4 hl[2], al[2]; v4u ag, oatt, og[2], z[2]; };
__device__ __forceinline__ void fin_load(Ctx& C, int row, FinIn& in, int lane) {
    const bf16* P = WSP(bf16, WS_PROJ);
    const float* hl = WSP(float, WS_LH) + (size_t)row * 512 + 8 * lane; const float* al = WSP(float, WS_LA) + (size_t)row * 512 + 8 * lane;
    in.hl[0] = *(const f32x4*)hl; in.hl[1] = *(const f32x4*)(hl + 4); in.al[0] = *(const f32x4*)al; in.al[1] = *(const f32x4*)(al + 4);
    in.ag = *(const v4u*)(P + (size_t)row * PP + C_AG + 8 * lane);
    in.oatt = (row < MP) ? *(const v4u*)(WSP(bf16, WS_OATT) + (size_t)row * 512 + 8 * lane) : (v4u){0u, 0u, 0u, 0u};
    const v4u* op = (const v4u*)(WSP(bf16, WS_OGDN) + (size_t)row * 1024 + 16 * lane); in.og[0] = op[0]; in.og[1] = op[1];
    const v4u* zp = (const v4u*)(P + (size_t)row * PP + C_Z + 16 * lane); in.z[0] = zp[0]; in.z[1] = zp[1];
}
__device__ __forceinline__ void phase_finalize(Ctx& C, int l) {
    KA_FRESH(C);
    const int gw = C.bid * NWAVES + C.wave, NGW = C.G * NWAVES, lane = C.lane;
    bf16* MIX = WSP(bf16, WS_MIX);
    float ga[8], gb[8], gc[16];
    {
        const float* pa = C.in(26) + l * 512 + 8 * lane; const float* pb = C.in(27) + l * 512 + 8 * lane; const float* pc = C.in(32) + l * 128 + ((16 * lane) & 127);
#pragma unroll
        for (int e = 0; e < 8; ++e) { ga[e] = pa[e]; gb[e] = pb[e]; }
#pragma unroll
        for (int e = 0; e < 16; ++e) gc[e] = pc[e];
    }
    FinIn in;
    if (gw < MR) fin_load(C, gw, in, lane);
    for (int row = gw; row < MR; row += NGW) {
        const int s = row_seq(row); const int t = row - seq_row0(s);
        const int chunk = t >> 5;
        const float* cr = WSP(float, WS_CARRY) + (size_t)(s * 64 + chunk) * 512 + 8 * lane;
        const f32x4 c0v = *(const f32x4*)cr, c1v = *(const f32x4*)(cr + 4);
        float y[8], o[8], og[16], zz[16];
        {
            const float hv[8] = {in.hl[0].x, in.hl[0].y, in.hl[0].z, in.hl[0].w, in.hl[1].x, in.hl[1].y, in.hl[1].z, in.hl[1].w};
            const float av[8] = {in.al[0].x, in.al[0].y, in.al[0].z, in.al[0].w, in.al[1].x, in.al[1].y, in.al[1].z, in.al[1].w};
            const float cv[8] = {c0v.x, c0v.y, c0v.z, c0v.w, c1v.x, c1v.y, c1v.z, c1v.w};
            const float gv[8] = {bflo(in.ag.x), bfhi(in.ag.x), bflo(in.ag.y), bfhi(in.ag.y), bflo(in.ag.z), bfhi(in.ag.z), bflo(in.ag.w), bfhi(in.ag.w)};
#pragma unroll
            for (int e = 0; e < 8; ++e) { const float h = hv[e] + av[e] * cv[e]; y[e] = h * gelu_tanh(gv[e]); }
            o[0] = bflo(in.oatt.x); o[1] = bfhi(in.oatt.x); o[2] = bflo(in.oatt.y); o[3] = bfhi(in.oatt.y); o[4] = bflo(in.oatt.z); o[5] = bfhi(in.oatt.z); o[6] = bflo(in.oatt.w); o[7] = bfhi(in.oatt.w);
#pragma unroll
            for (int h2 = 0; h2 < 2; ++h2) { const v4u a = in.og[h2], b = in.z[h2];
                og[8 * h2 + 0] = bflo(a.x); og[8 * h2 + 1] = bfhi(a.x); og[8 * h2 + 2] = bflo(a.y); og[8 * h2 + 3] = bfhi(a.y); og[8 * h2 + 4] = bflo(a.z); og[8 * h2 + 5] = bfhi(a.z); og[8 * h2 + 6] = bflo(a.w); og[8 * h2 + 7] = bfhi(a.w);
                zz[8 * h2 + 0] = bflo(b.x); zz[8 * h2 + 1] = bfhi(b.x); zz[8 * h2 + 2] = bflo(b.y); zz[8 * h2 + 3] = bfhi(b.y); zz[8 * h2 + 4] = bflo(b.z); zz[8 * h2 + 5] = bfhi(b.z); zz[8 * h2 + 6] = bflo(b.w); zz[8 * h2 + 7] = bfhi(b.w); }
        }
        asm volatile("" ::: "memory");
        const int nrow = row + NGW;
        if (nrow < MR) fin_load(C, nrow, in, lane);
        {
            float ss = 0.f;
#pragma unroll
            for (int e = 0; e < 8; ++e) ss += y[e] * y[e];
            const float rs = rsqrtf(wave_sum(ss) * (1.f / 512.f) + EPS);
            v4u w; w.x = cvtpk(y[0] * rs * ga[0], y[1] * rs * ga[1]); w.y = cvtpk(y[2] * rs * ga[2], y[3] * rs * ga[3]); w.z = cvtpk(y[4] * rs * ga[4], y[5] * rs * ga[5]); w.w = cvtpk(y[6] * rs * ga[6], y[7] * rs * ga[7]);
            *(GAS v4u*)(MIX + (size_t)row * DM + 8 * lane) = w;
        }
        {
            if (row >= MP) {
                const int b = (row - MP) >> 3, q = (row - MP) & 7, head = lane >> 3, dd = 8 * (lane & 7), bh = b * 8 + head;
                const float* spo = WSP(float, WS_SPO); const float* spt = WSP(float, WS_SPT);
                float R = 1.f;
#pragma unroll
                for (int e = 0; e < 8; ++e) o[e] = 0.f;
                const float* tp = spt + (size_t)(bh * 33) * 8 + q; const float* pb = spo + ((size_t)(bh * 33) * 8 + q) * 64 + dd;
#pragma unroll 1
                for (int rb = 22; rb >= 0; rb -= 11) {
                    float t[11]; f32x4 p0[11], p1[11];
#pragma unroll
                    for (int i = 0; i < 11; ++i) { t[i] = tp[(rb + i) * 8]; p0[i] = *(const f32x4*)(pb + (size_t)(rb + i) * 512); p1[i] = *(const f32x4*)(pb + (size_t)(rb + i) * 512 + 4); }
#pragma unroll
                    for (int i = 10; i >= 0; --i) {
                        o[0] += R * p0[i].x; o[1] += R * p0[i].y; o[2] += R * p0[i].z; o[3] += R * p0[i].w; o[4] += R * p1[i].x; o[5] += R * p1[i].y; o[6] += R * p1[i].z; o[7] += R * p1[i].w;
                        R *= t[i];
                    }
                }
            }
            float ss = 0.f;
#pragma unroll
            for (int e = 0; e < 8; ++e) ss += o[e] * o[e];
            const float rs = rsqrtf(wave_sum(ss) * (1.f / 512.f) + EPS);
            v4u w; w.x = cvtpk(o[0] * rs * gb[0], o[1] * rs * gb[1]); w.y = cvtpk(o[2] * rs * gb[2], o[3] * rs * gb[3]); w.z = cvtpk(o[4] * rs * gb[4], o[5] * rs * gb[5]); w.w = cvtpk(o[6] * rs * gb[6], o[7] * rs * gb[7]);
            *(GAS v4u*)(MIX + (size_t)row * DM + 512 + 8 * lane) = w;
        }
        {
            float ss = 0.f;
#pragma unroll
            for (int e = 0; e < 16; ++e) ss += og[e] * og[e];
            ss += __shfl_xor(ss, 1); ss += __shfl_xor(ss, 2); ss += __shfl_xor(ss, 4);
            const float rs = rsqrtf(ss * (1.f / 128.f) + EPS);
            float yc[16];
#pragma unroll
            for (int e = 0; e < 16; ++e) yc[e] = og[e] * rs * gc[e] * siluf_(zz[e]);
            v4u w0, w1; w0.x = cvtpk(yc[0], yc[1]); w0.y = cvtpk(yc[2], yc[3]); w0.z = cvtpk(yc[4], yc[5]); w0.w = cvtpk(yc[6], yc[7]);
            w1.x = cvtpk(yc[8], yc[9]); w1.y = cvtpk(yc[10], yc[11]); w1.z = cvtpk(yc[12], yc[13]); w1.w = cvtpk(yc[14], yc[15]);
            *(GAS v4u*)(MIX + (size_t)row * DM + 1024 + 16 * lane) = w0; *(GAS v4u*)(MIX + (size_t)row * DM + 1024 + 16 * lane + 8) = w1;
        }
    }
}

template <bool MASK>
__device__ __forceinline__ void sb_core(const bf16x8 (&kf)[4], const bf16x8 (&qf)[4], float bias2, int kbase, int qpos, int hi, float& R, v4u (&pw)[2]) {
    f32x16 p;
#pragma unroll
    for (int r = 0; r < 16; ++r) p[r] = bias2;
#pragma unroll
    for (int ks = 0; ks < 4; ++ks) p = __builtin_amdgcn_mfma_f32_32x32x16_bf16(kf[ks], qf[ks], p, 0, 0, 0);
    float w[16];
    float L = 1.f;
#pragma unroll
    for (int r = 0; r < 16; ++r) {
        float e = __builtin_amdgcn_exp2f(__builtin_amdgcn_fmed3f(p[r], -126.f, 7.f));
        if (MASK) { if (kbase + 16 * hi + r >= qpos) e = 0.f; }
        w[r] = e * L; L *= (1.f + e);
    }
    const float Pr = __builtin_amdgcn_rcpf(L);
    const float other = __shfl_xor(Pr, 32);
    const float F = (hi ? R : R * other) * Pr;
    R = R * Pr * other;
#pragma unroll
    for (int s = 0; s < 2; ++s) {
        pw[s].x = cvtpk(w[8 * s + 0] * F, w[8 * s + 1] * F); pw[s].y = cvtpk(w[8 * s + 2] * F, w[8 * s + 3] * F); pw[s].z = cvtpk(w[8 * s + 4] * F, w[8 * s + 5] * F); pw[s].w = cvtpk(w[8 * s + 6] * F, w[8 * s + 7] * F);
    }
}
__device__ __forceinline__ void sb_pv(f32x16 (&o)[2], const v4u (&pw)[2], const bf16x8 (&vf)[2][2]) {
#pragma unroll
    for (int dt = 0; dt < 2; ++dt)
#pragma unroll
        for (int st = 0; st < 2; ++st) o[dt] = __builtin_amdgcn_mfma_f32_32x32x16_bf16(__builtin_bit_cast(bf16x8, pw[st]), vf[dt][st], o[dt], 0, 0, 0);
}
constexpr int VT_PITCH = 72, VT_BYTES = 2 * 32 * VT_PITCH * 2;
struct RawBf { v4u k[4]; v4u v[4]; };
struct RawF32 { f32x4 k[8]; f32x4 v[8]; };
__device__ __forceinline__ void raw_load_bf16(RawBf& t, const bf16* Kb, const bf16* Vb, int pitch, int tile_base, int maxrow, int lane) {
#pragma unroll
    for (int i = 0; i < 4; ++i) { int row = tile_base + 8 * i + (lane >> 3); row = row > maxrow ? maxrow : row;
        t.k[i] = *(const v4u*)(Kb + (size_t)row * pitch + 8 * (lane & 7)); t.v[i] = *(const v4u*)(Vb + (size_t)row * pitch + 8 * (lane & 7)); }
}
__device__ __forceinline__ void raw_load_f32(RawF32& t, const float* Kt, const float* Vt, int lane) {
#pragma unroll
    for (int i = 0; i < 8; ++i) { t.k[i] = *(const f32x4*)(Kt + (size_t)(4 * i + (lane >> 4)) * 512 + 4 * (lane & 15)); t.v[i] = *(const f32x4*)(Vt + (size_t)(4 * i + (lane >> 4)) * 512 + 4 * (lane & 15)); }
}
__device__ __forceinline__ void vfrags_from_lds(const LAS bf16* vt, bf16x8 (&vf)[2][2], int lane) {
    typedef short s16x4v __attribute__((ext_vector_type(4)));
    const int g16 = lane >> 4, q = (lane & 15) >> 2, p = lane & 3, kh = g16 >> 1, cg = g16 & 1;
    const LAS bf16* base = vt + (16 * kh + q) * VT_PITCH + 16 * cg + 4 * p;
#pragma unroll
    for (int st = 0; st < 2; ++st)
#pragma unroll
        for (int dt = 0; dt < 2; ++dt) {
            const s16x4v lo = __builtin_bit_cast(s16x4v, __builtin_amdgcn_ds_read_tr16_b64_v4i16((LAS s16x4v*)(base + (8 * st + 0) * VT_PITCH + 32 * dt)));
            const s16x4v hi = __builtin_bit_cast(s16x4v, __builtin_amdgcn_ds_read_tr16_b64_v4i16((LAS s16x4v*)(base + (8 * st + 4) * VT_PITCH + 32 * dt)));
            vf[dt][st] = (bf16x8){lo[0], lo[1], lo[2], lo[3], hi[0], hi[1], hi[2], hi[3]};
        }
}
__device__ __forceinline__ void kfrags_from_lds(const LAS bf16* kt, bf16x8 (&kf)[4], int lane) {
    const int m = lane & 31, kh = lane >> 5;
    const LAS bf16* kp = kt + (16 * ((m >> 2) & 1) + (m & 3) + 4 * (m >> 3)) * VT_PITCH + 8 * kh;
#pragma unroll
    for (int ks = 0; ks < 4; ++ks) kf[ks] = *(const LAS bf16x8*)(kp + 16 * ks);
}
__device__ __forceinline__ void stage_bf16(const RawBf& t, LAS bf16* vt, bf16x8 (&kf)[4], int lane) {
    LAS bf16* kt = vt + 32 * VT_PITCH;
#pragma unroll
    for (int i = 0; i < 4; ++i) { *(LAS v4u*)(kt + (8 * i + (lane >> 3)) * VT_PITCH + 8 * (lane & 7)) = t.k[i]; *(LAS v4u*)(vt + (8 * i + (lane >> 3)) * VT_PITCH + 8 * (lane & 7)) = t.v[i]; }
    kfrags_from_lds(kt, kf, lane);
}
__device__ __forceinline__ void stage_f32(const RawF32& t, LAS bf16* vt, bf16x8 (&kf)[4], int lane) {
    LAS bf16* kt = vt + 32 * VT_PITCH;
#pragma unroll
    for (int i = 0; i < 8; ++i) { v2u w; w.x = cvtpk(t.k[i].x, t.k[i].y); w.y = cvtpk(t.k[i].z, t.k[i].w); *(LAS v2u*)(kt + (4 * i + (lane >> 4)) * VT_PITCH + 4 * (lane & 15)) = w;
        v2u u; u.x = cvtpk(t.v[i].x, t.v[i].y); u.y = cvtpk(t.v[i].z, t.v[i].w); *(LAS v2u*)(vt + (4 * i + (lane >> 4)) * VT_PITCH + 4 * (lane & 15)) = u; }
    kfrags_from_lds(kt, kf, lane);
}
template <bool MASK>
__device__ __forceinline__ void sb_compute(const bf16x8 (&kf)[4], const LAS bf16* vt, int tile_base, const bf16x8 (&qf)[4], float bias2, int qpos, int lane, float& R, f32x16 (&o)[2]) {
    v4u pw[2];
    sb_core<MASK>(kf, qf, bias2, tile_base, qpos, lane >> 5, R, pw);
    bf16x8 vf[2][2];
    vfrags_from_lds(vt, vf, lane);
    sb_pv(o, pw, vf);
}

constexpr int NATT_S = 64 * 33, NATT = NATT_S + 2048;
constexpr int SG_BYTES = 2 * 64 * VT_PITCH * 2;
struct RawG { f32x4 k[16]; f32x4 v[16]; };
__device__ __forceinline__ void rawg_load(RawG& t, const float* Kt, const float* Vt, int lane) {
#pragma unroll
    for (int i = 0; i < 16; ++i) { t.k[i] = *(const f32x4*)(Kt + (size_t)(4 * i + (lane >> 4)) * 512 + 4 * (lane & 15)); t.v[i] = *(const f32x4*)(Vt + (size_t)(4 * i + (lane >> 4)) * 512 + 4 * (lane & 15)); }
}
__device__ __forceinline__ void rawg_stage(const RawG& t, LAS bf16* vt, int lane) {
    LAS bf16* kt = vt + 64 * VT_PITCH;
#pragma unroll
    for (int i = 0; i < 16; ++i) { v2u w; w.x = cvtpk(t.k[i].x, t.k[i].y); w.y = cvtpk(t.k[i].z, t.k[i].w); *(LAS v2u*)(kt + (4 * i + (lane >> 4)) * VT_PITCH + 4 * (lane & 15)) = w;
        v2u u; u.x = cvtpk(t.v[i].x, t.v[i].y); u.y = cvtpk(t.v[i].z, t.v[i].w); *(LAS v2u*)(vt + (4 * i + (lane >> 4)) * VT_PITCH + 4 * (lane & 15)) = u; }
}
template <bool MASK>
__device__ __forceinline__ void sb16(const LAS bf16* vth, const LAS bf16* kth, const bf16x8 (&qf)[2], float bias2, int kbase, int qpos, int lane, float& R, f32x4 (&o)[4]) {
    typedef short s16x4v __attribute__((ext_vector_type(4)));
    const int i = lane & 15, g = lane >> 4;
    f32x4 p[2];
    {
        bf16x8 kf[2][2];
        const LAS bf16* kp = kth + (8 * (i >> 2) + (i & 3)) * VT_PITCH + 8 * g;
#pragma unroll
        for (int j2 = 0; j2 < 2; ++j2)
#pragma unroll
            for (int ks = 0; ks < 2; ++ks) kf[j2][ks] = *(const LAS bf16x8*)(kp + 4 * j2 * VT_PITCH + 32 * ks);
#pragma unroll
        for (int j2 = 0; j2 < 2; ++j2) { p[j2] = (f32x4){bias2, bias2, bias2, bias2};
#pragma unroll
            for (int ks = 0; ks < 2; ++ks) p[j2] = __builtin_amdgcn_mfma_f32_16x16x32_bf16(kf[j2][ks], qf[ks], p[j2], 0, 0, 0); }
    }
    float w[8]; float L = 1.f;
#pragma unroll
    for (int x = 0; x < 8; ++x) {
        float e = __builtin_amdgcn_exp2f(__builtin_amdgcn_fmed3f(p[x >> 2][x & 3], -126.f, 7.f));
        if (MASK) { if (kbase + 8 * g + x >= qpos) e = 0.f; }
        w[x] = e * L; L *= (1.f + e);
    }
    const float Pr = __builtin_amdgcn_rcpf(L);
    const float a = __shfl_xor(Pr, 16); const float pp = Pr * a; const float b = __shfl_xor(pp, 32);
    const float suf = (g == 3) ? 1.f : (g == 2) ? a : (g == 1) ? b : a * b;
    const float F = R * suf * Pr;
    R = R * pp * b;
    v4u pw; pw.x = cvtpk(w[0] * F, w[1] * F); pw.y = cvtpk(w[2] * F, w[3] * F); pw.z = cvtpk(w[4] * F, w[5] * F); pw.w = cvtpk(w[6] * F, w[7] * F);
    const LAS bf16* vb = vth + (8 * g + ((lane & 15) >> 2)) * VT_PITCH + 4 * (lane & 3);
#pragma unroll
    for (int dt = 0; dt < 4; ++dt) {
        const s16x4v lo = __builtin_bit_cast(s16x4v, __builtin_amdgcn_ds_read_tr16_b64_v4i16((LAS s16x4v*)(vb + 16 * dt)));
        const s16x4v hi = __builtin_bit_cast(s16x4v, __builtin_amdgcn_ds_read_tr16_b64_v4i16((LAS s16x4v*)(vb + 4 * VT_PITCH + 16 * dt)));
        const bf16x8 vf = (bf16x8){lo[0], lo[1], lo[2], lo[3], hi[0], hi[1], hi[2], hi[3]};
        o[dt] = __builtin_amdgcn_mfma_f32_16x16x32_bf16(vf, __builtin_bit_cast(bf16x8, pw), o[dt], 0, 0, 0);
    }
}
__device__ __forceinline__ void team_barrier(volatile LAS unsigned* tb, unsigned& kb);
__device__ __forceinline__ void attn_unit(Ctx& C, int l, int a, LAS bf16* vt, volatile LAS unsigned* tb, unsigned& kbar) {
    KA_FRESH(C);
    const int lane = C.lane, q = lane & 15, g = lane >> 4;
    const bf16* P = WSP(bf16, WS_PROJ);
    f32x4 o[4];
#pragma unroll
    for (int dt = 0; dt < 4; ++dt) o[dt] = (f32x4){0.f, 0.f, 0.f, 0.f};
    float R = 1.f;
    const int head = a & 7, b = (a >> 3) & 7, rg = a >> 6, bh = b * 8 + head;
    const float bias2 = C.in(28)[l * 8 + head] * LOG2E;
    const int row0 = MP + 8 * b;
    bf16x8 qf[2];
    { const int qr = q < 8 ? q : 7; const bf16* qp = P + (size_t)(row0 + qr) * PP + C_Q + 64 * head + 8 * g;
#pragma unroll
      for (int ks = 0; ks < 2; ++ks) { v4u x = *(const v4u*)(qp + 32 * ks); if (q >= 8) { x.x = 0u; x.y = 0u; x.z = 0u; x.w = 0u; } qf[ks] = __builtin_bit_cast(bf16x8, x); } }
    LAS bf16* kt = vt + 64 * VT_PITCH;
    if (rg < 32) {
        const int* pt = (const int*)C.in(6) + b * 128;
        const float* ck = C.in(4) + (size_t)l * 1280 * 128 * 512 + 64 * head; const float* cv = C.in(5) + (size_t)l * 1280 * 128 * 512 + 64 * head;
        RawG ra;
        const int p0 = __builtin_amdgcn_readfirstlane(pt[4 * rg + 0]), p1 = __builtin_amdgcn_readfirstlane(pt[4 * rg + 1]), p2 = __builtin_amdgcn_readfirstlane(pt[4 * rg + 2]), p3 = __builtin_amdgcn_readfirstlane(pt[4 * rg + 3]);
#define GOFF(j) (((size_t)(((j) >> 1) == 0 ? p0 : ((j) >> 1) == 1 ? p1 : ((j) >> 1) == 2 ? p2 : p3) * 128 + ((j) & 1) * 64) * 512)
        { const size_t off = GOFF(7); rawg_load(ra, ck + off, cv + off, lane); }
#pragma unroll 1
        for (int j = 7; j >= 0; --j) {
            team_barrier(tb, kbar);
            rawg_stage(ra, vt, lane);
            asm volatile("" ::: "memory");
            if (j > 0) { const size_t off = GOFF(j - 1); rawg_load(ra, ck + off, cv + off, lane); }
            sb16<false>(vt + 32 * VT_PITCH, kt + 32 * VT_PITCH, qf, bias2, 0, 0x7fffffff, lane, R, o);
            sb16<false>(vt, kt, qf, bias2, 0, 0x7fffffff, lane, R, o);
        }
#undef GOFF
    } else {
        RawBf cur; raw_load_bf16(cur, P + (size_t)row0 * PP + C_K + 64 * head, P + (size_t)row0 * PP + C_V + 64 * head, PP, 0, 7, lane);
#pragma unroll
        for (int i = 0; i < 4; ++i) { *(LAS v4u*)(kt + (8 * i + (lane >> 3)) * VT_PITCH + 8 * (lane & 7)) = cur.k[i]; *(LAS v4u*)(vt + (8 * i + (lane >> 3)) * VT_PITCH + 8 * (lane & 7)) = cur.v[i]; }
        sb16<true>(vt, kt, qf, bias2, 0, q, lane, R, o);
    }
    float* spo = WSP(float, WS_SPO) + (size_t)(bh * 33 + rg) * 8 * 64; float* spt = WSP(float, WS_SPT) + (size_t)(bh * 33 + rg) * 8;
    if (q < 8) {
#pragma unroll
        for (int dt = 0; dt < 4; ++dt) *(f32x4*)(spo + q * 64 + 16 * dt + 4 * g) = o[dt];
    }
    if (lane < 8) spt[lane] = R;
}

constexpr int PB_SLOT = 2 * 32 * VT_PITCH * 2;
__device__ __forceinline__ void team_barrier(volatile LAS unsigned* tb, unsigned& kb) {
    kb += 1u;
    const unsigned target = 4u * kb;
    const unsigned addr = (unsigned)(uintptr_t)tb;
    unsigned tmp, sc, cnt; unsigned long long sv;
    asm volatile(
        "s_waitcnt lgkmcnt(0)\n\t"
        "s_mov_b64 %[sv], exec\n\t"
        "s_mov_b64 exec, 1\n\t"
        "ds_add_u32 %[addr], %[one]\n\t"
        "s_mov_b64 exec, %[sv]\n\t"
        "s_mov_b32 %[cnt], 0\n\t"
        "1:\n\t"
        "ds_read_b32 %[tmp], %[addr]\n\t"
        "s_waitcnt lgkmcnt(0)\n\t"
        "v_readfirstlane_b32 %[sc], %[tmp]\n\t"
        "s_cmp_ge_u32 %[sc], %[target]\n\t"
        "s_cbranch_scc1 2f\n\t"
        "s_add_u32 %[cnt], %[cnt], 1\n\t"
        "s_cmp_gt_u32 %[cnt], 0x2000000\n\t"
        "s_cbranch_scc1 2f\n\t"
        "s_sleep 1\n\t"
        "s_branch 1b\n\t"
        "2:\n\t"
        : [tmp] "=&v"(tmp), [sc] "=&s"(sc), [cnt] "=&s"(cnt), [sv] "=&s"(sv)
        : [addr] "v"(addr), [one] "v"(1u), [target] "s"(target)
        : "memory", "scc");
}
__device__ __forceinline__ void prompt_team_unit(Ctx& C, int l, int u, LAS bf16* ring, volatile LAS unsigned* tb, unsigned& kb) {
    KA_FRESH(C);
    const int lane = C.lane, m = lane & 31, kh = lane >> 5, w4 = C.wave & 3;
    const int qb = 15 - (u >> 5), sh = u & 31, seq = sh >> 3, head = sh & 7;
    const int g = 4 * qb + w4, T0 = 4 * qb + 3;
    const bf16* P = WSP(bf16, WS_PROJ);
    const float bias2 = C.in(28)[l * 8 + head] * LOG2E;
    const int row0 = seq * 2048;
    bf16x8 qf[4];
    { const bf16* qp = P + (size_t)(row0 + 32 * g + m) * PP + C_Q + 64 * head + 8 * kh;
#pragma unroll
      for (int ks = 0; ks < 4; ++ks) qf[ks] = *(const bf16x8*)(qp + 16 * ks); }
    const int tt = C.tid & 255, lrow = tt >> 3, lch = tt & 7;
    const bf16* srck = P + (size_t)row0 * PP + C_K + 64 * head + 8 * lch; const bf16* srcv = P + (size_t)row0 * PP + C_V + 64 * head + 8 * lch;
    const int ldst = lrow * VT_PITCH + 8 * lch;
    const int qpos = 32 * g + m;
    f32x16 o[2];
#pragma unroll
    for (int r = 0; r < 16; ++r) { o[0][r] = 0.f; o[1][r] = 0.f; }
    float R = 1.f;
#define PT_LDK(t) (*(const v4u*)(srck + (size_t)(32 * ((t) > 0 ? (t) : 0) + lrow) * PP))
#define PT_LDV(t) (*(const v4u*)(srcv + (size_t)(32 * ((t) > 0 ? (t) : 0) + lrow) * PP))
    v4u rak = PT_LDK(T0), rav = PT_LDV(T0), rbk = PT_LDK(T0 - 1), rbv = PT_LDV(T0 - 1);
#pragma unroll 1
    for (int t = T0; t >= 0; t -= 2) {
        *(LAS v4u*)(ring + 32 * VT_PITCH + ldst) = rak; *(LAS v4u*)(ring + ldst) = rav;
        rak = PT_LDK(t - 2); rav = PT_LDV(t - 2);
        team_barrier(tb, kb);
        if (t <= g) {
            LAS bf16* vt = ring; bf16x8 kf[4]; kfrags_from_lds(vt + 32 * VT_PITCH, kf, lane);
            if (t == g) sb_compute<true>(kf, vt, 32 * t, qf, bias2, qpos, lane, R, o); else sb_compute<false>(kf, vt, 32 * t, qf, bias2, qpos, lane, R, o);
        }
        *(LAS v4u*)(ring + PB_SLOT / 2 + 32 * VT_PITCH + ldst) = rbk; *(LAS v4u*)(ring + PB_SLOT / 2 + ldst) = rbv;
        rbk = PT_LDK(t - 3); rbv = PT_LDV(t - 3);
        team_barrier(tb, kb);
        if (t - 1 <= g) {
            LAS bf16* vt = ring + PB_SLOT / 2; bf16x8 kf[4]; kfrags_from_lds(vt + 32 * VT_PITCH, kf, lane);
            if (t - 1 == g) sb_compute<true>(kf, vt, 32 * (t - 1), qf, bias2, qpos, lane, R, o); else sb_compute<false>(kf, vt, 32 * (t - 1), qf, bias2, qpos, lane, R, o);
        }
    }
#undef PT_LDK
#undef PT_LDV
    bf16* oa = WSP(bf16, WS_OATT) + (size_t)(row0 + 32 * g) * 512 + 64 * head;
#pragma unroll
    for (int dt = 0; dt < 2; ++dt)
#pragma unroll
        for (int r = 0; r < 16; ++r) oa[(size_t)crow(r, kh) * 512 + 32 * dt + m] = f2bf(o[dt][r]);
    team_barrier(tb, kb);
}
constexpr int PB_SLOT_FWD = 0;
__device__ __forceinline__ void prompt_block_unit(Ctx& C, int l, int u) {
    KA_FRESH(C);
    const int lane = C.lane, m = lane & 31, kh = lane >> 5, wave = C.wave;
    const int qb = 7 - (u >> 5), sh = u & 31, seq = sh >> 3, head = sh & 7;
    const int g = 8 * qb + wave, T0 = 8 * qb + 7;
    const bf16* P = WSP(bf16, WS_PROJ);
    const float bias2 = C.in(28)[l * 8 + head] * LOG2E;
    const int row0 = seq * 2048;
    bf16x8 qf[4];
    { const bf16* qp = P + (size_t)(row0 + 32 * g + m) * PP + C_Q + 64 * head + 8 * kh;
#pragma unroll
      for (int ks = 0; ks < 4; ++ks) qf[ks] = *(const bf16x8*)(qp + 16 * ks); }
    const int part = C.tid >> 8, lrow = (C.tid & 255) >> 3, lch = C.tid & 7;
    const bf16* src = P + (size_t)row0 * PP + (part == 0 ? C_K : C_V) + 64 * head + 8 * lch;
    const int ldst = (part == 0 ? 32 * VT_PITCH : 0) + lrow * VT_PITCH + 8 * lch;
    LAS bf16* ring = (LAS bf16*)C.lds;
    const int qpos = 32 * g + m;
    f32x16 o[2];
#pragma unroll
    for (int r = 0; r < 16; ++r) { o[0][r] = 0.f; o[1][r] = 0.f; }
    float R = 1.f;
#define PB_LD(t) (*(const v4u*)(src + (size_t)(32 * ((t) > 0 ? (t) : 0) + lrow) * PP))
    v4u ra = PB_LD(T0), rb = PB_LD(T0 - 1);
#pragma unroll 1
    for (int t = T0; t >= 0; t -= 2) {
        *(LAS v4u*)(ring + ldst) = ra;
        ra = PB_LD(t - 2);
        __syncthreads();
        if (t <= g) {
            LAS bf16* vt = ring; bf16x8 kf[4]; kfrags_from_lds(vt + 32 * VT_PITCH, kf, lane);
            if (t == g) sb_compute<true>(kf, vt, 32 * t, qf, bias2, qpos, lane, R, o); else sb_compute<false>(kf, vt, 32 * t, qf, bias2, qpos, lane, R, o);
        }
        *(LAS v4u*)(ring + PB_SLOT / 2 + ldst) = rb;
        rb = PB_LD(t - 3);
        __syncthreads();
        if (t - 1 <= g) {
            LAS bf16* vt = ring + PB_SLOT / 2; bf16x8 kf[4]; kfrags_from_lds(vt + 32 * VT_PITCH, kf, lane);
            if (t - 1 == g) sb_compute<true>(kf, vt, 32 * (t - 1), qf, bias2, qpos, lane, R, o); else sb_compute<false>(kf, vt, 32 * (t - 1), qf, bias2, qpos, lane, R, o);
        }
    }
#undef PB_LD
    bf16* oa = WSP(bf16, WS_OATT) + (size_t)(row0 + 32 * g) * 512 + 64 * head;
#pragma unroll
    for (int dt = 0; dt < 2; ++dt)
#pragma unroll
        for (int r = 0; r < 16; ++r) oa[(size_t)crow(r, kh) * 512 + 32 * dt + m] = f2bf(o[dt][r]);
    __syncthreads();
}

__device__ __forceinline__ bf16x8 pack8(const f32x16& a, int s) {
    v4u w;
    if (s == 0) { w.x = cvtpk(a[0], a[1]); w.y = cvtpk(a[2], a[3]); w.z = cvtpk(a[4], a[5]); w.w = cvtpk(a[6], a[7]); }
    else { w.x = cvtpk(a[8], a[9]); w.y = cvtpk(a[10], a[11]); w.z = cvtpk(a[12], a[13]); w.w = cvtpk(a[14], a[15]); }
    return __builtin_bit_cast(bf16x8, w);
}
__device__ __forceinline__ void bf16x16_to_f32(f32x16& a, const v4u x, const v4u y) {
    a[0] = bflo(x.x); a[1] = bfhi(x.x); a[2] = bflo(x.y); a[3] = bfhi(x.y); a[4] = bflo(x.z); a[5] = bfhi(x.z); a[6] = bflo(x.w); a[7] = bfhi(x.w);
    a[8] = bflo(y.x); a[9] = bfhi(y.x); a[10] = bflo(y.y); a[11] = bfhi(y.y); a[12] = bflo(y.z); a[13] = bfhi(y.z); a[14] = bflo(y.w); a[15] = bfhi(y.w);
}
__device__ __forceinline__ void gdn_scan_unit(Ctx& C, int l, int su) {
    KA_FRESH(C);
    const int lane = C.lane, m = lane & 31, hi = lane >> 5;
    int seq, head, ds, nch, cid0;
    if (su < 128) { const int sh = su >> 2; ds = su & 3; seq = sh >> 3; head = sh & 7; nch = 32; cid0 = sh * 32; }
    else { const int v = su - 128; const int sh = v >> 2; ds = v & 3; seq = 4 + (sh >> 3); head = sh & 7; nch = 1; cid0 = 1024 + sh; }
    const int row0 = seq_row0(seq);
    f32x16 S[4];
    if (seq >= 4) {
        const float* s0 = C.in(10) + ((size_t)(l * 8 + (seq - 4)) * 8 + head) * 16384 + 32 * ds + m;
#pragma unroll
        for (int dt = 0; dt < 4; ++dt)
#pragma unroll
            for (int r = 0; r < 16; ++r) S[dt][r] = s0[(size_t)(32 * dt + crow(r, hi)) * 128];
    } else {
#pragma unroll
        for (int dt = 0; dt < 4; ++dt)
#pragma unroll
            for (int r = 0; r < 16; ++r) S[dt][r] = 0.f;
    }
    bf16* OG = WSP(bf16, WS_OGDN);
#pragma unroll 1
    for (int ch = 0; ch < nch; ++ch) {
        const int cid = cid0 + ch;
        const bf16x8* Wf = (const bf16x8*)(WSP(v4u, WS_WF) + (size_t)cid * 1024) + lane;
        const bf16x8* QEf = (const bf16x8*)(WSP(v4u, WS_QEF) + (size_t)cid * 1024) + lane;
        const bf16x8* KDf = (const bf16x8*)(WSP(v4u, WS_KDF) + (size_t)cid * 1024) + lane;
        const bf16x8* QKf = (const bf16x8*)(WSP(v4u, WS_QKF) + (size_t)cid * 512) + lane;
        const v4u* Uf = (const v4u*)(WSP(bf16, WS_UF) + (size_t)cid * 8192);
        const float egl = WSP(float, WS_GL)[cid];
        bf16x8 Sf[8];
#pragma unroll
        for (int dt = 0; dt < 4; ++dt) { Sf[2 * dt] = pack8(S[dt], 0); Sf[2 * dt + 1] = pack8(S[dt], 1); }
        f32x16 av[2], ao[2];
#pragma unroll
        for (int ti = 0; ti < 2; ++ti) {
            { const v4u* up = Uf + ((ds * 2 + ti) * 64 + lane) * 2; bf16x16_to_f32(av[ti], up[0], up[1]); }
#pragma unroll
            for (int ks = 0; ks < 8; ++ks) av[ti] = __builtin_amdgcn_mfma_f32_32x32x16_bf16(Wf[(ti * 8 + ks) * 64], Sf[ks], av[ti], 0, 0, 0);
#pragma unroll
            for (int r = 0; r < 16; ++r) ao[ti][r] = 0.f;
#pragma unroll
            for (int ks = 0; ks < 8; ++ks) ao[ti] = __builtin_amdgcn_mfma_f32_32x32x16_bf16(QEf[(ti * 8 + ks) * 64], Sf[ks], ao[ti], 0, 0, 0);
        }
        bf16x8 Vf[4];
        Vf[0] = pack8(av[0], 0); Vf[1] = pack8(av[0], 1); Vf[2] = pack8(av[1], 0); Vf[3] = pack8(av[1], 1);
#pragma unroll
        for (int ti = 0; ti < 2; ++ti)
#pragma unroll
            for (int k2 = 0; k2 < 4; ++k2) ao[ti] = __builtin_amdgcn_mfma_f32_32x32x16_bf16(QKf[(ti * 4 + k2) * 64], Vf[k2], ao[ti], 0, 0, 0);
#pragma unroll
        for (int dt = 0; dt < 4; ++dt) {
#pragma unroll
            for (int r = 0; r < 16; ++r) S[dt][r] *= egl;
#pragma unroll
            for (int k2 = 0; k2 < 4; ++k2) S[dt] = __builtin_amdgcn_mfma_f32_32x32x16_bf16(KDf[(dt * 4 + k2) * 64], Vf[k2], S[dt], 0, 0, 0);
        }
        if (seq < 4) {
#pragma unroll
            for (int ti = 0; ti < 2; ++ti)
#pragma unroll
                for (int r = 0; r < 16; ++r) OG[(size_t)(row0 + ch * 64 + 32 * ti + crow(r, hi)) * 1024 + head * 128 + 32 * ds + m] = f2bf(ao[ti][r]);
        } else {
#pragma unroll
            for (int r = 0; r < 4; ++r) OG[(size_t)(row0 + crow(r, hi)) * 1024 + head * 128 + 32 * ds + m] = f2bf(ao[0][r]);
        }
    }
    float* so = (seq < 4) ? OUTB + O_GP + ((size_t)(l * 4 + seq) * 8 + head) * 16384 : OUTB + O_GS + ((size_t)(l * 8 + (seq - 4)) * 8 + head) * 16384;
#pragma unroll
    for (int dt = 0; dt < 4; ++dt)
#pragma unroll
        for (int r = 0; r < 16; ++r) so[(size_t)(32 * dt + crow(r, hi)) * 128 + 32 * ds + m] = S[dt][r];
}

constexpr int SCAN_BUF = 73728;
static_assert(2 * SCAN_BUF <= LDS_MISC, "scan LDS");
__device__ __forceinline__ void scan_load(Ctx& C, int cid, int lt, v4u (&t)[18]) {
#pragma unroll
    for (int i = 0; i < 18; ++i) { const int idx = lt + 256 * i;
        const v4u* src = (i < 4) ? WSP(v4u, WS_WF) + (size_t)cid * 1024 + idx : (i < 8) ? WSP(v4u, WS_QEF) + (size_t)cid * 1024 + (idx - 1024) : (i < 12) ? WSP(v4u, WS_KDF) + (size_t)cid * 1024 + (idx - 2048)
                       : (i < 14) ? WSP(v4u, WS_QKF) + (size_t)cid * 512 + (idx - 3072) : WSP(v4u, WS_UF) + (size_t)cid * 1024 + (idx - 3584);
        t[i] = *src; }
}
__device__ __forceinline__ void scan_store(LAS unsigned char* dst, int lt, const v4u (&t)[18]) {
#pragma unroll
    for (int i = 0; i < 18; ++i) *(LAS v4u*)(dst + (size_t)(lt + 256 * i) * 16) = t[i];
}
__device__ __forceinline__ void gdn_scan_block(Ctx& C, int l, int sh) {
    KA_FRESH(C);
    const int lane = C.lane, m = lane & 31, hi = lane >> 5, wave = C.wave;
    const int seq = sh >> 3, head = sh & 7, ds = wave & 3, cid0 = sh * 32;
    const int row0 = seq * 2048;
    const int lt = C.tid & 255;
    if (wave >= 4) {
        v4u tst[18];
        scan_load(C, cid0, lt, tst); scan_store(C.lds, lt, tst); scan_load(C, cid0 + 1, lt, tst);
        __syncthreads();
#pragma unroll 1
        for (int ch = 0; ch < 32; ++ch) {
            if (ch + 1 < 32) { scan_store(C.lds + ((ch + 1) & 1) * SCAN_BUF, lt, tst); if (ch + 2 < 32) scan_load(C, cid0 + ch + 2, lt, tst); }
            __syncthreads();
        }
    } else {
        const unsigned olane = (unsigned)(4 * hi * 1024 + m);
        f32x16 S[4];
#pragma unroll
        for (int dt = 0; dt < 4; ++dt)
#pragma unroll
            for (int r = 0; r < 16; ++r) S[dt][r] = 0.f;
        bf16* OG = WSP(bf16, WS_OGDN);
        float egl_next = WSP(float, WS_GL)[cid0];
        __syncthreads();
#pragma unroll 1
        for (int ch = 0; ch < 32; ++ch) {
            const int cid = cid0 + ch;
            const LAS bf16x8* Wf = (const LAS bf16x8*)(C.lds + (ch & 1) * SCAN_BUF) + lane;
            const LAS bf16x8* QEf = Wf + 1024; const LAS bf16x8* KDf = Wf + 2048; const LAS bf16x8* QKf = Wf + 3072;
            const LAS v4u* Ub = (const LAS v4u*)(C.lds + (ch & 1) * SCAN_BUF + 57344) + (ds * 2) * 128 + lane * 2;
            const float egl = egl_next; egl_next = WSP(float, WS_GL)[cid0 + (ch + 1 < 32 ? ch + 1 : ch)];
            f32x16 av[2], ao[2];
            bf16x16_to_f32(av[0], Ub[0], Ub[1]); bf16x16_to_f32(av[1], Ub[128], Ub[129]);
#pragma unroll
            for (int r = 0; r < 16; ++r) { ao[0][r] = 0.f; ao[1][r] = 0.f; }
#pragma unroll
            for (int dt = 0; dt < 4; ++dt)
#pragma unroll
                for (int sx = 0; sx < 2; ++sx) { const int ks = 2 * dt + sx; const bf16x8 sf = pack8(S[dt], sx);
                    av[0] = __builtin_amdgcn_mfma_f32_32x32x16_bf16(Wf[(0 * 8 + ks) * 64], sf, av[0], 0, 0, 0);
                    av[1] = __builtin_amdgcn_mfma_f32_32x32x16_bf16(Wf[(1 * 8 + ks) * 64], sf, av[1], 0, 0, 0);
                    ao[0] = __builtin_amdgcn_mfma_f32_32x32x16_bf16(QEf[(0 * 8 + ks) * 64], sf, ao[0], 0, 0, 0);
                    ao[1] = __builtin_amdgcn_mfma_f32_32x32x16_bf16(QEf[(1 * 8 + ks) * 64], sf, ao[1], 0, 0, 0); }
            bf16x8 Vf[4];
            Vf[0] = pack8(av[0], 0); Vf[1] = pack8(av[0], 1); Vf[2] = pack8(av[1], 0); Vf[3] = pack8(av[1], 1);
#pragma unroll
            for (int ti = 0; ti < 2; ++ti)
#pragma unroll
                for (int k2 = 0; k2 < 4; ++k2) ao[ti] = __builtin_amdgcn_mfma_f32_32x32x16_bf16(QKf[(ti * 4 + k2) * 64], Vf[k2], ao[ti], 0, 0, 0);
#pragma unroll
            for (int dt = 0; dt < 4; ++dt) {
#pragma unroll
                for (int r = 0; r < 16; ++r) S[dt][r] *= egl;
#pragma unroll
                for (int k2 = 0; k2 < 4; ++k2) S[dt] = __builtin_amdgcn_mfma_f32_32x32x16_bf16(KDf[(dt * 4 + k2) * 64], Vf[k2], S[dt], 0, 0, 0);
            }
#pragma unroll
            for (int ti = 0; ti < 2; ++ti)
#pragma unroll
                for (int r = 0; r < 16; ++r) { bf16* p = OG + (size_t)(row0 + ch * 64 + 32 * ti + (r & 3) + 8 * (r >> 2)) * 1024 + head * 128 + 32 * ds; p[olane] = f2bf(ao[ti][r]); }
            __syncthreads();
        }
        float* so = OUTB + O_GP + ((size_t)(l * 4 + seq) * 8 + head) * 16384;
#pragma unroll
        for (int dt = 0; dt < 4; ++dt)
#pragma unroll
            for (int r = 0; r < 16; ++r) { float* p = so + (32 * dt + (r & 3) + 8 * (r >> 2)) * 128 + 32 * ds; p[(unsigned)(4 * hi * 128 + m)] = S[dt][r]; }
    }
}

__device__ __forceinline__ void lru_carry_task(Ctx& C, int l, int task) {
    KA_FRESH(C);
    const int s = task >> 3, d = (task & 7) * 64 + C.lane;
    const int nchunk = s < 4 ? 64 : 1, len = s < 4 ? 32 : 8, row0 = seq_row0(s);
    float H = s < 4 ? 0.f : C.in(8)[(size_t)(l * 8 + (s - 4)) * 512 + d];
    const float* HL = WSP(float, WS_LH); const float* AL = WSP(float, WS_LA); float* CR = WSP(float, WS_CARRY);
#pragma unroll 8
    for (int c = 0; c < nchunk; ++c) {
        CR[(size_t)(s * 64 + c) * 512 + d] = H;
        const size_t off = (size_t)(row0 + c * len + len - 1) * 512 + d;
        H = AL[off] * H + HL[off];
    }
    float* o = s < 4 ? OUTB + O_LHP + (size_t)(l * 4 + s) * 512 : OUTB + O_LHS + (size_t)(l * 8 + (s - 4)) * 512;
    o[d] = H;
}

__device__ __forceinline__ void phase_m4(Ctx& C, int l, int rep, unsigned& kbar) {
    if (C.bid >= 160 && C.G == 256) {
        pg8::Gemm g{WSP(bf16, WS_H), WSP(bf16, WS_WIN + l * WIN_L) + (size_t)6144 * DM, MP, 768, DM}; pg8::StaticOrder S; S.init(MP, 768, 96, C.bid - 160);
        EpiBf E{WSP(bf16, WS_PROJ) + 6144, PP};
        pg8::gemm_phase<EpiBf, pg8::StaticOrder, true, true>(C.lds, g, S, E);
    }
    for (int r7 = 0; r7 < REPN(7); ++r7) {
        if (C.bid < 32) gdn_scan_block(C, l, C.bid);
        else if (C.bid < 96) {
            if (C.wave < 4) gdn_scan_unit(C, l, 128 + (C.bid - 32) * 4 + C.wave);
            else if (C.wave < 6) { const int t = (C.bid - 32) * 2 + (C.wave - 4); if (t < 96) lru_carry_task(C, l, t); }
        }
    }
    {
    unsigned* qs = (unsigned*)(C.ws + WS_CTL) + CW_QUEUE + 64 * l;
    unsigned* qp = (unsigned*)(C.ws + WS_CTL) + CW_QUEUE + 64 * (16 + l);
    const int team = C.wave >> 2;
    volatile LAS unsigned* tb = (volatile LAS unsigned*)(C.lds + LDS_MISC) + 32 + 8 * team;
    LAS unsigned char* treg = C.lds + team * 73728;
    __syncthreads();
#pragma unroll 1
    for (int pass = 0; pass < 2; ++pass) {
        const bool prompt_first = (team == 0);
        const bool do_prompt = prompt_first == (pass == 0);
        if (do_prompt) {
            for (;;) {
                if ((C.tid & 255) == 0) tb[2] = __hip_atomic_fetch_add(qp, 1u, __ATOMIC_RELAXED, __HIP_MEMORY_SCOPE_AGENT);
                team_barrier(tb, kbar);
                const unsigned u = (unsigned)__builtin_amdgcn_readfirstlane((int)tb[2]);
                team_barrier(tb, kbar);
                if (u >= 512u) break;
                prompt_team_unit(C, l, (int)u, (LAS bf16*)treg, tb, kbar);
            }
        } else {
            for (;;) {
                if ((C.tid & 255) == 0) tb[2] = __hip_atomic_fetch_add(qs, 1u, __ATOMIC_RELAXED, __HIP_MEMORY_SCOPE_AGENT);
                team_barrier(tb, kbar);
                const unsigned u = (unsigned)__builtin_amdgcn_readfirstlane((int)tb[2]);
                team_barrier(tb, kbar);
                if (u >= (unsigned)(NATT_S / 4)) break;
                attn_unit(C, l, (int)(4u * u) + (C.wave & 3), (LAS bf16*)(treg + (C.wave & 3) * SG_BYTES), tb, kbar);
            }
        }
    }
    }
}

struct Args { const void* in[38]; float* out; unsigned char* ws; int ph_lo, ph_hi; };

__global__ void __launch_bounds__(NTHR, 2) hymba_fwd(Args args) {
    extern __shared__ __attribute__((aligned(16))) unsigned char lds_raw[];
    Ctx C;
    C.kp = (kptr_t)__builtin_amdgcn_kernarg_segment_ptr();
    C.out = (GAS float*)args.out; C.ws = (GAS unsigned char*)args.ws; C.lds = (LAS unsigned char*)lds_raw;
    C.tid = threadIdx.x; C.lane = C.tid & 63; C.wave = __builtin_amdgcn_readfirstlane(C.tid >> 6); C.G = gridDim.x; C.bid = blockIdx.x;
    volatile LAS unsigned* MISC = (volatile LAS unsigned*)(C.lds + LDS_MISC);
    if (C.tid < 64) MISC[C.tid] = 0u;
    __syncthreads();
    unsigned* ctl = (unsigned*)(C.ws + WS_CTL);
    XcdBarrier bar = xcd_barrier_post(ctl + CW_BAR, MISC + 8);
    const int lo = args.ph_lo, hi = args.ph_hi;
#define IN(k) (lo <= (k) && (k) < hi)
#define SEAM(k) do { if (IN(k) && IN((k) + 1)) { xcd_barrier(bar); if (REPN(6) > 1) { xcd_barrier(bar); xcd_barrier(bar); } } } while (0)

        if (IN(0)) { for (int rp = 0; rp < REPN(0); ++rp) { p0_weights(C); p0_ada(C); } } SEAM(0);
    if (IN(1)) { for (int rp = 0; rp < REPN(4); ++rp) p0b_modreduce(C); } SEAM(1);
    if (IN(2)) { for (int rp = 0; rp < REPN(4); ++rp) phase_n1(C); } SEAM(2);
    unsigned kbar = 0u;
#pragma unroll 1
    for (int l = 0; l < 2; ++l) {
        const int pb = 3 + 10 * l;
#define LF ({ int l_ = l; asm volatile("" : "+s"(l_)); l_; })
        if (IN(pb + 0)) {
            const int ll = LF; KA_FRESH(C); pg8::Gemm g{WSP(bf16, WS_H), WSP(bf16, WS_WIN + ll * WIN_L), MP, 6144, DM}; pg8::StaticOrder S; S.init(MP, 6144, C.G, C.bid); S.rep = REPN(1);
            EpiIn E{WSP(bf16, WS_PROJ), OUTB, ll};
            pg8::gemm_phase<EpiIn, pg8::StaticOrder, true, true>(C.lds, g, S, E);
            for (int su = C.bid; su < 216; su += C.G) sample_gemm_unit<0>(C, WSP(bf16, WS_H) + (size_t)MP * DM, WSP(bf16, WS_WIN + ll * WIN_L), DM, su * 32, ll);

        }
        SEAM(pb + 0);
        if (IN(pb + 1)) {
            { const int ll = LF; unsigned* q3 = ctl + CW_QUEUE + 64 * (8 + ll); volatile LAS unsigned* slot = (volatile LAS unsigned*)(C.lds + LDS_MISC) + 16;
              for (;;) {
                  if (C.tid == 0) *slot = __hip_atomic_fetch_add(q3, 1u, __ATOMIC_RELAXED, __HIP_MEMORY_SCOPE_AGENT);
                  __syncthreads();
                  const unsigned u = *slot;
                  __syncthreads();
                  if (u >= 808u) break;
                  if (u < 544u) gdn_prep_unit(C, ll, (int)u); else lru_unit(C, ll, (int)u - 544);
              }
            }
        }
        SEAM(pb + 1);
        if (IN(pb + 2)) { for (int rp = 0; rp < REPN(3); ++rp) phase_m4(C, LF, rp, kbar); }
        SEAM(pb + 2);
        if (IN(pb + 3)) { for (int rp = 0; rp < REPN(4); ++rp) phase_finalize(C, LF); }
        SEAM(pb + 3);
        if (IN(pb + 4)) {
            const int ll = LF; KA_FRESH(C); pg8::Gemm g{WSP(bf16, WS_MIX), WSP(bf16, WS_WOUT + ll * WOUT_L), MP, DM, DM}; pg8::StaticOrder S; S.init(MP, DM, C.G, C.bid); S.rep = REPN(1);
            EpiBf E{WSP(bf16, WS_MIXO), DM};
            pg8::gemm_phase<EpiBf, pg8::StaticOrder, true, true>(C.lds, g, S, E);
            for (int su = C.bid; su < 64; su += C.G) sample_gemm_unit<1>(C, WSP(bf16, WS_MIX) + (size_t)MP * DM, WSP(bf16, WS_WOUT + ll * WOUT_L), DM, su * 32, ll);
        }
        SEAM(pb + 4);
        if (IN(pb + 5)) { for (int rp = REPN(5) - 1; rp >= 0; --rp) phase_resid(C, LF, 0, rp > 0); }
        SEAM(pb + 5);
        if (IN(pb + 6)) {
            const int ll = LF; KA_FRESH(C); pg8::Gemm g{WSP(bf16, WS_H), WSP(bf16, WS_WUP + ll * WUP_L), MP, DUP, DM}; pg8::StaticOrder S; S.init(MP, DUP, C.G, C.bid); S.rep = REPN(1);
            EpiAct E{WSP(bf16, WS_ACT), WSP(float, WS_TAILG), WSP(float, WS_HEADG), WSP(float, WS_HEADV), C.in(35) + (size_t)ll * 3 * DFF, C.in(36) + (size_t)ll * DFF};
            pg8::gemm_phase<EpiAct, pg8::StaticOrder, true, true>(C.lds, g, S, E);
            if (C.bid >= 128) for (int su = C.bid - 128; su < 352; su += 128) sample_gemm_unit<2>(C, WSP(bf16, WS_H) + (size_t)MP * DM, WSP(bf16, WS_WUP + ll * WUP_L), DM, su * 32, ll);
            if (TAILCONV && ll == 1 && C.bid >= 128) { conv_weights(C, 1, 3, (C.bid - 128) * NWAVES + C.wave, 128 * NWAVES); __syncthreads(); }

        }
        SEAM(pb + 6);
        if (IN(pb + 7)) { for (int rp = 0; rp < REPN(4); ++rp) phase_act(C, LF); }
        SEAM(pb + 7);
        if (IN(pb + 8)) {
            const int ll = LF; KA_FRESH(C); pg8::Gemm g{WSP(bf16, WS_ACT), WSP(bf16, WS_WDN + ll * WDN_L), MP, DM, DFF}; pg8::StaticOrder S; S.init(MP, DM, C.G, C.bid); S.rep = REPN(1);
            EpiBf E{WSP(bf16, WS_MIXO), DM};
            pg8::gemm_phase<EpiBf, pg8::StaticOrder, true, true>(C.lds, g, S, E);
            for (int su = C.bid; su < 64; su += C.G) sample_gemm_unit<1>(C, WSP(bf16, WS_ACT) + (size_t)MP * DFF, WSP(bf16, WS_WDN + ll * WDN_L), DFF, su * 32, ll);
        }
        SEAM(pb + 8);
        if (IN(pb + 9)) { for (int rp = REPN(5) - 1; rp >= 0; --rp) phase_resid(C, LF, 1, rp > 0); }
        if (l == 0) SEAM(pb + 9);
    }
#undef IN
#undef SEAM
}

#ifndef MK_PER_PHASE
#define MK_PER_PHASE 0
#endif
extern "C" void kernel_launch(void* const* d_in, const int* in_sizes, int n_in, void* d_out, int out_size, void* d_ws, size_t ws_size, hipStream_t stream) {
    static int grid = 0;
    if (grid == 0) {
        if (n_in != 38 || out_size != (int)O_END || ws_size < WS_END) { fprintf(stderr, "kernel_launch: unexpected shapes: n_in %d out %d ws %zu\n", n_in, out_size, ws_size); grid = -1; return; }
        int dev = 0, cus = 0, per_cu = 0;
        if (hipGetDevice(&dev) != hipSuccess || hipDeviceGetAttribute(&cus, hipDeviceAttributeMultiprocessorCount, dev) != hipSuccess) { grid = -1; return; }
        if (hipFuncSetAttribute((const void*)hymba_fwd, hipFuncAttributeMaxDynamicSharedMemorySize, LDS_BYTES) != hipSuccess) { fprintf(stderr, "kernel_launch: hipFuncSetAttribute failed\n"); grid = -1; return; }
        if (hipOccupancyMaxActiveBlocksPerMultiprocessor(&per_cu, (const void*)hymba_fwd, NTHR, LDS_BYTES) != hipSuccess || per_cu < 1) { fprintf(stderr, "kernel_launch: occupancy query says %d\n", per_cu); }
        (void)hipGetLastError();
        grid = cus;
    }
    if (grid < 0) return;
    (void)hipMemsetAsync((char*)d_ws + WS_CTL, 0, CTL_ZERO_BYTES, stream);
    Args a{};
    for (int i = 0; i < 38; ++i) a.in[i] = d_in[i];
    a.out = (float*)d_out; a.ws = (unsigned char*)d_ws;
#if MK_PER_PHASE
    for (int p = 0; p < NPHASE; ++p) { a.ph_lo = p; a.ph_hi = p + 1; hipLaunchKernelGGL(hymba_fwd, dim3(grid), dim3(NTHR), LDS_BYTES, stream, a); }
#else
    a.ph_lo = 0; a.ph_hi = NPHASE;
    hipLaunchKernelGGL(hymba_fwd, dim3(grid), dim3(NTHR), LDS_BYTES, stream, a);
#endif
    const hipError_t le = hipPeekAtLastError();
    if (le != hipSuccess) fprintf(stderr, "kernel_launch: launch failed: %s\n", hipGetErrorName(le));
}
```

```cpp
#include <hip/hip_runtime.h>
#include <cstdio>
#include <cstdint>
namespace pg8 {
#define PG8_LAS __attribute__((address_space(3)))
typedef unsigned short bf16_t;
typedef short bf16x8 __attribute__((ext_vector_type(8)));
typedef float f32x4 __attribute__((ext_vector_type(4)));
typedef unsigned u32x4 __attribute__((ext_vector_type(4)));
constexpr int BM = 256, BK = 64, HALF = 128, HTB = HALF * BK * 2  , STAGE_BYTES = 8 * HTB, NXCD = 8, WGM = 8;

__host__ __device__ __forceinline__ int lds_byte(int r, int c) { const int st = (r >> 4) * 2 + (c >> 5), rr = r & 15, cc = c & 31, ob = rr * 64 + cc * 2; return st * 1024 + (ob ^ (((ob >> 9) & 1) << 5)); }
__host__ __device__ __forceinline__ void stage_rc(int b, int& R, int& C) { const int st = b / 1024, sb = b % 1024, swz = sb ^ (((sb >> 9) & 1) << 5); R = (st >> 1) * 16 + swz / 64; C = (st & 1) * 32 + (swz % 64) / 2; }
__host__ __device__ __forceinline__ int perm32(int rho) { const int n = rho >> 4, i = rho & 15; return 8 * (i >> 2) + 4 * n + (i & 3); }

struct Unit { int pm, pn; };
struct Gemm { const bf16_t* A; const bf16_t* Bt; int M, N, K; };

struct StaticOrder {
    int nM, nN, nwg, G, c, rep;
    __host__ __device__ void init(int M, int N, int G_, int c_) { nM = M / BM; nN = N / BM; nwg = nM * nN; G = G_; c = c_; rep = 1; }
    __host__ __device__ bool next(int i, Unit& u) const {
        const long L = (long)i * G + c; if (L >= (long)nwg * rep) return false;
        int wgid = (int)(L % nwg); { const int q = nwg / NXCD, r = nwg % NXCD, xcd = wgid % NXCD, off = wgid / NXCD; wgid = (xcd < r ? xcd * (q + 1) : r * (q + 1) + (xcd - r) * q) + off; }
        const int nig = WGM * nN, gid = wgid / nig, fm = gid * WGM, gsz = (nM - fm) < WGM ? (nM - fm) : WGM;
        u.pm = fm + ((wgid % nig) % gsz); u.pn = (wgid % nig) / gsz; return true;
    }
    __device__ __forceinline__ void a_ready(const Unit&) const {}
    __device__ __forceinline__ void done(const Unit&) const {}
};

__device__ __forceinline__ unsigned cvt_pk_bf16(float lo, float hi) { unsigned r; asm volatile("v_cvt_pk_bf16_f32 %0, %1, %2" : "=v"(r) : "v"(lo), "v"(hi)); return r; }
typedef float f32x2 __attribute__((ext_vector_type(2)));
template <class Epi, class Sched, bool ALIGN_EPI = false, bool SP2 = false>
__device__ __forceinline__ void gemm_phase(PG8_LAS unsigned char* lds, const Gemm g, const Sched& S, const Epi& E) {
    int tid_ = threadIdx.x; asm volatile("" : "+v"(tid_)); const int tid = tid_, wid = __builtin_amdgcn_readfirstlane(tid >> 6), lane = tid & 63, wr = wid >> 2, wc = wid & 3, fr = lane & 15, fq = lane >> 4;
    const int K = g.K, nt = K / BK;
    unsigned voffA[2], voffB[2];
#pragma unroll
    for (int i = 0; i < 2; ++i) { int R, C; stage_rc(tid * 16 + i * 8192, R, C); const int Rb = Epi::PERM ? ((R & ~31) + perm32(R & 31)) : R;
        voffA[i] = (unsigned)(R * K + C) * 2u; voffB[i] = (unsigned)(Rb * K + C) * 2u; }
    const size_t kstep = (size_t)(BK * 2);
    const size_t hstep = (size_t)HALF * K * 2;
    const size_t tstep = 2 * hstep;
    const unsigned ldsw = (unsigned)wid * 1024u;
    const int aoff = lds_byte(wr * 64 + fr, fq * 8), boff = lds_byte(wc * 32 + fr, fq * 8);
#define PG8_SA(b, h) (((b) * 2 + (h)) * HTB)
#define PG8_SB(b, h) ((4 + (b) * 2 + (h)) * HTB)
#define PG8_STAGE(bufoff, gbase, voff) do { _Pragma("unroll") for (int _i = 0; _i < 2; ++_i) \
        __builtin_amdgcn_global_load_lds((const unsigned*)((const char*)(gbase) + (voff)[_i]), (PG8_LAS unsigned*)(lds + (bufoff) + ldsw + _i * 8192), 16, 0, 0); } while (0)
#define PG8_LDA(dst, b, h) do { _Pragma("unroll") for (int m = 0; m < 4; ++m) _Pragma("unroll") for (int k = 0; k < 2; ++k) dst[m][k] = *(const PG8_LAS bf16x8*)(lds + PG8_SA(b, h) + aoff + m * 2048 + k * 1024); } while (0)
#define PG8_LDB(dst, b, h) do { _Pragma("unroll") for (int n = 0; n < 2; ++n) _Pragma("unroll") for (int k = 0; k < 2; ++k) dst[n][k] = *(const PG8_LAS bf16x8*)(lds + PG8_SB(b, h) + boff + n * 2048 + k * 1024); } while (0)
#define PG8_MMA(ai, bj, At, Bt) do { __builtin_amdgcn_s_setprio(1); _Pragma("unroll") for (int m = 0; m < 4; ++m) _Pragma("unroll") for (int n = 0; n < 2; ++n) _Pragma("unroll") for (int k = 0; k < 2; ++k) \
        acc[ai][bj][m][n] = __builtin_amdgcn_mfma_f32_16x16x32_bf16(Bt[n][k], At[m][k], acc[ai][bj][m][n], 0, 0, 0); __builtin_amdgcn_s_setprio(0); } while (0)
#define PG8_WAIT_V(n) asm volatile("s_waitcnt vmcnt(" #n ")" ::: "memory")
#define PG8_WAIT_L(n) asm volatile("s_waitcnt lgkmcnt(" #n ")" ::: "memory")
#define PG8_BAR __builtin_amdgcn_s_barrier()
#define PG8_SCHED __builtin_amdgcn_sched_barrier(0)
    Unit cur, nxt; int ui = 0;
    if (!S.next(0, cur)) return;
    f32x4 acc[2][2][4][2];
#pragma unroll
    for (int a = 0; a < 2; ++a)
#pragma unroll
        for (int b = 0; b < 2; ++b)
#pragma unroll
            for (int m = 0; m < 4; ++m)
#pragma unroll
                for (int n = 0; n < 2; ++n) acc[a][b][m][n] = (f32x4){0.f, 0.f, 0.f, 0.f};
    bf16x8 At[4][2], B0[2][2], B1[2][2];
    const char* cA = (const char*)g.A + (size_t)cur.pm * tstep; const char* cB = (const char*)g.Bt + (size_t)cur.pn * tstep;
    S.a_ready(cur);
    if constexpr (SP2) {
        PG8_STAGE(PG8_SB(0, 0), cB, voffB); PG8_STAGE(PG8_SB(0, 1), cB + hstep, voffB); PG8_STAGE(PG8_SA(0, 0), cA, voffA); PG8_STAGE(PG8_SA(0, 1), cA + hstep, voffA);
        if (wr == 1) PG8_BAR;
        PG8_WAIT_V(2); PG8_BAR;
        PG8_STAGE(PG8_SB(1, 0), cB + kstep, voffB); PG8_STAGE(PG8_SA(1, 0), cA + kstep, voffA); PG8_STAGE(PG8_SB(1, 1), cB + hstep + kstep, voffB);
        PG8_WAIT_V(6); PG8_BAR;
    } else {
        PG8_STAGE(PG8_SB(0, 0), cB, voffB); PG8_STAGE(PG8_SA(0, 0), cA, voffA); PG8_STAGE(PG8_SB(0, 1), cB + hstep, voffB); PG8_STAGE(PG8_SA(0, 1), cA + hstep, voffA);
        if (wr == 1) PG8_BAR;
        PG8_WAIT_V(4); PG8_BAR;
        PG8_STAGE(PG8_SB(1, 0), cB + kstep, voffB); PG8_STAGE(PG8_SA(1, 0), cA + kstep, voffA); PG8_STAGE(PG8_SB(1, 1), cB + hstep + kstep, voffB);
        PG8_WAIT_V(6); PG8_BAR;
    }
    for (;;) {
        const bool has_next = S.next(ui + 1, nxt);
        const char* nA = has_next ? (const char*)g.A + (size_t)nxt.pm * tstep : cA; const char* nB = has_next ? (const char*)g.Bt + (size_t)nxt.pn * tstep : cB;
        for (int t = 0; t < nt; t += 2) {
            const bool last = (t == nt - 2);
            const char* a1 = cA + (size_t)(t + 1) * kstep;
            const char* a2 = last ? nA : cA + (size_t)(t + 2) * kstep; const char* b2 = last ? nB : cB + (size_t)(t + 2) * kstep;
            const char* a3 = a2 + kstep; const char* b3 = b2 + kstep;
            if (last && has_next) S.a_ready(nxt);
            if constexpr (SP2) {
            PG8_LDB(B0, 0, 0); PG8_LDB(B1, 0, 1); PG8_SCHED; PG8_LDA(At, 0, 0); PG8_STAGE(PG8_SA(1, 1), a1 + hstep, voffA);
            PG8_WAIT_V(8); PG8_WAIT_L(0); PG8_BAR; PG8_MMA(0, 0, At, B0); PG8_MMA(0, 1, At, B1); PG8_BAR; PG8_SCHED;
            PG8_LDA(At, 0, 1); PG8_STAGE(PG8_SB(0, 0), b2, voffB); PG8_STAGE(PG8_SB(0, 1), b2 + hstep, voffB); PG8_STAGE(PG8_SA(0, 0), a2, voffA);
            PG8_WAIT_V(8); PG8_WAIT_L(0); PG8_BAR; PG8_MMA(1, 0, At, B0); PG8_MMA(1, 1, At, B1); PG8_BAR; PG8_SCHED;
            PG8_LDB(B0, 1, 0); PG8_LDB(B1, 1, 1); PG8_SCHED; PG8_LDA(At, 1, 0); PG8_STAGE(PG8_SA(0, 1), a2 + hstep, voffA);
            PG8_WAIT_V(8); PG8_WAIT_L(0); PG8_BAR; PG8_MMA(0, 0, At, B0); PG8_MMA(0, 1, At, B1); PG8_BAR; PG8_SCHED;
            PG8_LDA(At, 1, 1); PG8_STAGE(PG8_SB(1, 0), b3, voffB); PG8_STAGE(PG8_SB(1, 1), b3 + hstep, voffB); PG8_STAGE(PG8_SA(1, 0), a3, voffA);
            PG8_WAIT_V(8); PG8_WAIT_L(0); PG8_BAR; PG8_MMA(1, 0, At, B0); PG8_MMA(1, 1, At, B1); PG8_BAR; PG8_SCHED;
            } else {
            PG8_LDB(B0, 0, 0); PG8_SCHED; PG8_LDA(At, 0, 0); PG8_STAGE(PG8_SA(1, 1), a1 + hstep, voffA);
            PG8_WAIT_L(8); PG8_BAR; PG8_WAIT_L(0); PG8_MMA(0, 0, At, B0); PG8_BAR; PG8_SCHED;
            PG8_LDB(B1, 0, 1); PG8_STAGE(PG8_SB(0, 0), b2, voffB);
            PG8_BAR; PG8_WAIT_L(0); PG8_MMA(0, 1, At, B1); PG8_BAR;
            PG8_LDA(At, 0, 1); PG8_STAGE(PG8_SA(0, 0), a2, voffA);
            PG8_BAR; PG8_WAIT_L(0); PG8_MMA(1, 0, At, B0); PG8_BAR; PG8_SCHED;
            PG8_STAGE(PG8_SB(0, 1), b2 + hstep, voffB);
            PG8_WAIT_V(6); PG8_BAR; PG8_MMA(1, 1, At, B1); PG8_BAR;
            PG8_LDB(B0, 1, 0); PG8_SCHED; PG8_LDA(At, 1, 0); PG8_STAGE(PG8_SA(0, 1), a2 + hstep, voffA);
            PG8_WAIT_L(8); PG8_BAR; PG8_WAIT_L(0); PG8_MMA(0, 0, At, B0); PG8_BAR; PG8_SCHED;
            PG8_LDB(B1, 1, 1); PG8_STAGE(PG8_SB(1, 0), b3, voffB);
            PG8_BAR; PG8_WAIT_L(0); PG8_MMA(0, 1, At, B1); PG8_BAR;
            PG8_LDA(At, 1, 1); PG8_STAGE(PG8_SA(1, 0), a3, voffA);
            PG8_BAR; PG8_WAIT_L(0); PG8_MMA(1, 0, At, B0); PG8_BAR; PG8_SCHED;
            PG8_STAGE(PG8_SB(1, 1), b3 + hstep, voffB);
            PG8_WAIT_V(6); PG8_BAR; PG8_MMA(1, 1, At, B1); PG8_BAR;
            }
        }
        if constexpr (ALIGN_EPI) { if (wr == 0) PG8_BAR; }
        if constexpr (!Epi::AFTER_DRAIN) { E(acc, cur, wr, wc, fr, fq); S.done(cur); }
        if (!has_next) break;
#pragma unroll
        for (int a = 0; a < 2; ++a)
#pragma unroll
            for (int b = 0; b < 2; ++b)
#pragma unroll
                for (int m = 0; m < 4; ++m)
#pragma unroll
                    for (int n = 0; n < 2; ++n) acc[a][b][m][n] = (f32x4){0.f, 0.f, 0.f, 0.f};
        cur = nxt; cA = nA; cB = nB; ++ui;
        if constexpr (ALIGN_EPI) { if (wr == 1) PG8_BAR; }
    }
    PG8_WAIT_V(0);
    if constexpr (!ALIGN_EPI) { if (wr == 0) PG8_BAR; }
    PG8_BAR;
    if constexpr (Epi::AFTER_DRAIN) { E.fused(acc, cur, wr, wc, fr, fq, lds, wid, lane); S.done(cur); }
#undef PG8_SA
#undef PG8_SB
#undef PG8_STAGE
#undef PG8_LDA
#undef PG8_LDB
#undef PG8_MMA
#undef PG8_WAIT_V
#undef PG8_WAIT_L
#undef PG8_BAR
#undef PG8_SCHED
}
}
#define LAS __attribute__((address_space(3)))
#define XB_TMO      128
#define XB_XCNT(j)  (256  + 64 * (j))
#define XB_XSUB(j)  (1280 + 64 * (j))
#define XB_XGEN(j)  (2304 + 64 * (j))
#define XB_TOP      3328
#define XB_TOPGEN   3392
#define XCD_BAR_WORDS 3456
#define XB_SPIN_CAP (1u << 18)

__device__ __forceinline__ unsigned xb_ld(unsigned* p)              { return __hip_atomic_load(p, __ATOMIC_RELAXED, __HIP_MEMORY_SCOPE_AGENT); }
__device__ __forceinline__ unsigned xb_add(unsigned* p, unsigned v) { return __hip_atomic_fetch_add(p, v, __ATOMIC_RELAXED, __HIP_MEMORY_SCOPE_AGENT); }
__device__ __forceinline__ unsigned xb_xcc_id() { return (unsigned)__builtin_amdgcn_s_getreg((3 << 11) | 20) & 0xFu; }
#define XB_SPIN(cond, bar) do { unsigned _sp = 0; while (cond) { __builtin_amdgcn_s_sleep(1); \
    if ((++_sp & 255u) == 0u) { if (xb_ld(&(bar)[XB_TMO])) break; if (_sp > XB_SPIN_CAP) { atomicAdd(&(bar)[XB_TMO], 1u); break; } } } } while (0)

struct XcdBarrier {
    unsigned* bar; unsigned x;
    volatile LAS unsigned* st;
};

__device__ __forceinline__ XcdBarrier xcd_barrier_post(unsigned* bar, volatile LAS unsigned* st) {
    XcdBarrier b; b.bar = bar; b.x = xb_xcc_id(); b.st = st;
    if (threadIdx.x == 0) (void)xb_add(&bar[XB_XCNT(b.x)], 1u);
    return b;
}
__device__ __forceinline__ void xcd_barrier_complete(unsigned* bar, unsigned x, unsigned& nloc, unsigned& nx) {
    const unsigned G = gridDim.x * gridDim.y * gridDim.z;
    unsigned sum, cnt, mine, sp = 0u;
    for (;;) {
        sum = 0u; cnt = 0u; mine = 0u;
#pragma unroll
        for (unsigned j = 0; j < 16; ++j) { const unsigned c = xb_ld(&bar[XB_XCNT(j)]); sum += c; cnt += (c > 0u) ? 1u : 0u; mine = (j == x) ? c : mine; }
        if (sum == G) break;
        __builtin_amdgcn_s_sleep(1);
        if ((++sp & 255u) == 0u) { if (xb_ld(&bar[XB_TMO])) break; if (sp > XB_SPIN_CAP) { atomicAdd(&bar[XB_TMO], 1u); break; } }
    }
    nloc = mine > 0u ? mine : 1u; nx = cnt > 0u ? cnt : 1u;
}

__device__ __forceinline__ void xcd_barrier(const XcdBarrier& b) {
    asm volatile("s_waitcnt vmcnt(0)" ::: "memory");
    __syncthreads();
    if (threadIdx.x == 0) {
        unsigned* bar = b.bar;
        __builtin_amdgcn_s_waitcnt(0);
        unsigned nloc = b.st[0], nx = b.st[1];
        if (nloc == 0u) { xcd_barrier_complete(bar, b.x, nloc, nx); b.st[0] = nloc; b.st[1] = nx; }
        const unsigned old = xb_add(&bar[XB_XSUB(b.x)], 1u);
        const unsigned gen = old / nloc;
        if (old + 1u == (gen + 1u) * nloc) {
            __builtin_amdgcn_fence(__ATOMIC_RELEASE, "agent");
            asm volatile("s_waitcnt vmcnt(0)" ::: "memory");
            const unsigned og = xb_add(&bar[XB_TOP], 1u);
            const unsigned tg = og / nx;
            if (og + 1u == (tg + 1u) * nx) xb_add(&bar[XB_TOPGEN], 1u);
            else XB_SPIN(xb_ld(&bar[XB_TOPGEN]) == tg, bar);
            __builtin_amdgcn_fence(__ATOMIC_ACQUIRE, "agent");
            xb_add(&bar[XB_XGEN(b.x)], 1u);
            asm volatile("s_waitcnt vmcnt(0)" ::: "memory");
        } else {
            XB_SPIN(xb_ld(&bar[XB_XGEN(b.x)]) == gen, bar);
            __builtin_amdgcn_fence(__ATOMIC_ACQUIRE, "agent");
            asm volatile("s_waitcnt vmcnt(0)" ::: "memory");
        }
    }
    __syncthreads();
}

#ifndef TP
#define TP 0xffff
#endif
#ifndef TAILCONV
#define TAILCONV 0
#endif
#ifndef REPMASK
#define REPMASK 0
#endif
#ifndef RN
#define RN 2
#endif
#define REPN(bit) (((REPMASK >> (bit)) & 1) ? RN : 1)
#define GAS __attribute__((address_space(1)))
#ifndef LAS
#define LAS __attribute__((address_space(3)))
#endif
typedef unsigned short bf16;
typedef unsigned v4u __attribute__((ext_vector_type(4)));
typedef unsigned v2u __attribute__((ext_vector_type(2)));
typedef float f32x4 __attribute__((ext_vector_type(4)));
typedef float f32x16 __attribute__((ext_vector_type(16)));
typedef short bf16x8 __attribute__((ext_vector_type(8)));

constexpr int NWAVES = 8, NTHR = 512;
constexpr int DM = 2048, MP = 8192, MS = 64, MR = 8256, MPAD = 8448;
constexpr int DINP = 6912, DFF = 5632, DUP = 11264, PP = 6912  ;
constexpr int C_AX = 0, C_AG = 512, C_Q = 1024, C_K = 1536, C_V = 2048, C_GQ = 2560, C_B = 5632, C_A = 5640, C_Z = 5888;
constexpr float EPS = 1e-6f;
constexpr float LOG2E = 1.4426950408889634f;
constexpr float QSCALE = 0.125f * LOG2E;

constexpr size_t O_Y = 0;
constexpr size_t O_KP = (size_t)MR * DM;
constexpr size_t O_VP = O_KP + (size_t)2 * 4 * 2048 * 512;
constexpr size_t O_KS = O_VP + (size_t)2 * 4 * 2048 * 512;
constexpr size_t O_VS = O_KS + (size_t)2 * 64 * 512;
constexpr size_t O_LCP = O_VS + (size_t)2 * 64 * 512;
constexpr size_t O_LCS = O_LCP + (size_t)2 * 4 * 3 * 512;
constexpr size_t O_LHP = O_LCS + (size_t)2 * 8 * 3 * 512;
constexpr size_t O_LHS = O_LHP + (size_t)2 * 4 * 512;
constexpr size_t O_GCP = O_LHS + (size_t)2 * 8 * 512;
constexpr size_t O_GCS = O_GCP + (size_t)2 * 4 * 3 * 3072;
constexpr size_t O_GP = O_GCS + (size_t)2 * 8 * 3 * 3072;
constexpr size_t O_GS = O_GP + (size_t)2 * 4 * 8 * 128 * 128;
constexpr size_t O_FCP = O_GS + (size_t)2 * 8 * 8 * 128 * 128;
constexpr size_t O_FCS = O_FCP + (size_t)2 * 4 * 2 * 5632;
constexpr size_t O_END = O_FCS + (size_t)2 * 8 * 2 * 5632;
static_assert(O_END == 37502976, "output size");

constexpr size_t MiB = 1u << 20;
constexpr size_t WS_CTL = 0, CTL_ZERO_BYTES = 65536;
constexpr size_t WS_WIN = 1 * MiB;
constexpr size_t WS_WOUT = 55 * MiB;
constexpr size_t WS_WUP = 71 * MiB;
constexpr size_t WS_WDN = 159 * MiB;
constexpr size_t WS_MODP = 203 * MiB;
constexpr size_t WS_MOD = 208 * MiB;
constexpr size_t WS_H = 210 * MiB;
constexpr size_t WS_PROJ = 243 * MiB;
constexpr size_t WS_LH = 355 * MiB;
constexpr size_t WS_LA = 372 * MiB;
constexpr size_t WS_CARRY = 389 * MiB;
constexpr size_t WS_WF = 391 * MiB;
constexpr size_t WS_QEF = 408 * MiB;
constexpr size_t WS_KDF = 425 * MiB;
constexpr size_t WS_QKF = 442 * MiB;
constexpr size_t WS_UF = 451 * MiB;
constexpr size_t WS_GL = 485 * MiB;
constexpr size_t WS_OGDN = 486 * MiB;
constexpr size_t WS_OATT = 519 * MiB;
constexpr size_t WS_SPO = 536 * MiB;
constexpr size_t WS_SPT = 541 * MiB;
constexpr size_t WS_MIX = 542 * MiB;
constexpr size_t WS_MIXO = 575 * MiB;
constexpr size_t WS_GV = 641 * MiB;
constexpr size_t WS_ACT = 823 * MiB;
constexpr size_t WS_TAILG = 914 * MiB;
constexpr size_t WS_HEADG = 920 * MiB;
constexpr size_t WS_HEADV = 926 * MiB;
constexpr size_t WS_END = 932 * MiB;
constexpr size_t WIN_L = (size_t)DINP * DM * 2, WOUT_L = (size_t)DM * DM * 2, WUP_L = (size_t)DUP * DM * 2, WDN_L = (size_t)DM * DFF * 2;

constexpr int CW_BAR = 4096;
constexpr int CW_QUEUE = 8192;

constexpr int LDS_MISC = 147456;
constexpr int LDS_BYTES = 148480;

constexpr int NPHASE = 23;
template <int CTRL> __device__ __forceinline__ float dppf(float x) { return __builtin_bit_cast(float, __builtin_amdgcn_mov_dpp(__builtin_bit_cast(int, x), CTRL, 0xf, 0xf, true)); }

#define LDS_WAIT() asm volatile("s_waitcnt lgkmcnt(0)" ::: "memory")
__device__ __forceinline__ float bf2f(unsigned short u) { return __uint_as_float((unsigned)u << 16); }
__device__ __forceinline__ float bflo(unsigned u) { return __uint_as_float(u << 16); }
__device__ __forceinline__ float bfhi(unsigned u) { return __uint_as_float(u & 0xffff0000u); }
__device__ __forceinline__ unsigned cvtpk(float lo, float hi) {
    typedef float f2_t __attribute__((ext_vector_type(2))); typedef __bf16 b2_t __attribute__((ext_vector_type(2)));
    f2_t v = {lo, hi}; b2_t b = __builtin_convertvector(v, b2_t); return __builtin_bit_cast(unsigned, b); }
__device__ __forceinline__ unsigned short f2bf(float f) { return (unsigned short)(cvtpk(f, 0.f) & 0xffffu); }
__device__ __forceinline__ float wave_sum(float v) {
#pragma unroll
    for (int o = 1; o < 64; o <<= 1) v += __shfl_xor(v, o);
    return v;
}
__device__ __forceinline__ float sigmoidf_(float x) { return __builtin_amdgcn_rcpf(1.0f + __builtin_amdgcn_exp2f(-1.4426950408889634f * x)); }
__device__ __forceinline__ float siluf_(float x) { return x * __builtin_amdgcn_rcpf(1.0f + __builtin_amdgcn_exp2f(-1.4426950408889634f * x)); }
__device__ __forceinline__ float softplusf_(float x) {
    const float t = __builtin_amdgcn_exp2f(-1.4426950408889634f * fabsf(x));
    const float series = t * (1.0f - t * (0.5f - t * (0.33333334f - t * (0.25f - 0.2f * t))));
    const float lg = 0.6931471805599453f * __builtin_amdgcn_logf(1.0f + t);
    return fmaxf(x, 0.f) + (t < 0.03125f ? series : lg);
}
__device__ __forceinline__ float gelu_tanh(float x) { const float u = 0.7978845608028654f * (x + 0.044715f * x * x * x); return x * sigmoidf_(2.0f * u); }
__device__ __forceinline__ int crow(int r, int hi) { return (r & 3) + 8 * (r >> 2) + 4 * hi; }
__device__ __forceinline__ int seq_row0(int s) { return s < 4 ? s * 2048 : 8192 + (s - 4) * 8; }

typedef const __attribute__((address_space(4))) unsigned long long* kptr_t;
struct Ctx {
    kptr_t kp;
    GAS float* out; GAS unsigned char* ws;
    LAS unsigned char* lds;
    int tid, lane, wave, G, bid;
    __device__ __forceinline__ const float* in(int i) const { return (const float*)(GAS const float*)kp[i]; }
};
#define KA_FRESH(C) do { asm volatile("" : "+s"((C).kp)); asm volatile("" : "+s"((C).ws)); asm volatile("" : "+s"((C).out)); asm volatile("" : "+v"((C).tid)); (C).lane = (C).tid & 63; (C).wave = __builtin_amdgcn_readfirstlane((C).tid >> 6); } while (0)
#define WSP(T, off) ((T*)(GAS T*)(C.ws + (off)))
#define OUTB ((float*)C.out)

__device__ __forceinline__ void tr_item(const float* __restrict__ W, int K, int Nsrc, int sc0, int nv, bf16* WT, int n0, int k0, LAS float* scr, int lane) {
    const float* src = W + (size_t)k0 * Nsrc + sc0 + lane;
    const bool ok = lane < nv;
#pragma unroll 32
    for (int i = 0; i < 64; ++i) { const float v = ok ? __builtin_nontemporal_load(src + (size_t)i * Nsrc) : 0.f; scr[i * 65 + lane] = v; }
    LDS_WAIT(); asm volatile("" ::: "memory");
    const int c = lane & 7;
#pragma unroll
    for (int j = 0; j < 8; ++j) { const int n = (lane >> 3) + 8 * j; const LAS float* s = scr + (8 * c) * 65 + n;
        v4u o; o.x = cvtpk(s[0 * 65], s[1 * 65]); o.y = cvtpk(s[2 * 65], s[3 * 65]); o.z = cvtpk(s[4 * 65], s[5 * 65]); o.w = cvtpk(s[6 * 65], s[7 * 65]);
        __builtin_nontemporal_store(o, (GAS v4u*)(WT + (size_t)(n0 + n) * K + k0 + 8 * c)); }
    LDS_WAIT(); asm volatile("" ::: "memory");
}

struct ConvItem { const float* src; size_t stride; bool ok; bf16* dst; int K; };
__device__ __forceinline__ ConvItem conv_item(Ctx& C, int l, int kind, int r, int lane) {
    ConvItem it;
    if (kind == 0) { const int nb = r >> 5, kb = r & 31; const int n0 = nb * 64;
        int sc0, nv; if (n0 < 5632) { sc0 = n0; nv = 64; } else if (n0 == 5632) { sc0 = 6656; nv = 16; } else if (n0 < 5888) { sc0 = 0; nv = 0; } else { sc0 = 5632 + (n0 - 5888); nv = 64; }
        it.src = C.in(18) + (size_t)l * DM * 6672 + (size_t)(kb * 64) * 6672 + sc0 + lane; it.stride = 6672; it.ok = lane < nv; it.K = DM; it.dst = WSP(bf16, WS_WIN + l * WIN_L) + (size_t)n0 * DM + kb * 64;
    } else if (kind == 1) { const int nb = r >> 5, kb = r & 31;
        it.src = C.in(33) + (size_t)l * DM * DM + (size_t)(kb * 64) * DM + nb * 64 + lane; it.stride = DM; it.ok = true; it.K = DM; it.dst = WSP(bf16, WS_WOUT + l * WOUT_L) + (size_t)(nb * 64) * DM + kb * 64;
    } else if (kind == 2) { const int nb = r >> 5, kb = r & 31; const int n0 = nb * 64; const int pn = n0 >> 8, bj = (n0 >> 7) & 1, c0 = n0 & 127;
        it.src = C.in(34) + (size_t)l * DM * DUP + (size_t)(kb * 64) * DUP + bj * DFF + pn * 128 + c0 + lane; it.stride = DUP; it.ok = true; it.K = DM; it.dst = WSP(bf16, WS_WUP + l * WUP_L) + (size_t)n0 * DM + kb * 64;
    } else { const int nb = r / 88, kb = r % 88;
        it.src = C.in(37) + (size_t)l * DFF * DM + (size_t)(kb * 64) * DM + nb * 64 + lane; it.stride = DM; it.ok = true; it.K = DFF; it.dst = WSP(bf16, WS_WDN + l * WDN_L) + (size_t)(nb * 64) * DFF + kb * 64;
    }
    return it;
}
__device__ __forceinline__ void conv_weights(Ctx& C, int l, int kind, int wi, int iend, int wn) {
    KA_FRESH(C);
    LAS float* scr = (LAS float*)(C.lds + C.wave * 16640);
    const int lane = C.lane;
    const int nitems = iend;
    float v[64];
    ConvItem cur;
    if (wi < nitems) { cur = conv_item(C, l, kind, wi, lane);
#pragma unroll
        for (int i = 0; i < 64; ++i) v[i] = cur.ok ? __builtin_nontemporal_load(cur.src + (size_t)i * cur.stride) : 0.f; }
#pragma unroll 1
    for (int r = wi; r < nitems; r += wn) {
#pragma unroll
        for (int i = 0; i < 64; ++i) scr[i * 65 + lane] = v[i];
        asm volatile("" ::: "memory");
        bf16* dst = cur.dst; const int K = cur.K;
        if (r + wn < nitems) { cur = conv_item(C, l, kind, r + wn, lane);
#pragma unroll
            for (int i = 0; i < 64; ++i) v[i] = cur.ok ? __builtin_nontemporal_load(cur.src + (size_t)i * cur.stride) : 0.f; }
        const int c = lane & 7;
#pragma unroll
        for (int j = 0; j < 8; ++j) { const int n = (lane >> 3) + 8 * j; const LAS float* s = scr + (8 * c) * 65 + n;
            v4u o; o.x = cvtpk(s[0 * 65], s[1 * 65]); o.y = cvtpk(s[2 * 65], s[3 * 65]); o.z = cvtpk(s[4 * 65], s[5 * 65]); o.w = cvtpk(s[6 * 65], s[7 * 65]);
            __builtin_nontemporal_store(o, (GAS v4u*)(dst + (size_t)n * K + 8 * c)); }
        asm volatile("" ::: "memory");
    }
}
__device__ __forceinline__ int conv_units(int ll) { return ll == 0 ? 202 : 148; }
__device__ __forceinline__ void conv_unit(Ctx& C, int ll, int cu) {
    int l = ll, kind, r0;
    if (cu < 16) { kind = 1; r0 = cu * 64; } else if (cu < 104) { kind = 2; r0 = (cu - 16) * 64; } else if (cu < 148) { kind = 3; r0 = (cu - 104) * 64; } else { l = 1; kind = 0; r0 = (cu - 148) * 64; }
    conv_weights(C, l, kind, r0 + C.wave, r0 + 64, NWAVES);
}
__device__ __forceinline__ void p0_weights(Ctx& C) {
    const int wi = C.bid * NWAVES + C.wave, wn = C.G * NWAVES;
    conv_weights(C, 0, 0, wi, 108 * 32, wn);
}

__device__ __forceinline__ void p0_ada(Ctx& C) {
    KA_FRESH(C);
    LAS float* sc = (LAS float*)C.lds;
    __syncthreads();
    for (int k = C.tid; k < DM; k += NTHR) {
#pragma unroll
        for (int r = 0; r < 12; ++r) { const float c = (r < 4) ? C.in(2)[r * DM + k] : C.in(3)[(r - 4) * DM + k]; sc[k * 16 + r] = siluf_(c); }
    }
    __syncthreads();
    const int gw = C.bid * NWAVES + C.wave, NGW = C.G * NWAVES;
    for (int task = gw; task < 2 * 192 * 4; task += NGW) {
        const int l = task / 768, rem = task % 768, nb = rem >> 2, ks = rem & 3;
        const int n = nb * 64 + C.lane;
        const float* w = C.in(12) + ((size_t)l * DM + ks * 512) * 12288 + n;
        typedef float f2a __attribute__((ext_vector_type(2)));
        f2a ac[6];
#pragma unroll
        for (int r = 0; r < 6; ++r) ac[r] = (f2a){0.f, 0.f};
#pragma unroll 8
        for (int k = 0; k < 512; ++k) {
            const float wv = w[(size_t)k * 12288]; const f2a w2 = {wv, wv};
            const LAS f32x4* s = (const LAS f32x4*)(sc + (ks * 512 + k) * 16);
            const f32x4 s0 = s[0], s1 = s[1], s2 = s[2];
            ac[0] = __builtin_elementwise_fma((f2a){s0.x, s0.y}, w2, ac[0]); ac[1] = __builtin_elementwise_fma((f2a){s0.z, s0.w}, w2, ac[1]);
            ac[2] = __builtin_elementwise_fma((f2a){s1.x, s1.y}, w2, ac[2]); ac[3] = __builtin_elementwise_fma((f2a){s1.z, s1.w}, w2, ac[3]);
            ac[4] = __builtin_elementwise_fma((f2a){s2.x, s2.y}, w2, ac[4]); ac[5] = __builtin_elementwise_fma((f2a){s2.z, s2.w}, w2, ac[5]);
        }
        float acc[12];
#pragma unroll
        for (int r = 0; r < 6; ++r) { acc[2 * r] = ac[r].x; acc[2 * r + 1] = ac[r].y; }
        float* mp = WSP(float, WS_MODP) + ((size_t)(l * 4 + ks) * 12) * 12288 + n;
#pragma unroll
        for (int r = 0; r < 12; ++r) mp[(size_t)r * 12288] = acc[r];
    }
    __syncthreads();
}

__device__ __forceinline__ void p0b_modreduce(Ctx& C) {
    KA_FRESH(C);
    const int gt = C.bid * NTHR + C.tid, NGT = C.G * NTHR;
    const float* mp = WSP(float, WS_MODP); float* md = WSP(float, WS_MOD);
    for (int e = gt; e < 2 * 12 * 12288; e += NGT) {
        const int l = e / (12 * 12288), rem = e % (12 * 12288), n = rem % 12288;
        float s = C.in(13)[l * 12288 + n];
#pragma unroll
        for (int ks = 0; ks < 4; ++ks) s += mp[(size_t)(l * 4 + ks) * 12 * 12288 + rem];
        md[e] = s;
    }
}

__device__ __forceinline__ void store_h_row(bf16* hrow, const f32x4 (&v)[8], float rs, const float* g, const float* scale, const float* shift, int lane) {
#pragma unroll
    for (int j = 0; j < 8; ++j) { const int e = 4 * lane + 256 * j;
        const f32x4 gg = *(const f32x4*)(g + e), sc = *(const f32x4*)(scale + e), sh = *(const f32x4*)(shift + e);
        const float a = v[j].x * rs * gg.x * (1.f + sc.x) + sh.x, b = v[j].y * rs * gg.y * (1.f + sc.y) + sh.y;
        const float c = v[j].z * rs * gg.z * (1.f + sc.z) + sh.z, d = v[j].w * rs * gg.w * (1.f + sc.w) + sh.w;
        v2u o; o.x = cvtpk(a, b); o.y = cvtpk(c, d); *(GAS v2u*)(hrow + e) = o; }
}
__device__ __forceinline__ int row_seq(int row) { return row < MP ? (row >> 11) : 4 + ((row - MP) >> 3); }

__device__ __forceinline__ void phase_n1(Ctx& C) {
    KA_FRESH(C);
    const int gw = C.bid * NWAVES + C.wave, NGW = C.G * NWAVES;
    f32x4 nx[8];
    if (gw < MR) { const float* xr = gw < MP ? C.in(0) + (size_t)gw * DM : C.in(1) + (size_t)(gw - MP) * DM;
#pragma unroll
        for (int j = 0; j < 8; ++j) nx[j] = *(const f32x4*)(xr + 4 * C.lane + 256 * j); }
    for (int row = gw; row < MR; row += NGW) {
        f32x4 v[8]; float ss = 0.f;
#pragma unroll
        for (int j = 0; j < 8; ++j) { v[j] = nx[j]; ss += v[j].x * v[j].x + v[j].y * v[j].y + v[j].z * v[j].z + v[j].w * v[j].w; }
        asm volatile("" ::: "memory");
        { const int nrow = row + NGW; if (nrow < MR) { const float* xr = nrow < MP ? C.in(0) + (size_t)nrow * DM : C.in(1) + (size_t)(nrow - MP) * DM;
#pragma unroll
            for (int j = 0; j < 8; ++j) nx[j] = *(const f32x4*)(xr + 4 * C.lane + 256 * j); } }
        const float rs = rsqrtf(wave_sum(ss) * (1.f / DM) + EPS);
        const float* md = WSP(float, WS_MOD) + (size_t)(0 * 12 + row_seq(row)) * 12288;
        store_h_row(WSP(bf16, WS_H) + (size_t)row * DM, v, rs, C.in(14), md + 1 * DM, md + 0 * DM, C.lane);
    }
}

constexpr size_t WS_X16 = WS_MIXO + 33 * MiB;
template <bool FIRST> struct ResidIn { v2u fp[8]; v2u xp[8]; };
template <> struct ResidIn<true> { v2u fp[8]; f32x4 xp[8]; };
template <bool FIRST>
__device__ __forceinline__ void resid_load(Ctx& C, int row, const bf16* src, const bf16* X16, ResidIn<FIRST>& in) {
#pragma unroll
    for (int j = 0; j < 8; ++j) in.fp[j] = *(const v2u*)(src + (size_t)row * DM + 4 * C.lane + 256 * j);
    if constexpr (FIRST) {
        const float* xin = row < MP ? C.in(0) + (size_t)row * DM : C.in(1) + (size_t)(row - MP) * DM;
#pragma unroll
        for (int j = 0; j < 8; ++j) in.xp[j] = *(const f32x4*)(xin + 4 * C.lane + 256 * j);
    } else {
#pragma unroll
        for (int j = 0; j < 8; ++j) in.xp[j] = *(const v2u*)(X16 + (size_t)row * DM + 4 * C.lane + 256 * j);
    }
}
template <bool FIRST>
__device__ __forceinline__ void resid_rows(Ctx& C, int l, int which, bool dry, int row_lo, int nrows) {
    const bf16* src = WSP(bf16, WS_MIXO);
    bf16* X16 = WSP(bf16, WS_X16);
    const bool last = (l == 1 && which == 1);
    const bool has_h = (which == 0) || (l == 0);
    const int s = row_seq(row_lo);
    const float* md = WSP(float, WS_MOD) + (size_t)(l * 12 + s) * 12288;
    f32x4 gg[8]; v2u hsp[8], hbp[8];
    {
        const float* gate = md + (which == 0 ? 2 : 5) * DM;
        const float* gpost = (which == 0 ? C.in(15) : C.in(17)) + l * DM;
        const float* gpre = (which == 0) ? C.in(16) + l * DM : C.in(14) + 1 * DM;
        const float* mdn = (which == 0) ? md : WSP(float, WS_MOD) + (size_t)(1 * 12 + s) * 12288;
        const float* scale = mdn + (which == 0 ? 4 : 1) * DM; const float* shift = mdn + (which == 0 ? 3 : 0) * DM;
#pragma unroll
        for (int j = 0; j < 8; ++j) { const int e = 4 * C.lane + 256 * j;
            gg[j] = *(const f32x4*)(gate + e) * *(const f32x4*)(gpost + e);
            if (has_h) { const f32x4 a = *(const f32x4*)(gpre + e) * (*(const f32x4*)(scale + e) + 1.0f), b = *(const f32x4*)(shift + e);
                hsp[j].x = cvtpk(a.x, a.y); hsp[j].y = cvtpk(a.z, a.w); hbp[j].x = cvtpk(b.x, b.y); hbp[j].y = cvtpk(b.z, b.w); } else { hsp[j] = (v2u){0u, 0u}; hbp[j] = hsp[j]; } }
    }
    ResidIn<FIRST> in;
    resid_load<FIRST>(C, row_lo, src, X16, in);
    bf16* Ho = dry ? WSP(bf16, WS_GV) : WSP(bf16, WS_H);
#pragma unroll 1
    for (int r = 0; r < nrows; ++r) {
        const int row = row_lo + r;
        f32x4 f[8], xv[8]; float ss = 0.f;
#pragma unroll
        for (int j = 0; j < 8; ++j) { f[j].x = bflo(in.fp[j].x); f[j].y = bfhi(in.fp[j].x); f[j].z = bflo(in.fp[j].y); f[j].w = bfhi(in.fp[j].y);
            if constexpr (FIRST) xv[j] = in.xp[j]; else { xv[j].x = bflo(in.xp[j].x); xv[j].y = bfhi(in.xp[j].x); xv[j].z = bflo(in.xp[j].y); xv[j].w = bfhi(in.xp[j].y); } }
        asm volatile("" ::: "memory");
        if constexpr (!FIRST) { if (r + 1 < nrows) resid_load<FIRST>(C, row + 1, src, X16, in); }
#pragma unroll
        for (int j = 0; j < 8; ++j) ss += f[j].x * f[j].x + f[j].y * f[j].y + f[j].z * f[j].z + f[j].w * f[j].w;
        const float rs = rsqrtf(wave_sum(ss) * (1.f / DM) + EPS);
        float ss2 = 0.f;
#pragma unroll
        for (int j = 0; j < 8; ++j) { const int e = 4 * C.lane + 256 * j;
            const f32x4 o = xv[j] + (f[j] * gg[j]) * rs;
            if (!dry) { if (last) *(f32x4*)(OUTB + O_Y + (size_t)row * DM + e) = o; else { v2u w; w.x = cvtpk(o.x, o.y); w.y = cvtpk(o.z, o.w); *(GAS v2u*)(X16 + (size_t)row * DM + e) = w; } }
            f[j] = o; ss2 += o.x * o.x + o.y * o.y + o.z * o.z + o.w * o.w; }
        if (has_h) {
            const float rs2 = rsqrtf(wave_sum(ss2) * (1.f / DM) + EPS);
#pragma unroll
            for (int j = 0; j < 8; ++j) { const int e = 4 * C.lane + 256 * j; const f32x4 hs = {bflo(hsp[j].x), bfhi(hsp[j].x), bflo(hsp[j].y), bfhi(hsp[j].y)}, hb = {bflo(hbp[j].x), bfhi(hbp[j].x), bflo(hbp[j].y), bfhi(hbp[j].y)};
                const f32x4 h = (f[j] * rs2) * hs + hb;
                v2u o; o.x = cvtpk(h.x, h.y); o.y = cvtpk(h.z, h.w); *(GAS v2u*)(Ho + (size_t)row * DM + e) = o; }
        }
        if constexpr (FIRST) { if (r + 1 < nrows) resid_load<FIRST>(C, row + 1, src, X16, in); }
    }
}
template <bool FIRST>
__device__ __forceinline__ void phase_resid_t(Ctx& C, int l, int which, bool dry) {
    KA_FRESH(C);
    const int gw = C.bid * NWAVES + C.wave, NGW = C.G * NWAVES;
#pragma unroll 1
    for (int r0 = 4 * gw; r0 < MP; r0 += 4 * NGW) resid_rows<FIRST>(C, l, which, dry, r0, 4);
    if (gw < MS) resid_rows<FIRST>(C, l, which, dry, MP + gw, 1);
}
__device__ __forceinline__ void phase_resid(Ctx& C, int l, int which, bool dry = false) {
    if (l == 0 && which == 0) phase_resid_t<true>(C, l, which, dry); else phase_resid_t<false>(C, l, which, dry);
}

struct EpiIn {
    static constexpr bool PERM = true, AFTER_DRAIN = false;
    bf16* P; float* out; int layer;
    __device__ __forceinline__ void operator()(const pg8::f32x4 (&acc)[2][2][4][2], const pg8::Unit& u, int wr, int wc, int fr, int fq) const {
        const int pn = u.pn; const int row0 = u.pm * 256 + wr * 64 + fr; const int col0 = pn * 256 + wc * 32 + 8 * fq;
        const float sc = (pn == 4 || pn == 5) ? QSCALE : 1.f;
        const bool kv = (pn >= 6 && pn <= 9); const bool isv = pn >= 8; const int cbase = isv ? C_V : C_K;
#pragma unroll
        for (int ai = 0; ai < 2; ++ai)
#pragma unroll
            for (int m = 0; m < 4; ++m) { const int row = row0 + ai * 128 + m * 16;
#pragma unroll
                for (int bj = 0; bj < 2; ++bj) { const int col = col0 + bj * 128;
                    const pg8::f32x4 v0 = acc[ai][bj][m][0] * sc, v1 = acc[ai][bj][m][1] * sc;
                    v4u w; w.x = cvtpk(v0[0], v0[1]); w.y = cvtpk(v0[2], v0[3]); w.z = cvtpk(v1[0], v1[1]); w.w = cvtpk(v1[2], v1[3]);
                    *(GAS v4u*)(P + (size_t)row * PP + col) = w;
                    if (kv && row < MR) {
                        float* o = (row < MP) ? out + (isv ? O_VP : O_KP) + (size_t)layer * 4194304 + (size_t)row * 512 + (col - cbase)
                                              : out + (isv ? O_VS : O_KS) + (size_t)layer * 32768 + (size_t)(row - MP) * 512 + (col - cbase);
                        *(pg8::f32x4*)o = v0; *(pg8::f32x4*)(o + 4) = v1; }
                } }
    }
};
struct EpiBf {
    static constexpr bool PERM = true, AFTER_DRAIN = false;
    bf16* O; int ldc;
    __device__ __forceinline__ void operator()(const pg8::f32x4 (&acc)[2][2][4][2], const pg8::Unit& u, int wr, int wc, int fr, int fq) const {
        const int row0 = u.pm * 256 + wr * 64 + fr; const int col0 = u.pn * 256 + wc * 32 + 8 * fq;
#pragma unroll
        for (int ai = 0; ai < 2; ++ai)
#pragma unroll
            for (int m = 0; m < 4; ++m) { const int row = row0 + ai * 128 + m * 16;
#pragma unroll
                for (int bj = 0; bj < 2; ++bj) { const int col = col0 + bj * 128;
                    const pg8::f32x4 v0 = acc[ai][bj][m][0], v1 = acc[ai][bj][m][1];
                    v4u w; w.x = cvtpk(v0[0], v0[1]); w.y = cvtpk(v0[2], v0[3]); w.z = cvtpk(v1[0], v1[1]); w.w = cvtpk(v1[2], v1[3]);
                    *(GAS v4u*)(O + (size_t)row * ldc + col) = w; } }
    }
};
struct EpiF32 {
    static constexpr bool PERM = true, AFTER_DRAIN = false;
    float* O; int ldc;
    __device__ __forceinline__ void operator()(const pg8::f32x4 (&acc)[2][2][4][2], const pg8::Unit& u, int wr, int wc, int fr, int fq) const {
        const int row0 = u.pm * 256 + wr * 64 + fr; const int col0 = u.pn * 256 + wc * 32 + 8 * fq;
#pragma unroll
        for (int ai = 0; ai < 2; ++ai)
#pragma unroll
            for (int m = 0; m < 4; ++m) { const int row = row0 + ai * 128 + m * 16;
#pragma unroll
                for (int bj = 0; bj < 2; ++bj) { float* o = O + (size_t)row * ldc + col0 + bj * 128;
                    *(pg8::f32x4*)o = acc[ai][bj][m][0]; *(pg8::f32x4*)(o + 4) = acc[ai][bj][m][1]; } }
    }
};

struct EpiAct {
    static constexpr bool PERM = true, AFTER_DRAIN = false;
    bf16* ACT; float* tailg; float* headg; float* headv; const float* cw; const float* cb;
    __device__ __forceinline__ void operator()(const pg8::f32x4 (&acc)[2][2][4][2], const pg8::Unit& u, int wr, int wc, int fr, int fq) const {
        const int j0 = u.pn * 128 + wc * 32 + 8 * fq;
        float w0[8], w1[8], w2[8], bb[8];
#pragma unroll
        for (int h = 0; h < 2; ++h) { const f32x4 a = *(const f32x4*)(cw + j0 + 4 * h), b = *(const f32x4*)(cw + DFF + j0 + 4 * h), c = *(const f32x4*)(cw + 2 * DFF + j0 + 4 * h), d = *(const f32x4*)(cb + j0 + 4 * h);
#pragma unroll
            for (int e = 0; e < 4; ++e) { w0[4 * h + e] = a[e]; w1[4 * h + e] = b[e]; w2[4 * h + e] = c[e]; bb[4 * h + e] = d[e]; } }
#pragma unroll
        for (int ai = 0; ai < 2; ++ai) {
            const int rbase = u.pm * 256 + ai * 128 + wr * 64; const int rb = rbase >> 6;
#pragma unroll
            for (int m = 0; m < 4; ++m) {
                const int row = rbase + 16 * m + fr;
                float o[8];
#pragma unroll
                for (int e = 0; e < 8; ++e) {
                    const float g = acc[ai][0][m][e >> 2][e & 3], v = acc[ai][1][m][e >> 2][e & 3];
                    const float gp = (m > 0) ? acc[ai][0][m > 0 ? m - 1 : 0][e >> 2][e & 3] : 0.f;
                    const float p1 = dppf<0x121>(g), p2 = dppf<0x122>(g), q1 = dppf<0x121>(gp), q2 = dppf<0x122>(gp);
                    const float g1 = fr >= 1 ? p1 : q1, g2 = fr >= 2 ? p2 : q2;
                    const float y = bb[e] + w0[e] * g2 + w1[e] * g1 + w2[e] * g;
                    o[e] = siluf_(y) * v;
                }
                if (m > 0 || fr >= 2) { v4u w; w.x = cvtpk(o[0], o[1]); w.y = cvtpk(o[2], o[3]); w.z = cvtpk(o[4], o[5]); w.w = cvtpk(o[6], o[7]); *(GAS v4u*)(ACT + (size_t)row * DFF + j0) = w; }
                if (m == 0 && fr < 2) { float* hg = headg + (size_t)(rb * 2 + fr) * DFF + j0; float* hv = headv + (size_t)(rb * 2 + fr) * DFF + j0;
                    *(pg8::f32x4*)hg = acc[ai][0][0][0]; *(pg8::f32x4*)(hg + 4) = acc[ai][0][0][1]; *(pg8::f32x4*)hv = acc[ai][1][0][0]; *(pg8::f32x4*)(hv + 4) = acc[ai][1][0][1]; }
                if (m == 3 && fr >= 14) { float* tg = tailg + (size_t)(rb * 2 + (fr - 14)) * DFF + j0; *(pg8::f32x4*)tg = acc[ai][0][3][0]; *(pg8::f32x4*)(tg + 4) = acc[ai][0][3][1]; }
            }
        }
    }
};

template <int MODE>
__device__ __forceinline__ void sample_gemm_unit(Ctx& C, const bf16* A  , const bf16* Bt  , int K, int n0, int layer) {
    const int lane = C.lane, m = lane & 31, kh = lane >> 5, wave = C.wave;
    const int kw = K >> 3;
    const bf16* a0 = A + (size_t)m * K + wave * kw + 8 * kh; const bf16* a1 = a0 + (size_t)32 * K;
    const bf16* b0 = Bt + (size_t)(n0 + m) * K + wave * kw + 8 * kh;
    f32x16 acc0, acc1;
#pragma unroll
    for (int r = 0; r < 16; ++r) { acc0[r] = 0.f; acc1[r] = 0.f; }
#pragma unroll 1
    for (int k = 0; k < kw; k += 256) {
        bf16x8 fa0[16], fa1[16], fb[16];
#pragma unroll
        for (int s = 0; s < 16; ++s) { const bool ok = k + 16 * s < kw; const int ko = ok ? k + 16 * s : 0;
            fa0[s] = *(const bf16x8*)(a0 + ko); fa1[s] = *(const bf16x8*)(a1 + ko); fb[s] = *(const bf16x8*)(b0 + ko);
            if (!ok) { fb[s] = (bf16x8){0, 0, 0, 0, 0, 0, 0, 0}; } }
#pragma unroll
        for (int s = 0; s < 16; ++s) { acc0 = __builtin_amdgcn_mfma_f32_32x32x16_bf16(fa0[s], fb[s], acc0, 0, 0, 0); acc1 = __builtin_amdgcn_mfma_f32_32x32x16_bf16(fa1[s], fb[s], acc1, 0, 0, 0); }
    }
    LAS float* red = (LAS float*)C.lds;
#pragma unroll
    for (int r = 0; r < 16; ++r) { red[(wave * 64 + crow(r, kh)) * 32 + m] = acc0[r]; red[(wave * 64 + 32 + crow(r, kh)) * 32 + m] = acc1[r]; }
    __syncthreads();
    const int row = C.tid >> 3, c4 = (C.tid & 7) * 4;
    f32x4 v = {0.f, 0.f, 0.f, 0.f};
#pragma unroll
    for (int w = 0; w < 8; ++w) { const f32x4 t = *(const LAS f32x4*)(red + (w * 64 + row) * 32 + c4); v += t; }
    const int n = n0 + c4; const int grow = MP + row;
    if (MODE == 0) {
        if (n >= C_Q && n < C_K) v *= QSCALE;
        v2u o; o.x = cvtpk(v.x, v.y); o.y = cvtpk(v.z, v.w);
        *(GAS v2u*)(WSP(bf16, WS_PROJ) + (size_t)grow * PP + n) = o;
        if (n >= C_K && n < C_GQ) { const bool isv = n >= C_V; float* op = OUTB + (isv ? O_VS : O_KS) + (size_t)layer * 32768 + (size_t)row * 512 + (n - (isv ? C_V : C_K)); *(f32x4*)op = v; }
    } else if (MODE == 1) {
        v2u o; o.x = cvtpk(v.x, v.y); o.y = cvtpk(v.z, v.w);
        *(GAS v2u*)(WSP(bf16, WS_MIXO) + (size_t)grow * DM + n) = o;
    } else {
        v2u o; o.x = cvtpk(v.x, v.y); o.y = cvtpk(v.z, v.w);
        *(GAS v2u*)(WSP(bf16, WS_GV) + (size_t)grow * DUP + n) = o;
    }
    __syncthreads();
}

__device__ __forceinline__ void lru_unit(Ctx& C, int l, int u) {
    KA_FRESH(C);
    int seq, t0, nt, T;
    if (u < 256) { seq = u >> 6; t0 = (u & 63) * 32; nt = 32; T = 2048; } else { seq = 4 + (u - 256); t0 = 0; nt = 8; T = 8; }
    const int d = C.tid, n = C.wave, dd = d & 63;
    const int row0 = seq_row0(seq);
    const bf16* P = WSP(bf16, WS_PROJ);
    LAS float* xs = (LAS float*)C.lds;
    const float cw0 = C.in(19)[(l * 4 + 0) * 512 + d], cw1 = C.in(19)[(l * 4 + 1) * 512 + d], cw2 = C.in(19)[(l * 4 + 2) * 512 + d], cw3 = C.in(19)[(l * 4 + 3) * 512 + d];
    const float cb = C.in(20)[l * 512 + d];
    float xm3, xm2, xm1;
    {
        float pre[3];
#pragma unroll
        for (int i = 0; i < 3; ++i) { const int tt = t0 - 3 + i;
            if (tt >= 0) pre[i] = bf2f(P[(size_t)(row0 + tt) * PP + C_AX + d]);
            else if (seq >= 4) pre[i] = C.in(7)[((size_t)(l * 8 + (seq - 4)) * 3 + (tt + 3)) * 512 + d];
            else pre[i] = 0.f; }
        xm3 = pre[0]; xm2 = pre[1]; xm1 = pre[2];
    }
    {
        float xv[32];
#pragma unroll
        for (int t = 0; t < 32; ++t) xv[t] = (t < nt) ? bf2f(P[(size_t)(row0 + t0 + t) * PP + C_AX + d]) : 0.f;
#pragma unroll
        for (int t = 0; t < 32; ++t) if (t < nt) {
            const float xt = xv[t];
            xs[t * 512 + d] = cb + cw0 * xm3 + cw1 * xm2 + cw2 * xm1 + cw3 * xt;
            xm3 = xm2; xm2 = xm1; xm1 = xt;
        }
    }
    if (t0 + nt == T) {
        float* o = (seq < 4) ? OUTB + O_LCP + (size_t)(l * 4 + seq) * 3 * 512 : OUTB + O_LCS + (size_t)(l * 8 + (seq - 4)) * 3 * 512;
        o[0 * 512 + d] = xm3; o[1 * 512 + d] = xm2; o[2 * 512 + d] = xm1;
    }
    const float br = C.in(22)[l * 512 + d], bi = C.in(24)[l * 512 + d];
    const float lam = C.in(25)[l * 512 + d];
    float L8L2 = -8.0f * softplusf_(-lam) * LOG2E;
    asm volatile("" : "+v"(L8L2) :: "memory");
    typedef float f2v __attribute__((ext_vector_type(2)));
    f2v wri[64];
    {
        const float* pr = C.in(21) + ((size_t)(l * 8 + n) * 64) * 64 + dd;
        const float* pi = C.in(23) + ((size_t)(l * 8 + n) * 64) * 64 + dd;
#pragma unroll
        for (int c = 0; c < 64; ++c) { wri[c].x = pr[c * 64]; wri[c].y = pi[c * 64]; }
    }
    __syncthreads();
    float h = 0.f, ap = 1.f;
    float* HL = WSP(float, WS_LH); float* AL = WSP(float, WS_LA);
    for (int t = 0; t < nt; ++t) {
        f2v a0 = {br, bi}, a1 = {0.f, 0.f};
        const LAS f32x4* xv = (const LAS f32x4*)(xs + t * 512 + n * 64);
#pragma unroll
        for (int c4 = 0; c4 < 16; ++c4) { const f32x4 v = xv[c4];
            a0 = __builtin_elementwise_fma((f2v){v.x, v.x}, wri[4 * c4], a0); a1 = __builtin_elementwise_fma((f2v){v.y, v.y}, wri[4 * c4 + 1], a1);
            a0 = __builtin_elementwise_fma((f2v){v.z, v.z}, wri[4 * c4 + 2], a0); a1 = __builtin_elementwise_fma((f2v){v.w, v.w}, wri[4 * c4 + 3], a1); }
        const float ar = a0.x + a1.x, ai = a0.y + a1.y;
        const float xc = xs[t * 512 + d];
        const float r = __builtin_amdgcn_rcpf(1.0f + __builtin_amdgcn_exp2f(-LOG2E * ar)), ig = __builtin_amdgcn_rcpf(1.0f + __builtin_amdgcn_exp2f(-LOG2E * ai));
        const float a = __builtin_amdgcn_exp2f(r * L8L2);
        const float uu = __builtin_amdgcn_sqrtf(fmaxf(1.0f - a * a, 0.f)) * (ig * xc);
        h = a * h + uu; ap *= a;
        const size_t off = (size_t)(row0 + t0 + t) * 512 + d;
        HL[off] = h; AL[off] = ap;
    }
    __syncthreads();
}

constexpr int GH_Q = 0, GH_K = 18224, GH_V = 36448, GH_L = 54672, GH_S = 72080, GH_BYTES = 73104;
static_assert(2 * GH_BYTES <= LDS_MISC, "gdn prep LDS");

__device__ __forceinline__ void gdn_prep_unit(Ctx& C, int l, int u) {
    KA_FRESH(C);
    int seq, chunk, hp, T;
    if (u < 512) { seq = u >> 7; chunk = (u >> 2) & 31; hp = u & 3; T = 2048; } else { const int v = u - 512; seq = 4 + (v >> 2); chunk = 0; hp = v & 3; T = 8; }
    const int hb = C.tid >> 8, ht = C.tid & 255, lane = C.lane;
    const int head = 2 * hp + hb;
    const int cid = (seq < 4) ? ((seq * 8 + head) * 32 + chunk) : (1024 + (seq - 4) * 8 + head);
    const int srow0 = seq_row0(seq);
    const int row0 = srow0 + chunk * 64;
    const int nvalid = (T - chunk * 64) < 64 ? (T - chunk * 64) : 64;
    const bf16* P = WSP(bf16, WS_PROJ);
    LAS unsigned char* hl = C.lds + hb * GH_BYTES;
    LAS bf16* Kimg = (LAS bf16*)(hl + GH_K); LAS bf16* Qimg = (LAS bf16*)(hl + GH_Q); LAS bf16* Vimg = (LAS bf16*)(hl + GH_V);
    LAS float* Lm = (LAS float*)(hl + GH_L);
    LAS float* s_gc = (LAS float*)(hl + GH_S); LAS float* s_beta = s_gc + 64; LAS float* s_eg = s_gc + 128;
    if (ht < 64) {
        const int t = ht; const bool valid = t < nvalid;
        float beta = 0.f, g = 0.f;
        if (valid) { const float cbv = bf2f(P[(size_t)(row0 + t) * PP + C_B + head]), cav = bf2f(P[(size_t)(row0 + t) * PP + C_A + head]);
            beta = sigmoidf_(cbv); g = -__expf(C.in(30)[l * 8 + head]) * softplusf_(cav + C.in(31)[l * 8 + head]); }
#pragma unroll
        for (int off = 1; off < 64; off <<= 1) { const float v = __shfl_up(g, off); if (lane >= off) g += v; }
        s_gc[t] = g; s_beta[t] = beta; s_eg[t] = __expf(g);
    }
    __syncthreads();
    const float gl = s_gc[63];
    {
        LAS float* wgt = (LAS float*)(hl + GH_L);
        {
            v4u xs[13];
#pragma unroll
            for (int i = 0; i < 13; ++i) {
                const int idx = ht + 256 * i; const int r = idx / 48, chn = idx % 48, part = chn >> 4, col = (chn & 15) * 8;
                const int tt = chunk * 64 - 3 + r;
                v4u x = {0u, 0u, 0u, 0u};
                if (idx < 67 * 48) {
                    if (tt >= 0) x = *(const v4u*)(P + (size_t)(srow0 + tt) * PP + C_GQ + part * 1024 + head * 128 + col);
                    else if (seq >= 4) { const float* bp = C.in(9) + ((size_t)(l * 8 + (seq - 4)) * 3 + (tt + 3)) * 3072 + part * 1024 + head * 128 + col;
                        x.x = cvtpk(bp[0], bp[1]); x.y = cvtpk(bp[2], bp[3]); x.z = cvtpk(bp[4], bp[5]); x.w = cvtpk(bp[6], bp[7]); }
                }
                xs[i] = x;
            }
#pragma unroll
            for (int i = 0; i < 13; ++i) {
                const int idx = ht + 256 * i; const int r = idx / 48, chn = idx % 48, part = chn >> 4, col = (chn & 15) * 8;
                if (idx < 67 * 48) *(LAS v4u*)((LAS bf16*)(hl + part * 18224) + r * 136 + col) = xs[i];
            }
        }
        for (int e = ht; e < 4 * 384; e += 256) { const int i = e / 384, cc = e % 384; wgt[e] = C.in(29)[(size_t)(l * 4 + i) * 3072 + (cc >> 7) * 1024 + head * 128 + (cc & 127)]; }
        __syncthreads();
        const int t = ht >> 2, cgp = ht & 3; const bool valid = t < nvalid;
#pragma unroll 1
        for (int part = 0; part < 3; ++part) {
            LAS bf16* reg = (LAS bf16*)(hl + part * 18224);
            float acc[32];
#pragma unroll
            for (int c = 0; c < 32; ++c) acc[c] = 0.f;
#pragma unroll
            for (int i = 0; i < 4; ++i) {
                const LAS v4u* rp = (const LAS v4u*)(reg + (t + i) * 136 + cgp * 32);
                const LAS f32x4* wp = (const LAS f32x4*)(wgt + i * 384 + part * 128 + cgp * 32);
#pragma unroll
                for (int q4 = 0; q4 < 4; ++q4) { const v4u x = rp[q4]; const f32x4 w0 = wp[2 * q4], w1 = wp[2 * q4 + 1];
                    acc[8 * q4 + 0] += w0.x * bflo(x.x); acc[8 * q4 + 1] += w0.y * bfhi(x.x); acc[8 * q4 + 2] += w0.z * bflo(x.y); acc[8 * q4 + 3] += w0.w * bfhi(x.y);
                    acc[8 * q4 + 4] += w1.x * bflo(x.z); acc[8 * q4 + 5] += w1.y * bfhi(x.z); acc[8 * q4 + 6] += w1.z * bflo(x.w); acc[8 * q4 + 7] += w1.w * bfhi(x.w); }
            }
            float ss = 0.f;
#pragma unroll
            for (int c = 0; c < 32; ++c) { const float v = valid ? siluf_(acc[c]) : 0.f; acc[c] = v; ss += v * v; }
            float scl = 1.f;
            if (part < 2) { ss += __shfl_xor(ss, 1); ss += __shfl_xor(ss, 2); scl = rsqrtf(ss + EPS); if (part == 0) scl *= 0.08838834764831845f; }
            v4u outp[4];
#pragma unroll
            for (int q4 = 0; q4 < 4; ++q4) {
                outp[q4].x = cvtpk(acc[8 * q4 + 0] * scl, acc[8 * q4 + 1] * scl); outp[q4].y = cvtpk(acc[8 * q4 + 2] * scl, acc[8 * q4 + 3] * scl);
                outp[q4].z = cvtpk(acc[8 * q4 + 4] * scl, acc[8 * q4 + 5] * scl); outp[q4].w = cvtpk(acc[8 * q4 + 6] * scl, acc[8 * q4 + 7] * scl); }
            __syncthreads();
#pragma unroll
            for (int q4 = 0; q4 < 4; ++q4) *(LAS v4u*)(reg + t * 136 + cgp * 32 + 8 * q4) = outp[q4];
        }
        if (chunk * 64 + 64 >= T) {
            float* o = (seq < 4) ? OUTB + O_GCP + (size_t)(l * 4 + seq) * 3 * 3072 : OUTB + O_GCS + (size_t)(l * 8 + (seq - 4)) * 3 * 3072;
            for (int e = ht; e < 3 * 384; e += 256) { const int i = e / 384, cc = e % 384, part = cc >> 7, c = cc & 127; const int col = part * 1024 + head * 128 + c;
                o[i * 3072 + col] = bf2f(P[(size_t)(srow0 + T - 3 + i) * PP + C_GQ + col]); }
        }
    }
    __syncthreads();
    {
        v4u* QEf = WSP(v4u, WS_QEF) + (size_t)cid * 1024; v4u* KDf = WSP(v4u, WS_KDF) + (size_t)cid * 1024;
#pragma unroll 1
        for (int f = 0; f < 4; ++f) {
            const int task = ht + 256 * f, frag = task >> 6, ln = task & 63, h = ln >> 5;
            {
                const int ti = frag >> 3, ks = frag & 7, tok = 32 * ti + (ln & 31), dkb = 32 * (ks >> 1) + 16 * (ks & 1) + 4 * h;
                const float sc = s_eg[tok];
                const v2u a = *(const LAS v2u*)(Qimg + tok * 136 + dkb), b = *(const LAS v2u*)(Qimg + tok * 136 + dkb + 8);
                v4u o; o.x = cvtpk(bflo(a.x) * sc, bfhi(a.x) * sc); o.y = cvtpk(bflo(a.y) * sc, bfhi(a.y) * sc); o.z = cvtpk(bflo(b.x) * sc, bfhi(b.x) * sc); o.w = cvtpk(bflo(b.y) * sc, bfhi(b.y) * sc);
                QEf[frag * 64 + ln] = o;
            }
            {
                const int dt = frag >> 2, ks2 = frag & 3, dk = 32 * dt + (ln & 31), tb = 32 * (ks2 >> 1) + 16 * (ks2 & 1) + 4 * h;
                float v[8];
#pragma unroll
                for (int j = 0; j < 8; ++j) { const int tok = tb + 8 * (j >> 2) + (j & 3); v[j] = bf2f(Kimg[tok * 136 + dk]) * __expf(gl - s_gc[tok]); }
                v4u o; o.x = cvtpk(v[0], v[1]); o.y = cvtpk(v[2], v[3]); o.z = cvtpk(v[4], v[5]); o.w = cvtpk(v[6], v[7]);
                KDf[frag * 64 + ln] = o;
            }
        }
    }
    {
        const int wv = ht >> 6, tj = wv >> 1, ti = wv & 1, m = lane & 31, kh = lane >> 5;
        f32x16 akk, aqk;
#pragma unroll
        for (int r = 0; r < 16; ++r) { akk[r] = 0.f; aqk[r] = 0.f; }
#pragma unroll
        for (int ks = 0; ks < 8; ++ks) {
            const bf16x8 a = *(const LAS bf16x8*)(Kimg + (32 * tj + m) * 136 + 16 * ks + 8 * kh);
            const bf16x8 bk = *(const LAS bf16x8*)(Kimg + (32 * ti + m) * 136 + 16 * ks + 8 * kh);
            const bf16x8 bq = *(const LAS bf16x8*)(Qimg + (32 * ti + m) * 136 + 16 * ks + 8 * kh);
            akk = __builtin_amdgcn_mfma_f32_32x32x16_bf16(a, bk, akk, 0, 0, 0);
            aqk = __builtin_amdgcn_mfma_f32_32x32x16_bf16(a, bq, aqk, 0, 0, 0);
        }
        const int i = 32 * ti + m; const float gci = s_gc[i], bi = s_beta[i];
        float lv[16], qv[16];
#pragma unroll
        for (int r = 0; r < 16; ++r) { const int j = 32 * tj + crow(r, kh); const float dec = __expf(fminf(gci - s_gc[j], 0.f));
            lv[r] = (i > j) ? bi * akk[r] * dec : 0.f; qv[r] = (i >= j) ? aqk[r] * dec : 0.f; }
#pragma unroll
        for (int rq = 0; rq < 4; ++rq) { f32x4 o; o.x = lv[4 * rq]; o.y = lv[4 * rq + 1]; o.z = lv[4 * rq + 2]; o.w = lv[4 * rq + 3];
            *(LAS f32x4*)(Lm + i * 68 + 32 * tj + 8 * rq + 4 * kh) = o; }
        v4u* QKf = WSP(v4u, WS_QKF) + (size_t)cid * 512;
#pragma unroll
        for (int s = 0; s < 2; ++s) { v4u o; o.x = cvtpk(qv[8 * s + 0], qv[8 * s + 1]); o.y = cvtpk(qv[8 * s + 2], qv[8 * s + 3]); o.z = cvtpk(qv[8 * s + 4], qv[8 * s + 5]); o.w = cvtpk(qv[8 * s + 6], qv[8 * s + 7]);
            QKf[(ti * 4 + 2 * tj + s) * 64 + lane] = o; }
    }
    __syncthreads();
    {
        const int c = ht;
        float sol[64];
#pragma unroll 1
        for (int r12 = 0; r12 < REPN(12); ++r12) {
        if (c < 128) {
#pragma unroll
            for (int i = 0; i < 64; ++i) sol[i] = bf2f(Vimg[i * 136 + c]) * s_beta[i];
        } else {
#pragma unroll
            for (int i = 0; i < 64; ++i) sol[i] = bf2f(Kimg[i * 136 + (c - 128)]) * (s_beta[i] * s_eg[i]);
        }
#pragma unroll
        for (int i = 1; i < 64; ++i) {
            float s = sol[i];
#pragma unroll
            for (int j4 = 0; j4 <= ((i - 1) >> 2); ++j4) { const f32x4 Lv = *(const LAS f32x4*)(Lm + i * 68 + 4 * j4);
                s -= Lv.x * sol[4 * j4]; if (4 * j4 + 1 < i) s -= Lv.y * sol[4 * j4 + 1]; if (4 * j4 + 2 < i) s -= Lv.z * sol[4 * j4 + 2]; if (4 * j4 + 3 < i) s -= Lv.w * sol[4 * j4 + 3]; }
            sol[i] = s;
        }
        }
        __syncthreads();
        if (c < 128) {
            const int ds = c >> 5, col = c & 31;
            bf16* Uf = WSP(bf16, WS_UF) + (size_t)cid * 8192;
#pragma unroll
            for (int a = 0; a < 8; ++a)
#pragma unroll
                for (int hi = 0; hi < 2; ++hi) { const int ti = a >> 2; v2u o; o.x = cvtpk(sol[8 * a + 4 * hi], sol[8 * a + 4 * hi + 1]); o.y = cvtpk(sol[8 * a + 4 * hi + 2], sol[8 * a + 4 * hi + 3]);
                    *(GAS v2u*)(Uf + ((size_t)((ds * 2 + ti) * 64 + col + 32 * hi)) * 16 + 4 * (a & 3)) = o; }
        } else {
            const int dk = c - 128;
#pragma unroll
            for (int i = 0; i < 64; ++i) Qimg[i * 136 + dk] = f2bf(-sol[i]);
        }
        if (ht == 0) WSP(float, WS_GL)[cid] = __expf(gl);
    }
    __syncthreads();
    {
        v4u* Wf = WSP(v4u, WS_WF) + (size_t)cid * 1024;
#pragma unroll 1
        for (int f = 0; f < 4; ++f) {
            const int task = ht + 256 * f, frag = task >> 6, ln = task & 63, h = ln >> 5;
            const int ti = frag >> 3, ks = frag & 7, tok = 32 * ti + (ln & 31), dkb = 32 * (ks >> 1) + 16 * (ks & 1) + 4 * h;
            const v2u a = *(const LAS v2u*)(Qimg + tok * 136 + dkb), b = *(const LAS v2u*)(Qimg + tok * 136 + dkb + 8);
            v4u o; o.x = a.x; o.y = a.y; o.z = b.x; o.w = b.y;
            Wf[frag * 64 + ln] = o;
        }
    }
    __syncthreads();
}

__device__ __forceinline__ void phase_act(Ctx& C, int l) {
    KA_FRESH(C);
    const bf16* GV = WSP(bf16, WS_GV); bf16* ACT = WSP(bf16, WS_ACT);
    const long gt = (long)C.bid * NTHR + C.tid, NGT = (long)C.G * NTHR;
    const float* cw = C.in(35) + (size_t)l * 3 * DFF; const float* cb = C.in(36) + (size_t)l * DFF;
    for (long it = gt; it < (long)MS * 704; it += NGT) {
        const int row = MP + (int)(it / 704), grp = (int)(it % 704);
        const int j0 = grp * 8; const int gcol = (j0 >> 7) * 256 + (j0 & 127);
        const int s = row_seq(row); const int t = row - seq_row0(s); const int T = 8;
        float x[3][8];
#pragma unroll
        for (int i = 0; i < 3; ++i) {
            const int tt = t - 2 + i;
            if (tt >= 0) { const v4u g = *(const v4u*)(GV + (size_t)(row - 2 + i) * DUP + gcol);
                x[i][0] = bflo(g.x); x[i][1] = bfhi(g.x); x[i][2] = bflo(g.y); x[i][3] = bfhi(g.y); x[i][4] = bflo(g.z); x[i][5] = bfhi(g.z); x[i][6] = bflo(g.w); x[i][7] = bfhi(g.w);
            } else { const float* bp = C.in(11) + ((size_t)(l * 8 + (s - 4)) * 2 + (tt + 2)) * DFF + j0;
#pragma unroll
                for (int e = 0; e < 8; ++e) x[i][e] = bp[e]; }
        }
        const v4u vv = *(const v4u*)(GV + (size_t)row * DUP + gcol + 128);
        const float val[8] = {bflo(vv.x), bfhi(vv.x), bflo(vv.y), bfhi(vv.y), bflo(vv.z), bfhi(vv.z), bflo(vv.w), bfhi(vv.w)};
        float o[8];
#pragma unroll
        for (int e = 0; e < 8; ++e) { const float y = cb[j0 + e] + cw[0 * DFF + j0 + e] * x[0][e] + cw[1 * DFF + j0 + e] * x[1][e] + cw[2 * DFF + j0 + e] * x[2][e]; o[e] = siluf_(y) * val[e]; }
        v4u w; w.x = cvtpk(o[0], o[1]); w.y = cvtpk(o[2], o[3]); w.z = cvtpk(o[4], o[5]); w.w = cvtpk(o[6], o[7]);
        *(GAS v4u*)(ACT + (size_t)row * DFF + j0) = w;
        if (t >= T - 2) {
            float* fo = OUTB + O_FCS + ((size_t)(l * 8 + (s - 4)) * 2 + (t - (T - 2))) * DFF + j0;
#pragma unroll
            for (int e = 0; e < 8; ++e) fo[e] = x[2][e];
        }
    }
    const float* TG = WSP(float, WS_TAILG); const float* HG = WSP(float, WS_HEADG); const float* HV = WSP(float, WS_HEADV);
    for (long it = gt; it < (long)256 * 704; it += NGT) {
        const int rr = (int)(it / 704), grp = (int)(it % 704), rb = rr >> 1, i = rr & 1, j0 = grp * 8;
        const bool first = (rb & 31) == 0;
        float g2[8], g1[8], g0[8], vv[8];
#pragma unroll
        for (int e = 0; e < 8; ++e) {
            const float t0 = first ? 0.f : TG[(size_t)((rb - 1) * 2 + 0) * DFF + j0 + e], t1 = first ? 0.f : TG[(size_t)((rb - 1) * 2 + 1) * DFF + j0 + e];
            const float h0 = HG[(size_t)(rb * 2 + 0) * DFF + j0 + e], h1 = HG[(size_t)(rb * 2 + 1) * DFF + j0 + e];
            g2[e] = i == 0 ? t0 : t1; g1[e] = i == 0 ? t1 : h0; g0[e] = i == 0 ? h0 : h1; vv[e] = HV[(size_t)(rb * 2 + i) * DFF + j0 + e];
        }
        float o[8];
#pragma unroll
        for (int e = 0; e < 8; ++e) { const float y = cb[j0 + e] + cw[0 * DFF + j0 + e] * g2[e] + cw[1 * DFF + j0 + e] * g1[e] + cw[2 * DFF + j0 + e] * g0[e]; o[e] = siluf_(y) * vv[e]; }
        v4u w; w.x = cvtpk(o[0], o[1]); w.y = cvtpk(o[2], o[3]); w.z = cvtpk(o[4], o[5]); w.w = cvtpk(o[6], o[7]);
        *(GAS v4u*)(ACT + (size_t)(rb * 64 + i) * DFF + j0) = w;
        if ((rb & 31) == 31) {
            float* fo = OUTB + O_FCP + ((size_t)(l * 4 + (rb >> 5)) * 2 + i) * DFF + j0;
#pragma unroll
            for (int e = 0; e < 8; ++e) fo[e] = TG[(size_t)(rb * 2 + i) * DFF + j0 + e];
        }
    }
}

struct FinIn { f32x4 hl[2], al[2]; v4u ag, oatt, og[2], z[2]; };
__device__ __forceinline__ void fin_load(Ctx& C, int row, FinIn& in, int lane) {
    const bf16* P = WSP(bf16, WS_PROJ);
    const float* hl = WSP(float, WS_LH) + (size_t)row * 512 + 8 * lane; const float* al = WSP(float, WS_LA) + (size_t)row * 512 + 8 * lane;
    in.hl[0] = *(const f32x4*)hl; in.hl[1] = *(const f32x4*)(hl + 4); in.al[0] = *(const f32x4*)al; in.al[1] = *(const f32x4*)(al + 4);
    in.ag = *(const v4u*)(P + (size_t)row * PP + C_AG + 8 * lane);
    in.oatt = (row < MP) ? *(const v4u*)(WSP(bf16, WS_OATT) + (size_t)row * 512 + 8 * lane) : (v4u){0u, 0u, 0u, 0u};
    const v4u* op = (const v4u*)(WSP(bf16, WS_OGDN) + (size_t)row * 1024 + 16 * lane); in.og[0] = op[0]; in.og[1] = op[1];
    const v4u* zp = (const v4u*)(P + (size_t)row * PP + C_Z + 16 * lane); in.z[0] = zp[0]; in.z[1] = zp[1];
}
__device__ __forceinline__ void phase_finalize(Ctx& C, int l) {
    KA_FRESH(C);
    const int gw = C.bid * NWAVES + C.wave, NGW = C.G * NWAVES, lane = C.lane;
    bf16* MIX = WSP(bf16, WS_MIX);
    float ga[8], gb[8], gc[16];
    {
        const float* pa = C.in(26) + l * 512 + 8 * lane; const float* pb = C.in(27) + l * 512 + 8 * lane; const float* pc = C.in(32) + l * 128 + ((16 * lane) & 127);
#pragma unroll
        for (int e = 0; e < 8; ++e) { ga[e] = pa[e]; gb[e] = pb[e]; }
#pragma unroll
        for (int e = 0; e < 16; ++e) gc[e] = pc[e];
    }
    FinIn in;
    if (gw < MR) fin_load(C, gw, in, lane);
    for (int row = gw; row < MR; row += NGW) {
        const int s = row_seq(row); const int t = row - seq_row0(s);
        const int chunk = t >> 5;
        const float* cr = WSP(float, WS_CARRY) + (size_t)(s * 64 + chunk) * 512 + 8 * lane;
        const f32x4 c0v = *(const f32x4*)cr, c1v = *(const f32x4*)(cr + 4);
        float y[8], o[8], og[16], zz[16];
        {
            const float hv[8] = {in.hl[0].x, in.hl[0].y, in.hl[0].z, in.hl[0].w, in.hl[1].x, in.hl[1].y, in.hl[1].z, in.hl[1].w};
            const float av[8] = {in.al[0].x, in.al[0].y, in.al[0].z, in.al[0].w, in.al[1].x, in.al[1].y, in.al[1].z, in.al[1].w};
            const float cv[8] = {c0v.x, c0v.y, c0v.z, c0v.w, c1v.x, c1v.y, c1v.z, c1v.w};
            const float gv[8] = {bflo(in.ag.x), bfhi(in.ag.x), bflo(in.ag.y), bfhi(in.ag.y), bflo(in.ag.z), bfhi(in.ag.z), bflo(in.ag.w), bfhi(in.ag.w)};
#pragma unroll
            for (int e = 0; e < 8; ++e) { const float h = hv[e] + av[e] * cv[e]; y[e] = h * gelu_tanh(gv[e]); }
            o[0] = bflo(in.oatt.x); o[1] = bfhi(in.oatt.x); o[2] = bflo(in.oatt.y); o[3] = bfhi(in.oatt.y); o[4] = bflo(in.oatt.z); o[5] = bfhi(in.oatt.z); o[6] = bflo(in.oatt.w); o[7] = bfhi(in.oatt.w);
#pragma unroll
            for (int h2 = 0; h2 < 2; ++h2) { const v4u a = in.og[h2], b = in.z[h2];
                og[8 * h2 + 0] = bflo(a.x); og[8 * h2 + 1] = bfhi(a.x); og[8 * h2 + 2] = bflo(a.y); og[8 * h2 + 3] = bfhi(a.y); og[8 * h2 + 4] = bflo(a.z); og[8 * h2 + 5] = bfhi(a.z); og[8 * h2 + 6] = bflo(a.w); og[8 * h2 + 7] = bfhi(a.w);
                zz[8 * h2 + 0] = bflo(b.x); zz[8 * h2 + 1] = bfhi(b.x); zz[8 * h2 + 2] = bflo(b.y); zz[8 * h2 + 3] = bfhi(b.y); zz[8 * h2 + 4] = bflo(b.z); zz[8 * h2 + 5] = bfhi(b.z); zz[8 * h2 + 6] = bflo(b.w); zz[8 * h2 + 7] = bfhi(b.w); }
        }
        asm volatile("" ::: "memory");
        const int nrow = row + NGW;
        if (nrow < MR) fin_load(C, nrow, in, lane);
        {
            float ss = 0.f;
#pragma unroll
            for (int e = 0; e < 8; ++e) ss += y[e] * y[e];
            const float rs = rsqrtf(wave_sum(ss) * (1.f / 512.f) + EPS);
            v4u w; w.x = cvtpk(y[0] * rs * ga[0], y[1] * rs * ga[1]); w.y = cvtpk(y[2] * rs * ga[2], y[3] * rs * ga[3]); w.z = cvtpk(y[4] * rs * ga[4], y[5] * rs * ga[5]); w.w = cvtpk(y[6] * rs * ga[6], y[7] * rs * ga[7]);
            *(GAS v4u*)(MIX + (size_t)row * DM + 8 * lane) = w;
        }
        {
            if (row >= MP) {
                const int b = (row - MP) >> 3, q = (row - MP) & 7, head = lane >> 3, dd = 8 * (lane & 7), bh = b * 8 + head;
                const float* spo = WSP(float, WS_SPO); const float* spt = WSP(float, WS_SPT);
                float R = 1.f;
#pragma unroll
                for (int e = 0; e < 8; ++e) o[e] = 0.f;
                const float* tp = spt + (size_t)(bh * 33) * 8 + q; const float* pb = spo + ((size_t)(bh * 33) * 8 + q) * 64 + dd;
#pragma unroll 1
                for (int rb = 22; rb >= 0; rb -= 11) {
                    float t[11]; f32x4 p0[11], p1[11];
#pragma unroll
                    for (int i = 0; i < 11; ++i) { t[i] = tp[(rb + i) * 8]; p0[i] = *(const f32x4*)(pb + (size_t)(rb + i) * 512); p1[i] = *(const f32x4*)(pb + (size_t)(rb + i) * 512 + 4); }
#pragma unroll
                    for (int i = 10; i >= 0; --i) {
                        o[0] += R * p0[i].x; o[1] += R * p0[i].y; o[2] += R * p0[i].z; o[3] += R * p0[i].w; o[4] += R * p1[i].x; o[5] += R * p1[i].y; o[6] += R * p1[i].z; o[7] += R * p1[i].w;
                        R *= t[i];
                    }
                }
            }
            float ss = 0.f;
#pragma unroll
            for (int e = 0; e < 8; ++e) ss += o[e] * o[e];
            const float rs = rsqrtf(wave_sum(ss) * (1.f / 512.f) + EPS);
            v4u w; w.x = cvtpk(o[0] * rs * gb[0], o[1] * rs * gb[1]); w.y = cvtpk(o[2] * rs * gb[2], o[3] * rs * gb[3]); w.z = cvtpk(o[4] * rs * gb[4], o[5] * rs * gb[5]); w.w = cvtpk(o[6] * rs * gb[6], o[7] * rs * gb[7]);
            *(GAS v4u*)(MIX + (size_t)row * DM + 512 + 8 * lane) = w;
        }
        {
            float ss = 0.f;
#pragma unroll
            for (int e = 0; e < 16; ++e) ss += og[e] * og[e];
            ss += __shfl_xor(ss, 1); ss += __shfl_xor(ss, 2); ss += __shfl_xor(ss, 4);
            const float rs = rsqrtf(ss * (1.f / 128.f) + EPS);
            float yc[16];
#pragma unroll
            for (int e = 0; e < 16; ++e) yc[e] = og[e] * rs * gc[e] * siluf_(zz[e]);
            v4u w0, w1; w0.x = cvtpk(yc[0], yc[1]); w0.y = cvtpk(yc[2], yc[3]); w0.z = cvtpk(yc[4], yc[5]); w0.w = cvtpk(yc[6], yc[7]);
            w1.x = cvtpk(yc[8], yc[9]); w1.y = cvtpk(yc[10], yc[11]); w1.z = cvtpk(yc[12], yc[13]); w1.w = cvtpk(yc[14], yc[15]);
            *(GAS v4u*)(MIX + (size_t)row * DM + 1024 + 16 * lane) = w0; *(GAS v4u*)(MIX + (size_t)row * DM + 1024 + 16 * lane + 8) = w1;
        }
    }
}

template <bool MASK>
__device__ __forceinline__ void sb_core(const bf16x8 (&kf)[4], const bf16x8 (&qf)[4], float bias2, int kbase, int qpos, int hi, float& R, v4u (&pw)[2]) {
    f32x16 p;
#pragma unroll
    for (int r = 0; r < 16; ++r) p[r] = bias2;
#pragma unroll
    for (int ks = 0; ks < 4; ++ks) p = __builtin_amdgcn_mfma_f32_32x32x16_bf16(kf[ks], qf[ks], p, 0, 0, 0);
    float w[16];
    float L = 1.f;
#pragma unroll
    for (int r = 0; r < 16; ++r) {
        float e = __builtin_amdgcn_exp2f(__builtin_amdgcn_fmed3f(p[r], -126.f, 7.f));
        if (MASK) { if (kbase + 16 * hi + r >= qpos) e = 0.f; }
        w[r] = e * L; L *= (1.f + e);
    }
    const float Pr = __builtin_amdgcn_rcpf(L);
    const float other = __shfl_xor(Pr, 32);
    const float F = (hi ? R : R * other) * Pr;
    R = R * Pr * other;
#pragma unroll
    for (int s = 0; s < 2; ++s) {
        pw[s].x = cvtpk(w[8 * s + 0] * F, w[8 * s + 1] * F); pw[s].y = cvtpk(w[8 * s + 2] * F, w[8 * s + 3] * F); pw[s].z = cvtpk(w[8 * s + 4] * F, w[8 * s + 5] * F); pw[s].w = cvtpk(w[8 * s + 6] * F, w[8 * s + 7] * F);
    }
}
__device__ __forceinline__ void sb_pv(f32x16 (&o)[2], const v4u (&pw)[2], const bf16x8 (&vf)[2][2]) {
#pragma unroll
    for (int dt = 0; dt < 2; ++dt)
#pragma unroll
        for (int st = 0; st < 2; ++st) o[dt] = __builtin_amdgcn_mfma_f32_32x32x16_bf16(__builtin_bit_cast(bf16x8, pw[st]), vf[dt][st], o[dt], 0, 0, 0);
}
constexpr int VT_PITCH = 72, VT_BYTES = 2 * 32 * VT_PITCH * 2;
struct RawBf { v4u k[4]; v4u v[4]; };
struct RawF32 { f32x4 k[8]; f32x4 v[8]; };
__device__ __forceinline__ void raw_load_bf16(RawBf& t, const bf16* Kb, const bf16* Vb, int pitch, int tile_base, int maxrow, int lane) {
#pragma unroll
    for (int i = 0; i < 4; ++i) { int row = tile_base + 8 * i + (lane >> 3); row = row > maxrow ? maxrow : row;
        t.k[i] = *(const v4u*)(Kb + (size_t)row * pitch + 8 * (lane & 7)); t.v[i] = *(const v4u*)(Vb + (size_t)row * pitch + 8 * (lane & 7)); }
}
__device__ __forceinline__ void raw_load_f32(RawF32& t, const float* Kt, const float* Vt, int lane) {
#pragma unroll
    for (int i = 0; i < 8; ++i) { t.k[i] = *(const f32x4*)(Kt + (size_t)(4 * i + (lane >> 4)) * 512 + 4 * (lane & 15)); t.v[i] = *(const f32x4*)(Vt + (size_t)(4 * i + (lane >> 4)) * 512 + 4 * (lane & 15)); }
}
__device__ __forceinline__ void vfrags_from_lds(const LAS bf16* vt, bf16x8 (&vf)[2][2], int lane) {
    typedef short s16x4v __attribute__((ext_vector_type(4)));
    const int g16 = lane >> 4, q = (lane & 15) >> 2, p = lane & 3, kh = g16 >> 1, cg = g16 & 1;
    const LAS bf16* base = vt + (16 * kh + q) * VT_PITCH + 16 * cg + 4 * p;
#pragma unroll
    for (int st = 0; st < 2; ++st)
#pragma unroll
        for (int dt = 0; dt < 2; ++dt) {
            const s16x4v lo = __builtin_bit_cast(s16x4v, __builtin_amdgcn_ds_read_tr16_b64_v4i16((LAS s16x4v*)(base + (8 * st + 0) * VT_PITCH + 32 * dt)));
            const s16x4v hi = __builtin_bit_cast(s16x4v, __builtin_amdgcn_ds_read_tr16_b64_v4i16((LAS s16x4v*)(base + (8 * st + 4) * VT_PITCH + 32 * dt)));
            vf[dt][st] = (bf16x8){lo[0], lo[1], lo[2], lo[3], hi[0], hi[1], hi[2], hi[3]};
        }
}
__device__ __forceinline__ void kfrags_from_lds(const LAS bf16* kt, bf16x8 (&kf)[4], int lane) {
    const int m = lane & 31, kh = lane >> 5;
    const LAS bf16* kp = kt + (16 * ((m >> 2) & 1) + (m & 3) + 4 * (m >> 3)) * VT_PITCH + 8 * kh;
#pragma unroll
    for (int ks = 0; ks < 4; ++ks) kf[ks] = *(const LAS bf16x8*)(kp + 16 * ks);
}
__device__ __forceinline__ void stage_bf16(const RawBf& t, LAS bf16* vt, bf16x8 (&kf)[4], int lane) {
    LAS bf16* kt = vt + 32 * VT_PITCH;
#pragma unroll
    for (int i = 0; i < 4; ++i) { *(LAS v4u*)(kt + (8 * i + (lane >> 3)) * VT_PITCH + 8 * (lane & 7)) = t.k[i]; *(LAS v4u*)(vt + (8 * i + (lane >> 3)) * VT_PITCH + 8 * (lane & 7)) = t.v[i]; }
    kfrags_from_lds(kt, kf, lane);
}
__device__ __forceinline__ void stage_f32(const RawF32& t, LAS bf16* vt, bf16x8 (&kf)[4], int lane) {
    LAS bf16* kt = vt + 32 * VT_PITCH;
#pragma unroll
    for (int i = 0; i < 8; ++i) { v2u w; w.x = cvtpk(t.k[i].x, t.k[i].y); w.y = cvtpk(t.k[i].z, t.k[i].w); *(LAS v2u*)(kt + (4 * i + (lane >> 4)) * VT_PITCH + 4 * (lane & 15)) = w;
        v2u u; u.x = cvtpk(t.v[i].x, t.v[i].y); u.y = cvtpk(t.v[i].z, t.v[i].w); *(LAS v2u*)(vt + (4 * i + (lane >> 4)) * VT_PITCH + 4 * (lane & 15)) = u; }
    kfrags_from_lds(kt, kf, lane);
}
template <bool MASK>
__device__ __forceinline__ void sb_compute(const bf16x8 (&kf)[4], const LAS bf16* vt, int tile_base, const bf16x8 (&qf)[4], float bias2, int qpos, int lane, float& R, f32x16 (&o)[2]) {
    v4u pw[2];
    sb_core<MASK>(kf, qf, bias2, tile_base, qpos, lane >> 5, R, pw);
    bf16x8 vf[2][2];
    vfrags_from_lds(vt, vf, lane);
    sb_pv(o, pw, vf);
}

constexpr int NATT_S = 64 * 33, NATT = NATT_S + 2048;
constexpr int SG_BYTES = 2 * 64 * VT_PITCH * 2;
struct RawG { f32x4 k[16]; f32x4 v[16]; };
__device__ __forceinline__ void rawg_load(RawG& t, const float* Kt, const float* Vt, int lane) {
#pragma unroll
    for (int i = 0; i < 16; ++i) { t.k[i] = *(const f32x4*)(Kt + (size_t)(4 * i + (lane >> 4)) * 512 + 4 * (lane & 15)); t.v[i] = *(const f32x4*)(Vt + (size_t)(4 * i + (lane >> 4)) * 512 + 4 * (lane & 15)); }
}
__device__ __forceinline__ void rawg_stage(const RawG& t, LAS bf16* vt, int lane) {
    LAS bf16* kt = vt + 64 * VT_PITCH;
#pragma unroll
    for (int i = 0; i < 16; ++i) { v2u w; w.x = cvtpk(t.k[i].x, t.k[i].y); w.y = cvtpk(t.k[i].z, t.k[i].w); *(LAS v2u*)(kt + (4 * i + (lane >> 4)) * VT_PITCH + 4 * (lane & 15)) = w;
        v2u u; u.x = cvtpk(t.v[i].x, t.v[i].y); u.y = cvtpk(t.v[i].z, t.v[i].w); *(LAS v2u*)(vt + (4 * i + (lane >> 4)) * VT_PITCH + 4 * (lane & 15)) = u; }
}
template <bool MASK>
__device__ __forceinline__ void sb16(const LAS bf16* vth, const LAS bf16* kth, const bf16x8 (&qf)[2], float bias2, int kbase, int qpos, int lane, float& R, f32x4 (&o)[4]) {
    typedef short s16x4v __attribute__((ext_vector_type(4)));
    const int i = lane & 15, g = lane >> 4;
    f32x4 p[2];
    {
        bf16x8 kf[2][2];
        const LAS bf16* kp = kth + (8 * (i >> 2) + (i & 3)) * VT_PITCH + 8 * g;
#pragma unroll
        for (int j2 = 0; j2 < 2; ++j2)
#pragma unroll
            for (int ks = 0; ks < 2; ++ks) kf[j2][ks] = *(const LAS bf16x8*)(kp + 4 * j2 * VT_PITCH + 32 * ks);
#pragma unroll
        for (int j2 = 0; j2 < 2; ++j2) { p[j2] = (f32x4){bias2, bias2, bias2, bias2};
#pragma unroll
            for (int ks = 0; ks < 2; ++ks) p[j2] = __builtin_amdgcn_mfma_f32_16x16x32_bf16(kf[j2][ks], qf[ks], p[j2], 0, 0, 0); }
    }
    float w[8]; float L = 1.f;
#pragma unroll
    for (int x = 0; x < 8; ++x) {
        float e = __builtin_amdgcn_exp2f(__builtin_amdgcn_fmed3f(p[x >> 2][x & 3], -126.f, 7.f));
        if (MASK) { if (kbase + 8 * g + x >= qpos) e = 0.f; }
        w[x] = e * L; L *= (1.f + e);
    }
    const float Pr = __builtin_amdgcn_rcpf(L);
    const float a = __shfl_xor(Pr, 16); const float pp = Pr * a; const float b = __shfl_xor(pp, 32);
    const float suf = (g == 3) ? 1.f : (g == 2) ? a : (g == 1) ? b : a * b;
    const float F = R * suf * Pr;
    R = R * pp * b;
    v4u pw; pw.x = cvtpk(w[0] * F, w[1] * F); pw.y = cvtpk(w[2] * F, w[3] * F); pw.z = cvtpk(w[4] * F, w[5] * F); pw.w = cvtpk(w[6] * F, w[7] * F);
    const LAS bf16* vb = vth + (8 * g + ((lane & 15) >> 2)) * VT_PITCH + 4 * (lane & 3);
#pragma unroll
    for (int dt = 0; dt < 4; ++dt) {
        const s16x4v lo = __builtin_bit_cast(s16x4v, __builtin_amdgcn_ds_read_tr16_b64_v4i16((LAS s16x4v*)(vb + 16 * dt)));
        const s16x4v hi = __builtin_bit_cast(s16x4v, __builtin_amdgcn_ds_read_tr16_b64_v4i16((LAS s16x4v*)(vb + 4 * VT_PITCH + 16 * dt)));
        const bf16x8 vf = (bf16x8){lo[0], lo[1], lo[2], lo[3], hi[0], hi[1], hi[2], hi[3]};
        o[dt] = __builtin_amdgcn_mfma_f32_16x16x32_bf16(vf, __builtin_bit_cast(bf16x8, pw), o[dt], 0, 0, 0);
    }
}
__device__ __forceinline__ void team_barrier(volatile LAS unsigned* tb, unsigned& kb);
__device__ __forceinline__ void attn_unit(Ctx& C, int l, int a, LAS bf16* vt, volatile LAS unsigned* tb, unsigned& kbar) {
    KA_FRESH(C);
    const int lane = C.lane, q = lane & 15, g = lane >> 4;
    const bf16* P = WSP(bf16, WS_PROJ);
    f32x4 o[4];
#pragma unroll
    for (int dt = 0; dt < 4; ++dt) o[dt] = (f32x4){0.f, 0.f, 0.f, 0.f};
    float R = 1.f;
    const int head = a & 7, b = (a >> 3) & 7, rg = a >> 6, bh = b * 8 + head;
    const float bias2 = C.in(28)[l * 8 + head] * LOG2E;
    const int row0 = MP + 8 * b;
    bf16x8 qf[2];
    { const int qr = q < 8 ? q : 7; const bf16* qp = P + (size_t)(row0 + qr) * PP + C_Q + 64 * head + 8 * g;
#pragma unroll
      for (int ks = 0; ks < 2; ++ks) { v4u x = *(const v4u*)(qp + 32 * ks); if (q >= 8) { x.x = 0u; x.y = 0u; x.z = 0u; x.w = 0u; } qf[ks] = __builtin_bit_cast(bf16x8, x); } }
    LAS bf16* kt = vt + 64 * VT_PITCH;
    if (rg < 32) {
        const int* pt = (const int*)C.in(6) + b * 128;
        const float* ck = C.in(4) + (size_t)l * 1280 * 128 * 512 + 64 * head; const float* cv = C.in(5) + (size_t)l * 1280 * 128 * 512 + 64 * head;
        RawG ra;
        const int p0 = __builtin_amdgcn_readfirstlane(pt[4 * rg + 0]), p1 = __builtin_amdgcn_readfirstlane(pt[4 * rg + 1]), p2 = __builtin_amdgcn_readfirstlane(pt[4 * rg + 2]), p3 = __builtin_amdgcn_readfirstlane(pt[4 * rg + 3]);
#define GOFF(j) (((size_t)(((j) >> 1) == 0 ? p0 : ((j) >> 1) == 1 ? p1 : ((j) >> 1) == 2 ? p2 : p3) * 128 + ((j) & 1) * 64) * 512)
        { const size_t off = GOFF(7); rawg_load(ra, ck + off, cv + off, lane); }
#pragma unroll 1
        for (int j = 7; j >= 0; --j) {
            team_barrier(tb, kbar);
            rawg_stage(ra, vt, lane);
            asm volatile("" ::: "memory");
            if (j > 0) { const size_t off = GOFF(j - 1); rawg_load(ra, ck + off, cv + off, lane); }
            sb16<false>(vt + 32 * VT_PITCH, kt + 32 * VT_PITCH, qf, bias2, 0, 0x7fffffff, lane, R, o);
            sb16<false>(vt, kt, qf, bias2, 0, 0x7fffffff, lane, R, o);
        }
#undef GOFF
    } else {
        RawBf cur; raw_load_bf16(cur, P + (size_t)row0 * PP + C_K + 64 * head, P + (size_t)row0 * PP + C_V + 64 * head, PP, 0, 7, lane);
#pragma unroll
        for (int i = 0; i < 4; ++i) { *(LAS v4u*)(kt + (8 * i + (lane >> 3)) * VT_PITCH + 8 * (lane & 7)) = cur.k[i]; *(LAS v4u*)(vt + (8 * i + (lane >> 3)) * VT_PITCH + 8 * (lane & 7)) = cur.v[i]; }
        sb16<true>(vt, kt, qf, bias2, 0, q, lane, R, o);
    }
    float* spo = WSP(float, WS_SPO) + (size_t)(bh * 33 + rg) * 8 * 64; float* spt = WSP(float, WS_SPT) + (size_t)(bh * 33 + rg) * 8;
    if (q < 8) {
#pragma unroll
        for (int dt = 0; dt < 4; ++dt) *(f32x4*)(spo + q * 64 + 16 * dt + 4 * g) = o[dt];
    }
    if (lane < 8) spt[lane] = R;
}

constexpr int PB_SLOT = 2 * 32 * VT_PITCH * 2;
__device__ __forceinline__ void team_barrier(volatile LAS unsigned* tb, unsigned& kb) {
    kb += 1u;
    const unsigned target = 4u * kb;
    const unsigned addr = (unsigned)(uintptr_t)tb;
    unsigned tmp, sc, cnt; unsigned long long sv;
    asm volatile(
        "s_waitcnt lgkmcnt(0)\n\t"
        "s_mov_b64 %[sv], exec\n\t"
        "s_mov_b64 exec, 1\n\t"
        "ds_add_u32 %[addr], %[one]\n\t"
        "s_mov_b64 exec, %[sv]\n\t"
        "s_mov_b32 %[cnt], 0\n\t"
        "1:\n\t"
        "ds_read_b32 %[tmp], %[addr]\n\t"
        "s_waitcnt lgkmcnt(0)\n\t"
        "v_readfirstlane_b32 %[sc], %[tmp]\n\t"
        "s_cmp_ge_u32 %[sc], %[target]\n\t"
        "s_cbranch_scc1 2f\n\t"
        "s_add_u32 %[cnt], %[cnt], 1\n\t"
        "s_cmp_gt_u32 %[cnt], 0x2000000\n\t"
        "s_cbranch_scc1 2f\n\t"
        "s_sleep 1\n\t"
        "s_branch 1b\n\t"
        "2:\n\t"
        : [tmp] "=&v"(tmp), [sc] "=&s"(sc), [cnt] "=&s"(cnt), [sv] "=&s"(sv)
        : [addr] "v"(addr), [one] "v"(1u), [target] "s"(target)
        : "memory", "scc");
}
__device__ __forceinline__ void prompt_team_unit(Ctx& C, int l, int u, LAS bf16* ring, volatile LAS unsigned* tb, unsigned& kb) {
    KA_FRESH(C);
    const int lane = C.lane, m = lane & 31, kh = lane >> 5, w4 = C.wave & 3;
    const int qb = 15 - (u >> 5), sh = u & 31, seq = sh >> 3, head = sh & 7;
    const int g = 4 * qb + w4, T0 = 4 * qb + 3;
    const bf16* P = WSP(bf16, WS_PROJ);
    const float bias2 = C.in(28)[l * 8 + head] * LOG2E;
    const int row0 = seq * 2048;
    bf16x8 qf[4];
    { const bf16* qp = P + (size_t)(row0 + 32 * g + m) * PP + C_Q + 64 * head + 8 * kh;
#pragma unroll
      for (int ks = 0; ks < 4; ++ks) qf[ks] = *(const bf16x8*)(qp + 16 * ks); }
    const int tt = C.tid & 255, lrow = tt >> 3, lch = tt & 7;
    const bf16* srck = P + (size_t)row0 * PP + C_K + 64 * head + 8 * lch; const bf16* srcv = P + (size_t)row0 * PP + C_V + 64 * head + 8 * lch;
    const int ldst = lrow * VT_PITCH + 8 * lch;
    const int qpos = 32 * g + m;
    f32x16 o[2];
#pragma unroll
    for (int r = 0; r < 16; ++r) { o[0][r] = 0.f; o[1][r] = 0.f; }
    float R = 1.f;
#define PT_LDK(t) (*(const v4u*)(srck + (size_t)(32 * ((t) > 0 ? (t) : 0) + lrow) * PP))
#define PT_LDV(t) (*(const v4u*)(srcv + (size_t)(32 * ((t) > 0 ? (t) : 0) + lrow) * PP))
    v4u rak = PT_LDK(T0), rav = PT_LDV(T0), rbk = PT_LDK(T0 - 1), rbv = PT_LDV(T0 - 1);
#pragma unroll 1
    for (int t = T0; t >= 0; t -= 2) {
        *(LAS v4u*)(ring + 32 * VT_PITCH + ldst) = rak; *(LAS v4u*)(ring + ldst) = rav;
        rak = PT_LDK(t - 2); rav = PT_LDV(t - 2);
        team_barrier(tb, kb);
        if (t <= g) {
            LAS bf16* vt = ring; bf16x8 kf[4]; kfrags_from_lds(vt + 32 * VT_PITCH, kf, lane);
            if (t == g) sb_compute<true>(kf, vt, 32 * t, qf, bias2, qpos, lane, R, o); else sb_compute<false>(kf, vt, 32 * t, qf, bias2, qpos, lane, R, o);
        }
        *(LAS v4u*)(ring + PB_SLOT / 2 + 32 * VT_PITCH + ldst) = rbk; *(LAS v4u*)(ring + PB_SLOT / 2 + ldst) = rbv;
        rbk = PT_LDK(t - 3); rbv = PT_LDV(t - 3);
        team_barrier(tb, kb);
        if (t - 1 <= g) {
            LAS bf16* vt = ring + PB_SLOT / 2; bf16x8 kf[4]; kfrags_from_lds(vt + 32 * VT_PITCH, kf, lane);
            if (t - 1 == g) sb_compute<true>(kf, vt, 32 * (t - 1), qf, bias2, qpos, lane, R, o); else sb_compute<false>(kf, vt, 32 * (t - 1), qf, bias2, qpos, lane, R, o);
        }
    }
#undef PT_LDK
#undef PT_LDV
    bf16* oa = WSP(bf16, WS_OATT) + (size_t)(row0 + 32 * g) * 512 + 64 * head;
#pragma unroll
    for (int dt = 0; dt < 2; ++dt)
#pragma unroll
        for (int r = 0; r < 16; ++r) oa[(size_t)crow(r, kh) * 512 + 32 * dt + m] = f2bf(o[dt][r]);
    team_barrier(tb, kb);
}
constexpr int PB_SLOT_FWD = 0;
__device__ __forceinline__ void prompt_block_unit(Ctx& C, int l, int u) {
    KA_FRESH(C);
    const int lane = C.lane, m = lane & 31, kh = lane >> 5, wave = C.wave;
    const int qb = 7 - (u >> 5), sh = u & 31, seq = sh >> 3, head = sh & 7;
    const int g = 8 * qb + wave, T0 = 8 * qb + 7;
    const bf16* P = WSP(bf16, WS_PROJ);
    const float bias2 = C.in(28)[l * 8 + head] * LOG2E;
    const int row0 = seq * 2048;
    bf16x8 qf[4];
    { const bf16* qp = P + (size_t)(row0 + 32 * g + m) * PP + C_Q + 64 * head + 8 * kh;
#pragma unroll
      for (int ks = 0; ks < 4; ++ks) qf[ks] = *(const bf16x8*)(qp + 16 * ks); }
    const int part = C.tid >> 8, lrow = (C.tid & 255) >> 3, lch = C.tid & 7;
    const bf16* src = P + (size_t)row0 * PP + (part == 0 ? C_K : C_V) + 64 * head + 8 * lch;
    const int ldst = (part == 0 ? 32 * VT_PITCH : 0) + lrow * VT_PITCH + 8 * lch;
    LAS bf16* ring = (LAS bf16*)C.lds;
    const int qpos = 32 * g + m;
    f32x16 o[2];
#pragma unroll
    for (int r = 0; r < 16; ++r) { o[0][r] = 0.f; o[1][r] = 0.f; }
    float R = 1.f;
#define PB_LD(t) (*(const v4u*)(src + (size_t)(32 * ((t) > 0 ? (t) : 0) + lrow) * PP))
    v4u ra = PB_LD(T0), rb = PB_LD(T0 - 1);
#pragma unroll 1
    for (int t = T0; t >= 0; t -= 2) {
        *(LAS v4u*)(ring + ldst) = ra;
        ra = PB_LD(t - 2);
        __syncthreads();
        if (t <= g) {
            LAS bf16* vt = ring; bf16x8 kf[4]; kfrags_from_lds(vt + 32 * VT_PITCH, kf, lane);
            if (t == g) sb_compute<true>(kf, vt, 32 * t, qf, bias2, qpos, lane, R, o); else sb_compute<false>(kf, vt, 32 * t, qf, bias2, qpos, lane, R, o);
        }
        *(LAS v4u*)(ring + PB_SLOT / 2 + ldst) = rb;
        rb = PB_LD(t - 3);
        __syncthreads();
        if (t - 1 <= g) {
            LAS bf16* vt = ring + PB_SLOT / 2; bf16x8 kf[4]; kfrags_from_lds(vt + 32 * VT_PITCH, kf, lane);
            if (t - 1 == g) sb_compute<true>(kf, vt, 32 * (t - 1), qf, bias2, qpos, lane, R, o); else sb_compute<false>(kf, vt, 32 * (t - 1), qf, bias2, qpos, lane, R, o);
        }
    }
#undef PB_LD
    bf16* oa = WSP(bf16, WS_OATT) + (size_t)(row0 + 32 * g) * 512 + 64 * head;
#pragma unroll
    for (int dt = 0; dt < 2; ++dt)
#pragma unroll
        for (int r = 0; r < 16; ++r) oa[(size_t)crow(r, kh) * 512 + 32 * dt + m] = f2bf(o[dt][r]);
    __syncthreads();
}

__device__ __forceinline__ bf16x8 pack8(const f32x16& a, int s) {
    v4u w;
    if (s == 0) { w.x = cvtpk(a[0], a[1]); w.y = cvtpk(a[2], a[3]); w.z = cvtpk(a[4], a[5]); w.w = cvtpk(a[6], a[7]); }
    else { w.x = cvtpk(a[8], a[9]); w.y = cvtpk(a[10], a[11]); w.z = cvtpk(a[12], a[13]); w.w = cvtpk(a[14], a[15]); }
    return __builtin_bit_cast(bf16x8, w);
}
__device__ __forceinline__ void bf16x16_to_f32(f32x16& a, const v4u x, const v4u y) {
    a[0] = bflo(x.x); a[1] = bfhi(x.x); a[2] = bflo(x.y); a[3] = bfhi(x.y); a[4] = bflo(x.z); a[5] = bfhi(x.z); a[6] = bflo(x.w); a[7] = bfhi(x.w);
    a[8] = bflo(y.x); a[9] = bfhi(y.x); a[10] = bflo(y.y); a[11] = bfhi(y.y); a[12] = bflo(y.z); a[13] = bfhi(y.z); a[14] = bflo(y.w); a[15] = bfhi(y.w);
}
__device__ __forceinline__ void gdn_scan_unit(Ctx& C, int l, int su) {
    KA_FRESH(C);
    const int lane = C.lane, m = lane & 31, hi = lane >> 5;
    int seq, head, ds, nch, cid0;
    if (su < 128) { const int sh = su >> 2; ds = su & 3; seq = sh >> 3; head = sh & 7; nch = 32; cid0 = sh * 32; }
    else { const int v = su - 128; const int sh = v >> 2; ds = v & 3; seq = 4 + (sh >> 3); head = sh & 7; nch = 1; cid0 = 1024 + sh; }
    const int row0 = seq_row0(seq);
    f32x16 S[4];
    if (seq >= 4) {
        const float* s0 = C.in(10) + ((size_t)(l * 8 + (seq - 4)) * 8 + head) * 16384 + 32 * ds + m;
#pragma unroll
        for (int dt = 0; dt < 4; ++dt)
#pragma unroll
            for (int r = 0; r < 16; ++r) S[dt][r] = s0[(size_t)(32 * dt + crow(r, hi)) * 128];
    } else {
#pragma unroll
        for (int dt = 0; dt < 4; ++dt)
#pragma unroll
            for (int r = 0; r < 16; ++r) S[dt][r] = 0.f;
    }
    bf16* OG = WSP(bf16, WS_OGDN);
#pragma unroll 1
    for (int ch = 0; ch < nch; ++ch) {
        const int cid = cid0 + ch;
        const bf16x8* Wf = (const bf16x8*)(WSP(v4u, WS_WF) + (size_t)cid * 1024) + lane;
        const bf16x8* QEf = (const bf16x8*)(WSP(v4u, WS_QEF) + (size_t)cid * 1024) + lane;
        const bf16x8* KDf = (const bf16x8*)(WSP(v4u, WS_KDF) + (size_t)cid * 1024) + lane;
        const bf16x8* QKf = (const bf16x8*)(WSP(v4u, WS_QKF) + (size_t)cid * 512) + lane;
        const v4u* Uf = (const v4u*)(WSP(bf16, WS_UF) + (size_t)cid * 8192);
        const float egl = WSP(float, WS_GL)[cid];
        bf16x8 Sf[8];
#pragma unroll
        for (int dt = 0; dt < 4; ++dt) { Sf[2 * dt] = pack8(S[dt], 0); Sf[2 * dt + 1] = pack8(S[dt], 1); }
        f32x16 av[2], ao[2];
#pragma unroll
        for (int ti = 0; ti < 2; ++ti) {
            { const v4u* up = Uf + ((ds * 2 + ti) * 64 + lane) * 2; bf16x16_to_f32(av[ti], up[0], up[1]); }
#pragma unroll
            for (int ks = 0; ks < 8; ++ks) av[ti] = __builtin_amdgcn_mfma_f32_32x32x16_bf16(Wf[(ti * 8 + ks) * 64], Sf[ks], av[ti], 0, 0, 0);
#pragma unroll
            for (int r = 0; r < 16; ++r) ao[ti][r] = 0.f;
#pragma unroll
            for (int ks = 0; ks < 8; ++ks) ao[ti] = __builtin_amdgcn_mfma_f32_32x32x16_bf16(QEf[(ti * 8 + ks) * 64], Sf[ks], ao[ti], 0, 0, 0);
        }
        bf16x8 Vf[4];
        Vf[0] = pack8(av[0], 0); Vf[1] = pack8(av[0], 1); Vf[2] = pack8(av[1], 0); Vf[3] = pack8(av[1], 1);
#pragma unroll
        for (int ti = 0; ti < 2; ++ti)
#pragma unroll
            for (int k2 = 0; k2 < 4; ++k2) ao[ti] = __builtin_amdgcn_mfma_f32_32x32x16_bf16(QKf[(ti * 4 + k2) * 64], Vf[k2], ao[ti], 0, 0, 0);
#pragma unroll
        for (int dt = 0; dt < 4; ++dt) {
#pragma unroll
            for (int r = 0; r < 16; ++r) S[dt][r] *= egl;
#pragma unroll
            for (int k2 = 0; k2 < 4; ++k2) S[dt] = __builtin_amdgcn_mfma_f32_32x32x16_bf16(KDf[(dt * 4 + k2) * 64], Vf[k2], S[dt], 0, 0, 0);
        }
        if (seq < 4) {
#pragma unroll
            for (int ti = 0; ti < 2; ++ti)
#pragma unroll
                for (int r = 0; r < 16; ++r) OG[(size_t)(row0 + ch * 64 + 32 * ti + crow(r, hi)) * 1024 + head * 128 + 32 * ds + m] = f2bf(ao[ti][r]);
        } else {
#pragma unroll
            for (int r = 0; r < 4; ++r) OG[(size_t)(row0 + crow(r, hi)) * 1024 + head * 128 + 32 * ds + m] = f2bf(ao[0][r]);
        }
    }
    float* so = (seq < 4) ? OUTB + O_GP + ((size_t)(l * 4 + seq) * 8 + head) * 16384 : OUTB + O_GS + ((size_t)(l * 8 + (seq - 4)) * 8 + head) * 16384;
#pragma unroll
    for (int dt = 0; dt < 4; ++dt)
#pragma unroll
        for (int r = 0; r < 16; ++r) so[(size_t)(32 * dt + crow(r, hi)) * 128 + 32 * ds + m] = S[dt][r];
}

constexpr int SCAN_BUF = 73728;
static_assert(2 * SCAN_BUF <= LDS_MISC, "scan LDS");
__device__ __forceinline__ void scan_load(Ctx& C, int cid, int lt, v4u (&t)[18]) {
#pragma unroll
    for (int i = 0; i < 18; ++i) { const int idx = lt + 256 * i;
        const v4u* src = (i < 4) ? WSP(v4u, WS_WF) + (size_t)cid * 1024 + idx : (i < 8) ? WSP(v4u, WS_QEF) + (size_t)cid * 1024 + (idx - 1024) : (i < 12) ? WSP(v4u, WS_KDF) + (size_t)cid * 1024 + (idx - 2048)
                       : (i < 14) ? WSP(v4u, WS_QKF) + (size_t)cid * 512 + (idx - 3072) : WSP(v4u, WS_UF) + (size_t)cid * 1024 + (idx - 3584);
        t[i] = *src; }
}
__device__ __forceinline__ void scan_store(LAS unsigned char* dst, int lt, const v4u (&t)[18]) {
#pragma unroll
    for (int i = 0; i < 18; ++i) *(LAS v4u*)(dst + (size_t)(lt + 256 * i) * 16) = t[i];
}
__device__ __forceinline__ void gdn_scan_block(Ctx& C, int l, int sh) {
    KA_FRESH(C);
    const int lane = C.lane, m = lane & 31, hi = lane >> 5, wave = C.wave;
    const int seq = sh >> 3, head = sh & 7, ds = wave & 3, cid0 = sh * 32;
    const int row0 = seq * 2048;
    const int lt = C.tid & 255;
    if (wave >= 4) {
        v4u tst[18];
        scan_load(C, cid0, lt, tst); scan_store(C.lds, lt, tst); scan_load(C, cid0 + 1, lt, tst);
        __syncthreads();
#pragma unroll 1
        for (int ch = 0; ch < 32; ++ch) {
            if (ch + 1 < 32) { scan_store(C.lds + ((ch + 1) & 1) * SCAN_BUF, lt, tst); if (ch + 2 < 32) scan_load(C, cid0 + ch + 2, lt, tst); }
            __syncthreads();
        }
    } else {
        const unsigned olane = (unsigned)(4 * hi * 1024 + m);
        f32x16 S[4];
#pragma unroll
        for (int dt = 0; dt < 4; ++dt)
#pragma unroll
            for (int r = 0; r < 16; ++r) S[dt][r] = 0.f;
        bf16* OG = WSP(bf16, WS_OGDN);
        float egl_next = WSP(float, WS_GL)[cid0];
        __syncthreads();
#pragma unroll 1
        for (int ch = 0; ch < 32; ++ch) {
            const int cid = cid0 + ch;
            const LAS bf16x8* Wf = (const LAS bf16x8*)(C.lds + (ch & 1) * SCAN_BUF) + lane;
            const LAS bf16x8* QEf = Wf + 1024; const LAS bf16x8* KDf = Wf + 2048; const LAS bf16x8* QKf = Wf + 3072;
            const LAS v4u* Ub = (const LAS v4u*)(C.lds + (ch & 1) * SCAN_BUF + 57344) + (ds * 2) * 128 + lane * 2;
            const float egl = egl_next; egl_next = WSP(float, WS_GL)[cid0 + (ch + 1 < 32 ? ch + 1 : ch)];
            f32x16 av[2], ao[2];
            bf16x16_to_f32(av[0], Ub[0], Ub[1]); bf16x16_to_f32(av[1], Ub[128], Ub[129]);
#pragma unroll
            for (int r = 0; r < 16; ++r) { ao[0][r] = 0.f; ao[1][r] = 0.f; }
#pragma unroll
            for (int dt = 0; dt < 4; ++dt)
#pragma unroll
                for (int sx = 0; sx < 2; ++sx) { const int ks = 2 * dt + sx; const bf16x8 sf = pack8(S[dt], sx);
                    av[0] = __builtin_amdgcn_mfma_f32_32x32x16_bf16(Wf[(0 * 8 + ks) * 64], sf, av[0], 0, 0, 0);
                    av[1] = __builtin_amdgcn_mfma_f32_32x32x16_bf16(Wf[(1 * 8 + ks) * 64], sf, av[1], 0, 0, 0);
                    ao[0] = __builtin_amdgcn_mfma_f32_32x32x16_bf16(QEf[(0 * 8 + ks) * 64], sf, ao[0], 0, 0, 0);
                    ao[1] = __builtin_amdgcn_mfma_f32_32x32x16_bf16(QEf[(1 * 8 + ks) * 64], sf, ao[1], 0, 0, 0); }
            bf16x8 Vf[4];
            Vf[0] = pack8(av[0], 0); Vf[1] = pack8(av[0], 1); Vf[2] = pack8(av[1], 0); Vf[3] = pack8(av[1], 1);
#pragma unroll
            for (int ti = 0; ti < 2; ++ti)
#pragma unroll
                for (int k2 = 0; k2 < 4; ++k2) ao[ti] = __builtin_amdgcn_mfma_f32_32x32x16_bf16(QKf[(ti * 4 + k2) * 64], Vf[k2], ao[ti], 0, 0, 0);
#pragma unroll
            for (int dt = 0; dt < 4; ++dt) {
#pragma unroll
                for (int r = 0; r < 16; ++r) S[dt][r] *= egl;
#pragma unroll
                for (int k2 = 0; k2 < 4; ++k2) S[dt] = __builtin_amdgcn_mfma_f32_32x32x16_bf16(KDf[(dt * 4 + k2) * 64], Vf[k2], S[dt], 0, 0, 0);
            }
#pragma unroll
            for (int ti = 0; ti < 2; ++ti)
#pragma unroll
                for (int r = 0; r < 16; ++r) { bf16* p = OG + (size_t)(row0 + ch * 64 + 32 * ti + (r & 3) + 8 * (r >> 2)) * 1024 + head * 128 + 32 * ds; p[olane] = f2bf(ao[ti][r]); }
            __syncthreads();
        }
        float* so = OUTB + O_GP + ((size_t)(l * 4 + seq) * 8 + head) * 16384;
#pragma unroll
        for (int dt = 0; dt < 4; ++dt)
#pragma unroll
            for (int r = 0; r < 16; ++r) { float* p = so + (32 * dt + (r & 3) + 8 * (r >> 2)) * 128 + 32 * ds; p[(unsigned)(4 * hi * 128 + m)] = S[dt][r]; }
    }
}

__device__ __forceinline__ void lru_carry_task(Ctx& C, int l, int task) {
    KA_FRESH(C);
    const int s = task >> 3, d = (task & 7) * 64 + C.lane;
    const int nchunk = s < 4 ? 64 : 1, len = s < 4 ? 32 : 8, row0 = seq_row0(s);
    float H = s < 4 ? 0.f : C.in(8)[(size_t)(l * 8 + (s - 4)) * 512 + d];
    const float* HL = WSP(float, WS_LH); const float* AL = WSP(float, WS_LA); float* CR = WSP(float, WS_CARRY);
#pragma unroll 8
    for (int c = 0; c < nchunk; ++c) {
        CR[(size_t)(s * 64 + c) * 512 + d] = H;
        const size_t off = (size_t)(row0 + c * len + len - 1) * 512 + d;
        H = AL[off] * H + HL[off];
    }
    float* o = s < 4 ? OUTB + O_LHP + (size_t)(l * 4 + s) * 512 : OUTB + O_LHS + (size_t)(l * 8 + (s - 4)) * 512;
    o[d] = H;
}

__device__ __forceinline__ void phase_m4(Ctx& C, int l, int rep, unsigned& kbar) {
    if (C.bid >= 160 && C.G == 256) {
        pg8::Gemm g{WSP(bf16, WS_H), WSP(bf16, WS_WIN + l * WIN_L) + (size_t)6144 * DM, MP, 768, DM}; pg8::StaticOrder S; S.init(MP, 768, 96, C.bid - 160);
        EpiBf E{WSP(bf16, WS_PROJ) + 6144, PP};
        pg8::gemm_phase<EpiBf, pg8::StaticOrder, true, true>(C.lds, g, S, E);
    }
    for (int r7 = 0; r7 < REPN(7); ++r7) {
        if (C.bid < 32) gdn_scan_block(C, l, C.bid);
        else if (C.bid < 96) {
            if (C.wave < 4) gdn_scan_unit(C, l, 128 + (C.bid - 32) * 4 + C.wave);
            else if (C.wave < 6) { const int t = (C.bid - 32) * 2 + (C.wave - 4); if (t < 96) lru_carry_task(C, l, t); }
        }
    }
    {
    unsigned* qs = (unsigned*)(C.ws + WS_CTL) + CW_QUEUE + 64 * l;
    unsigned* qp = (unsigned*)(C.ws + WS_CTL) + CW_QUEUE + 64 * (16 + l);
    const int team = C.wave >> 2;
    volatile LAS unsigned* tb = (volatile LAS unsigned*)(C.lds + LDS_MISC) + 32 + 8 * team;
    LAS unsigned char* treg = C.lds + team * 73728;
    __syncthreads();
#pragma unroll 1
    for (int pass = 0; pass < 2; ++pass) {
        const bool prompt_first = (team == 0);
        const bool do_prompt = prompt_first == (pass == 0);
        if (do_prompt) {
            for (;;) {
                if ((C.tid & 255) == 0) tb[2] = __hip_atomic_fetch_add(qp, 1u, __ATOMIC_RELAXED, __HIP_MEMORY_SCOPE_AGENT);
                team_barrier(tb, kbar);
                const unsigned u = (unsigned)__builtin_amdgcn_readfirstlane((int)tb[2]);
                team_barrier(tb, kbar);
                if (u >= 512u) break;
                prompt_team_unit(C, l, (int)u, (LAS bf16*)treg, tb, kbar);
            }
        } else {
            for (;;) {
                if ((C.tid & 255) == 0) tb[2] = __hip_atomic_fetch_add(qs, 1u, __ATOMIC_RELAXED, __HIP_MEMORY_SCOPE_AGENT);
                team_barrier(tb, kbar);
                const unsigned u = (unsigned)__builtin_amdgcn_readfirstlane((int)tb[2]);
                team_barrier(tb, kbar);
                if (u >= (unsigned)(NATT_S / 4)) break;
                attn_unit(C, l, (int)(4u * u) + (C.wave & 3), (LAS bf16*)(treg + (C.wave & 3) * SG_BYTES), tb, kbar);
            }
        }
    }
    }
}

struct Args { const void* in[38]; float* out; unsigned char* ws; int ph_lo, ph_hi; };

__global__ void __launch_bounds__(NTHR, 2) hymba_fwd(Args args) {
    extern __shared__ __attribute__((aligned(16))) unsigned char lds_raw[];
    Ctx C;
    C.kp = (kptr_t)__builtin_amdgcn_kernarg_segment_ptr();
    C.out = (GAS float*)args.out; C.ws = (GAS unsigned char*)args.ws; C.lds = (LAS unsigned char*)lds_raw;
    C.tid = threadIdx.x; C.lane = C.tid & 63; C.wave = __builtin_amdgcn_readfirstlane(C.tid >> 6); C.G = gridDim.x; C.bid = blockIdx.x;
    volatile LAS unsigned* MISC = (volatile LAS unsigned*)(C.lds + LDS_MISC);
    if (C.tid < 64) MISC[C.tid] = 0u;
    __syncthreads();
    unsigned* ctl = (unsigned*)(C.ws + WS_CTL);
    XcdBarrier bar = xcd_barrier_post(ctl + CW_BAR, MISC + 8);
    const int lo = args.ph_lo, hi = args.ph_hi;
#define IN(k) (lo <= (k) && (k) < hi)
#define SEAM(k) do { if (IN(k) && IN((k) + 1)) { xcd_barrier(bar); if (REPN(6) > 1) { xcd_barrier(bar); xcd_barrier(bar); } } } while (0)

        if (IN(0)) { for (int rp = 0; rp < REPN(0); ++rp) { p0_weights(C); p0_ada(C); } } SEAM(0);
    if (IN(1)) { for (int rp = 0; rp < REPN(4); ++rp) p0b_modreduce(C); } SEAM(1);
    if (IN(2)) { for (int rp = 0; rp < REPN(4); ++rp) phase_n1(C); } SEAM(2);
    unsigned kbar = 0u;
#pragma unroll 1
    for (int l = 0; l < 2; ++l) {
        const int pb = 3 + 10 * l;
#define LF ({ int l_ = l; asm volatile("" : "+s"(l_)); l_; })
        if (IN(pb + 0)) {
            const int ll = LF; KA_FRESH(C); pg8::Gemm g{WSP(bf16, WS_H), WSP(bf16, WS_WIN + ll * WIN_L), MP, 6144, DM}; pg8::StaticOrder S; S.init(MP, 6144, C.G, C.bid); S.rep = REPN(1);
            EpiIn E{WSP(bf16, WS_PROJ), OUTB, ll};
            pg8::gemm_phase<EpiIn, pg8::StaticOrder, true, true>(C.lds, g, S, E);
            for (int su = C.bid; su < 216; su += C.G) sample_gemm_unit<0>(C, WSP(bf16, WS_H) + (size_t)MP * DM, WSP(bf16, WS_WIN + ll * WIN_L), DM, su * 32, ll);

        }
        SEAM(pb + 0);
        if (IN(pb + 1)) {
            { const int ll = LF; unsigned* q3 = ctl + CW_QUEUE + 64 * (8 + ll); volatile LAS unsigned* slot = (volatile LAS unsigned*)(C.lds + LDS_MISC) + 16;
              for (;;) {
                  if (C.tid == 0) *slot = __hip_atomic_fetch_add(q3, 1u, __ATOMIC_RELAXED, __HIP_MEMORY_SCOPE_AGENT);
                  __syncthreads();
                  const unsigned u = *slot;
                  __syncthreads();
                  const unsigned NC = (unsigned)conv_units(ll), T = 808u + NC;
                  if (u >= T) break;
                  const unsigned cb = u * NC / T, ca = (u + 1u) * NC / T;
                  if (ca > cb) conv_unit(C, ll, (int)cb);
                  else { const unsigned w = u - cb; if (w < 544u) gdn_prep_unit(C, ll, (int)w); else lru_unit(C, ll, (int)w - 544); }
              }
            }
        }
        SEAM(pb + 1);
        if (IN(pb + 2)) { for (int rp = 0; rp < REPN(3); ++rp) phase_m4(C, LF, rp, kbar); }
        SEAM(pb + 2);
        if (IN(pb + 3)) { for (int rp = 0; rp < REPN(4); ++rp) phase_finalize(C, LF); }
        SEAM(pb + 3);
        if (IN(pb + 4)) {
            const int ll = LF; KA_FRESH(C); pg8::Gemm g{WSP(bf16, WS_MIX), WSP(bf16, WS_WOUT + ll * WOUT_L), MP, DM, DM}; pg8::StaticOrder S; S.init(MP, DM, C.G, C.bid); S.rep = REPN(1);
            EpiBf E{WSP(bf16, WS_MIXO), DM};
            pg8::gemm_phase<EpiBf, pg8::StaticOrder, true, true>(C.lds, g, S, E);
            for (int su = C.bid; su < 64; su += C.G) sample_gemm_unit<1>(C, WSP(bf16, WS_MIX) + (size_t)MP * DM, WSP(bf16, WS_WOUT + ll * WOUT_L), DM, su * 32, ll);
        }
        SEAM(pb + 4);
        if (IN(pb + 5)) { for (int rp = REPN(5) - 1; rp >= 0; --rp) phase_resid(C, LF, 0, rp > 0); }
        SEAM(pb + 5);
        if (IN(pb + 6)) {
            const int ll = LF; KA_FRESH(C); pg8::Gemm g{WSP(bf16, WS_H), WSP(bf16, WS_WUP + ll * WUP_L), MP, DUP, DM}; pg8::StaticOrder S; S.init(MP, DUP, C.G, C.bid); S.rep = REPN(1);
            EpiAct E{WSP(bf16, WS_ACT), WSP(float, WS_TAILG), WSP(float, WS_HEADG), WSP(float, WS_HEADV), C.in(35) + (size_t)ll * 3 * DFF, C.in(36) + (size_t)ll * DFF};
            pg8::gemm_phase<EpiAct, pg8::StaticOrder, true, true>(C.lds, g, S, E);
            if (C.bid >= 128) for (int su = C.bid - 128; su < 352; su += 128) sample_gemm_unit<2>(C, WSP(bf16, WS_H) + (size_t)MP * DM, WSP(bf16, WS_WUP + ll * WUP_L), DM, su * 32, ll);

        }
        SEAM(pb + 6);
        if (IN(pb + 7)) { for (int rp = 0; rp < REPN(4); ++rp) phase_act(C, LF); }
        SEAM(pb + 7);
        if (IN(pb + 8)) {
            const int ll = LF; KA_FRESH(C); pg8::Gemm g{WSP(bf16, WS_ACT), WSP(bf16, WS_WDN + ll * WDN_L), MP, DM, DFF}; pg8::StaticOrder S; S.init(MP, DM, C.G, C.bid); S.rep = REPN(1);
            EpiBf E{WSP(bf16, WS_MIXO), DM};
            pg8::gemm_phase<EpiBf, pg8::StaticOrder, true, true>(C.lds, g, S, E);
            for (int su = C.bid; su < 64; su += C.G) sample_gemm_unit<1>(C, WSP(bf16, WS_ACT) + (size_t)MP * DFF, WSP(bf16, WS_WDN + ll * WDN_L), DFF, su * 32, ll);
        }
        SEAM(pb + 8);
        if (IN(pb + 9)) { for (int rp = REPN(5) - 1; rp >= 0; --rp) phase_resid(C, LF, 1, rp > 0); }
        if (l == 0) SEAM(pb + 9);
    }
#undef IN
#undef SEAM
}

#ifndef MK_PER_PHASE
#define MK_PER_PHASE 0
#endif
extern "C" void kernel_launch(void* const* d_in, const int* in_sizes, int n_in, void* d_out, int out_size, void* d_ws, size_t ws_size, hipStream_t stream) {
    static int grid = 0;
    if (grid == 0) {
        if (n_in != 38 || out_size != (int)O_END || ws_size < WS_END) { fprintf(stderr, "kernel_launch: unexpected shapes: n_in %d out %d ws %zu\n", n_in, out_size, ws_size); grid = -1; return; }
        int dev = 0, cus = 0, per_cu = 0;
        if (hipGetDevice(&dev) != hipSuccess || hipDeviceGetAttribute(&cus, hipDeviceAttributeMultiprocessorCount, dev) != hipSuccess) { grid = -1; return; }
        if (hipFuncSetAttribute((const void*)hymba_fwd, hipFuncAttributeMaxDynamicSharedMemorySize, LDS_BYTES) != hipSuccess) { fprintf(stderr, "kernel_launch: hipFuncSetAttribute failed\n"); grid = -1; return; }
        if (hipOccupancyMaxActiveBlocksPerMultiprocessor(&per_cu, (const void*)hymba_fwd, NTHR, LDS_BYTES) != hipSuccess || per_cu < 1) { fprintf(stderr, "kernel_launch: occupancy query says %d\n", per_cu); }
        (void)hipGetLastError();
        grid = cus;
    }
    if (grid < 0) return;
    (void)hipMemsetAsync((char*)d_ws + WS_CTL, 0, CTL_ZERO_BYTES, stream);
    Args a{};
    for (int i = 0; i < 38; ++i) a.in[i] = d_in[i];
    a.out = (float*)d_out; a.ws = (unsigned char*)d_ws;
#if MK_PER_PHASE
    for (int p = 0; p < NPHASE; ++p) { a.ph_lo = p; a.ph_hi = p + 1; hipLaunchKernelGGL(hymba_fwd, dim3(grid), dim3(NTHR), LDS_BYTES, stream, a); }
#else
    a.ph_lo = 0; a.ph_hi = NPHASE;
    hipLaunchKernelGGL(hymba_fwd, dim3(grid), dim3(NTHR), LDS_BYTES, stream, a);
#endif
    const hipError_t le = hipPeekAtLastError();
    if (le != hipSuccess) fprintf(stderr, "kernel_launch: launch failed: %s\n", hipGetErrorName(le));
}
```

```cpp
#include <hip/hip_runtime.h>
#include <cstdio>
#include <cstdint>
namespace pg8 {
#define PG8_LAS __attribute__((address_space(3)))
typedef unsigned short bf16_t;
typedef short bf16x8 __attribute__((ext_vector_type(8)));
typedef float f32x4 __attribute__((ext_vector_type(4)));
typedef unsigned u32x4 __attribute__((ext_vector_type(4)));
constexpr int BM = 256, BK = 64, HALF = 128, HTB = HALF * BK * 2  , STAGE_BYTES = 8 * HTB, NXCD = 8, WGM = 8;

__host__ __device__ __forceinline__ int lds_byte(int r, int c) { const int st = (r >> 4) * 2 + (c >> 5), rr = r & 15, cc = c & 31, ob = rr * 64 + cc * 2; return st * 1024 + (ob ^ (((ob >> 9) & 1) << 5)); }
__host__ __device__ __forceinline__ void stage_rc(int b, int& R, int& C) { const int st = b / 1024, sb = b % 1024, swz = sb ^ (((sb >> 9) & 1) << 5); R = (st >> 1) * 16 + swz / 64; C = (st & 1) * 32 + (swz % 64) / 2; }
__host__ __device__ __forceinline__ int perm32(int rho) { const int n = rho >> 4, i = rho & 15; return 8 * (i >> 2) + 4 * n + (i & 3); }

struct Unit { int pm, pn; };
struct Gemm { const bf16_t* A; const bf16_t* Bt; int M, N, K; };

struct StaticOrder {
    int nM, nN, nwg, G, c, rep;
    __host__ __device__ void init(int M, int N, int G_, int c_) { nM = M / BM; nN = N / BM; nwg = nM * nN; G = G_; c = c_; rep = 1; }
    __host__ __device__ bool next(int i, Unit& u) const {
        const long L = (long)i * G + c; if (L >= (long)nwg * rep) return false;
        int wgid = (int)(L % nwg); { const int q = nwg / NXCD, r = nwg % NXCD, xcd = wgid % NXCD, off = wgid / NXCD; wgid = (xcd < r ? xcd * (q + 1) : r * (q + 1) + (xcd - r) * q) + off; }
        const int nig = WGM * nN, gid = wgid / nig, fm = gid * WGM, gsz = (nM - fm) < WGM ? (nM - fm) : WGM;
        u.pm = fm + ((wgid % nig) % gsz); u.pn = (wgid % nig) / gsz; return true;
    }
    __device__ __forceinline__ void a_ready(const Unit&) const {}
    __device__ __forceinline__ void done(const Unit&) const {}
};

__device__ __forceinline__ unsigned cvt_pk_bf16(float lo, float hi) { unsigned r; asm volatile("v_cvt_pk_bf16_f32 %0, %1, %2" : "=v"(r) : "v"(lo), "v"(hi)); return r; }
typedef float f32x2 __attribute__((ext_vector_type(2)));
template <class Epi, class Sched, bool ALIGN_EPI = false, bool SP2 = false>
__device__ __forceinline__ void gemm_phase(PG8_LAS unsigned char* lds, const Gemm g, const Sched& S, const Epi& E) {
    int tid_ = threadIdx.x; asm volatile("" : "+v"(tid_)); const int tid = tid_, wid = __builtin_amdgcn_readfirstlane(tid >> 6), lane = tid & 63, wr = wid >> 2, wc = wid & 3, fr = lane & 15, fq = lane >> 4;
    const int K = g.K, nt = K / BK;
    unsigned voffA[2], voffB[2];
#pragma unroll
    for (int i = 0; i < 2; ++i) { int R, C; stage_rc(tid * 16 + i * 8192, R, C); const int Rb = Epi::PERM ? ((R & ~31) + perm32(R & 31)) : R;
        voffA[i] = (unsigned)(R * K + C) * 2u; voffB[i] = (unsigned)(Rb * K + C) * 2u; }
    const size_t kstep = (size_t)(BK * 2);
    const size_t hstep = (size_t)HALF * K * 2;
    const size_t tstep = 2 * hstep;
    const unsigned ldsw = (unsigned)wid * 1024u;
    const int aoff = lds_byte(wr * 64 + fr, fq * 8), boff = lds_byte(wc * 32 + fr, fq * 8);
#define PG8_SA(b, h) (((b) * 2 + (h)) * HTB)
#define PG8_SB(b, h) ((4 + (b) * 2 + (h)) * HTB)
#define PG8_STAGE(bufoff, gbase, voff) do { _Pragma("unroll") for (int _i = 0; _i < 2; ++_i) \
        __builtin_amdgcn_global_load_lds((const unsigned*)((const char*)(gbase) + (voff)[_i]), (PG8_LAS unsigned*)(lds + (bufoff) + ldsw + _i * 8192), 16, 0, 0); } while (0)
#define PG8_LDA(dst, b, h) do { _Pragma("unroll") for (int m = 0; m < 4; ++m) _Pragma("unroll") for (int k = 0; k < 2; ++k) dst[m][k] = *(const PG8_LAS bf16x8*)(lds + PG8_SA(b, h) + aoff + m * 2048 + k * 1024); } while (0)
#define PG8_LDB(dst, b, h) do { _Pragma("unroll") for (int n = 0; n < 2; ++n) _Pragma("unroll") for (int k = 0; k < 2; ++k) dst[n][k] = *(const PG8_LAS bf16x8*)(lds + PG8_SB(b, h) + boff + n * 2048 + k * 1024); } while (0)
#define PG8_MMA(ai, bj, At, Bt) do { __builtin_amdgcn_s_setprio(1); _Pragma("unroll") for (int m = 0; m < 4; ++m) _Pragma("unroll") for (int n = 0; n < 2; ++n) _Pragma("unroll") for (int k = 0; k < 2; ++k) \
        acc[ai][bj][m][n] = __builtin_amdgcn_mfma_f32_16x16x32_bf16(Bt[n][k], At[m][k], acc[ai][bj][m][n], 0, 0, 0); __builtin_amdgcn_s_setprio(0); } while (0)
#define PG8_WAIT_V(n) asm volatile("s_waitcnt vmcnt(" #n ")" ::: "memory")
#define PG8_WAIT_L(n) asm volatile("s_waitcnt lgkmcnt(" #n ")" ::: "memory")
#define PG8_BAR __builtin_amdgcn_s_barrier()
#define PG8_SCHED __builtin_amdgcn_sched_barrier(0)
    Unit cur, nxt; int ui = 0;
    if (!S.next(0, cur)) return;
    f32x4 acc[2][2][4][2];
#pragma unroll
    for (int a = 0; a < 2; ++a)
#pragma unroll
        for (int b = 0; b < 2; ++b)
#pragma unroll
            for (int m = 0; m < 4; ++m)
#pragma unroll
                for (int n = 0; n < 2; ++n) acc[a][b][m][n] = (f32x4){0.f, 0.f, 0.f, 0.f};
    bf16x8 At[4][2], B0[2][2], B1[2][2];
    const char* cA = (const char*)g.A + (size_t)cur.pm * tstep; const char* cB = (const char*)g.Bt + (size_t)cur.pn * tstep;
    S.a_ready(cur);
    if constexpr (SP2) {
        PG8_STAGE(PG8_SB(0, 0), cB, voffB); PG8_STAGE(PG8_SB(0, 1), cB + hstep, voffB); PG8_STAGE(PG8_SA(0, 0), cA, voffA); PG8_STAGE(PG8_SA(0, 1), cA + hstep, voffA);
        if (wr == 1) PG8_BAR;
        PG8_WAIT_V(2); PG8_BAR;
        PG8_STAGE(PG8_SB(1, 0), cB + kstep, voffB); PG8_STAGE(PG8_SA(1, 0), cA + kstep, voffA); PG8_STAGE(PG8_SB(1, 1), cB + hstep + kstep, voffB);
        PG8_WAIT_V(6); PG8_BAR;
    } else {
        PG8_STAGE(PG8_SB(0, 0), cB, voffB); PG8_STAGE(PG8_SA(0, 0), cA, voffA); PG8_STAGE(PG8_SB(0, 1), cB + hstep, voffB); PG8_STAGE(PG8_SA(0, 1), cA + hstep, voffA);
        if (wr == 1) PG8_BAR;
        PG8_WAIT_V(4); PG8_BAR;
        PG8_STAGE(PG8_SB(1, 0), cB + kstep, voffB); PG8_STAGE(PG8_SA(1, 0), cA + kstep, voffA); PG8_STAGE(PG8_SB(1, 1), cB + hstep + kstep, voffB);
        PG8_WAIT_V(6); PG8_BAR;
    }
    for (;;) {
        const bool has_next = S.next(ui + 1, nxt);
        const char* nA = has_next ? (const char*)g.A + (size_t)nxt.pm * tstep : cA; const char* nB = has_next ? (const char*)g.Bt + (size_t)nxt.pn * tstep : cB;
        for (int t = 0; t < nt; t += 2) {
            const bool last = (t == nt - 2);
            const char* a1 = cA + (size_t)(t + 1) * kstep;
            const char* a2 = last ? nA : cA + (size_t)(t + 2) * kstep; const char* b2 = last ? nB : cB + (size_t)(t + 2) * kstep;
            const char* a3 = a2 + kstep; const char* b3 = b2 + kstep;
            if (last && has_next) S.a_ready(nxt);
            if constexpr (SP2) {
            PG8_LDB(B0, 0, 0); PG8_LDB(B1, 0, 1); PG8_SCHED; PG8_LDA(At, 0, 0); PG8_STAGE(PG8_SA(1, 1), a1 + hstep, voffA);
            PG8_WAIT_V(8); PG8_WAIT_L(0); PG8_BAR; PG8_MMA(0, 0, At, B0); PG8_MMA(0, 1, At, B1); PG8_BAR; PG8_SCHED;
            PG8_LDA(At, 0, 1); PG8_STAGE(PG8_SB(0, 0), b2, voffB); PG8_STAGE(PG8_SB(0, 1), b2 + hstep, voffB); PG8_STAGE(PG8_SA(0, 0), a2, voffA);
            PG8_WAIT_V(8); PG8_WAIT_L(0); PG8_BAR; PG8_MMA(1, 0, At, B0); PG8_MMA(1, 1, At, B1); PG8_BAR; PG8_SCHED;
            PG8_LDB(B0, 1, 0); PG8_LDB(B1, 1, 1); PG8_SCHED; PG8_LDA(At, 1, 0); PG8_STAGE(PG8_SA(0, 1), a2 + hstep, voffA);
            PG8_WAIT_V(8); PG8_WAIT_L(0); PG8_BAR; PG8_MMA(0, 0, At, B0); PG8_MMA(0, 1, At, B1); PG8_BAR; PG8_SCHED;
            PG8_LDA(At, 1, 1); PG8_STAGE(PG8_SB(1, 0), b3, voffB); PG8_STAGE(PG8_SB(1, 1), b3 + hstep, voffB); PG8_STAGE(PG8_SA(1, 0), a3, voffA);
            PG8_WAIT_V(8); PG8_WAIT_L(0); PG8_BAR; PG8_MMA(1, 0, At, B0); PG8_MMA(1, 1, At, B1); PG8_BAR; PG8_SCHED;
            } else {
            PG8_LDB(B0, 0, 0); PG8_SCHED; PG8_LDA(At, 0, 0); PG8_STAGE(PG8_SA(1, 1), a1 + hstep, voffA);
            PG8_WAIT_L(8); PG8_BAR; PG8_WAIT_L(0); PG8_MMA(0, 0, At, B0); PG8_BAR; PG8_SCHED;
            PG8_LDB(B1, 0, 1); PG8_STAGE(PG8_SB(0, 0), b2, voffB);
            PG8_BAR; PG8_WAIT_L(0); PG8_MMA(0, 1, At, B1); PG8_BAR;
            PG8_LDA(At, 0, 1); PG8_STAGE(PG8_SA(0, 0), a2, voffA);
            PG8_BAR; PG8_WAIT_L(0); PG8_MMA(1, 0, At, B0); PG8_BAR; PG8_SCHED;
            PG8_STAGE(PG8_SB(0, 1), b2 + hstep, voffB);
            PG8_WAIT_V(6); PG8_BAR; PG8_MMA(1, 1, At, B1); PG8_BAR;
            PG8_LDB(B0, 1, 0); PG8_SCHED; PG8_LDA(At, 1, 0); PG8_STAGE(PG8_SA(0, 1), a2 + hstep, voffA);
            PG8_WAIT_L(8); PG8_BAR; PG8_WAIT_L(0); PG8_MMA(0, 0, At, B0); PG8_BAR; PG8_SCHED;
            PG8_LDB(B1, 1, 1); PG8_STAGE(PG8_SB(1, 0), b3, voffB);
            PG8_BAR; PG8_WAIT_L(0); PG8_MMA(0, 1, At, B1); PG8_BAR;
            PG8_LDA(At, 1, 1); PG8_STAGE(PG8_SA(1, 0), a3, voffA);
            PG8_BAR; PG8_WAIT_L(0); PG8_MMA(1, 0, At, B0); PG8_BAR; PG8_SCHED;
            PG8_STAGE(PG8_SB(1, 1), b3 + hstep, voffB);
            PG8_WAIT_V(6); PG8_BAR; PG8_MMA(1, 1, At, B1); PG8_BAR;
            }
        }
        if constexpr (ALIGN_EPI) { if (wr == 0) PG8_BAR; }
        if constexpr (!Epi::AFTER_DRAIN) { E(acc, cur, wr, wc, fr, fq); S.done(cur); }
        if (!has_next) break;
#pragma unroll
        for (int a = 0; a < 2; ++a)
#pragma unroll
            for (int b = 0; b < 2; ++b)
#pragma unroll
                for (int m = 0; m < 4; ++m)
#pragma unroll
                    for (int n = 0; n < 2; ++n) acc[a][b][m][n] = (f32x4){0.f, 0.f, 0.f, 0.f};
        cur = nxt; cA = nA; cB = nB; ++ui;
        if constexpr (ALIGN_EPI) { if (wr == 1) PG8_BAR; }
    }
    PG8_WAIT_V(0);
    if constexpr (!ALIGN_EPI) { if (wr == 0) PG8_BAR; }
    PG8_BAR;
    if constexpr (Epi::AFTER_DRAIN) { E.fused(acc, cur, wr, wc, fr, fq, lds, wid, lane); S.done(cur); }
#undef PG8_SA
#undef PG8_SB
#undef PG8_STAGE
#undef PG8_LDA
#undef PG8_LDB
#undef PG8_MMA
#undef PG8_WAIT_V
#undef PG8_WAIT_L
#undef PG8_BAR
#undef PG8_SCHED
}
}
#define LAS __attribute__((address_space(3)))
#define XB_TMO      128
#define XB_XCNT(j)  (256  + 64 * (j))
#define XB_XSUB(j)  (1280 + 64 * (j))
#define XB_XGEN(j)  (2304 + 64 * (j))
#define XB_TOP      3328
#define XB_TOPGEN   3392
#define XCD_BAR_WORDS 3456
#define XB_SPIN_CAP (1u << 18)

__device__ __forceinline__ unsigned xb_ld(unsigned* p)              { return __hip_atomic_load(p, __ATOMIC_RELAXED, __HIP_MEMORY_SCOPE_AGENT); }
__device__ __forceinline__ unsigned xb_add(unsigned* p, unsigned v) { return __hip_atomic_fetch_add(p, v, __ATOMIC_RELAXED, __HIP_MEMORY_SCOPE_AGENT); }
__device__ __forceinline__ unsigned xb_xcc_id() { return (unsigned)__builtin_amdgcn_s_getreg((3 << 11) | 20) & 0xFu; }
#define XB_SPIN(cond, bar) do { unsigned _sp = 0; while (cond) { __builtin_amdgcn_s_sleep(1); \
    if ((++_sp & 255u) == 0u) { if (xb_ld(&(bar)[XB_TMO])) break; if (_sp > XB_SPIN_CAP) { atomicAdd(&(bar)[XB_TMO], 1u); break; } } } } while (0)

struct XcdBarrier {
    unsigned* bar; unsigned x;
    volatile LAS unsigned* st;
};

__device__ __forceinline__ XcdBarrier xcd_barrier_post(unsigned* bar, volatile LAS unsigned* st) {
    XcdBarrier b; b.bar = bar; b.x = xb_xcc_id(); b.st = st;
    if (threadIdx.x == 0) (void)xb_add(&bar[XB_XCNT(b.x)], 1u);
    return b;
}
__device__ __forceinline__ void xcd_barrier_complete(unsigned* bar, unsigned x, unsigned& nloc, unsigned& nx) {
    const unsigned G = gridDim.x * gridDim.y * gridDim.z;
    unsigned sum, cnt, mine, sp = 0u;
    for (;;) {
        sum = 0u; cnt = 0u; mine = 0u;
#pragma unroll
        for (unsigned j = 0; j < 16; ++j) { const unsigned c = xb_ld(&bar[XB_XCNT(j)]); sum += c; cnt += (c > 0u) ? 1u : 0u; mine = (j == x) ? c : mine; }
        if (sum == G) break;
        __builtin_amdgcn_s_sleep(1);
        if ((++sp & 255u) == 0u) { if (xb_ld(&bar[XB_TMO])) break; if (sp > XB_SPIN_CAP) { atomicAdd(&bar[XB_TMO], 1u); break; } }
    }
    nloc = mine > 0u ? mine : 1u; nx = cnt > 0u ? cnt : 1u;
}

__device__ __forceinline__ void xcd_barrier(const XcdBarrier& b) {
    asm volatile("s_waitcnt vmcnt(0)" ::: "memory");
    __syncthreads();
    if (threadIdx.x == 0) {
        unsigned* bar = b.bar;
        __builtin_amdgcn_s_waitcnt(0);
        unsigned nloc = b.st[0], nx = b.st[1];
        if (nloc == 0u) { xcd_barrier_complete(bar, b.x, nloc, nx); b.st[0] = nloc; b.st[1] = nx; }
        const unsigned old = xb_add(&bar[XB_XSUB(b.x)], 1u);
        const unsigned gen = old / nloc;
        if (old + 1u == (gen + 1u) * nloc) {
            __builtin_amdgcn_fence(__ATOMIC_RELEASE, "agent");
            asm volatile("s_waitcnt vmcnt(0)" ::: "memory");
            const unsigned og = xb_add(&bar[XB_TOP], 1u);
            const unsigned tg = og / nx;
            if (og + 1u == (tg + 1u) * nx) xb_add(&bar[XB_TOPGEN], 1u);
            else XB_SPIN(xb_ld(&bar[XB_TOPGEN]) == tg, bar);
            __builtin_amdgcn_fence(__ATOMIC_ACQUIRE, "agent");
            xb_add(&bar[XB_XGEN(b.x)], 1u);
            asm volatile("s_waitcnt vmcnt(0)" ::: "memory");
        } else {
            XB_SPIN(xb_ld(&bar[XB_XGEN(b.x)]) == gen, bar);
            __builtin_amdgcn_fence(__ATOMIC_ACQUIRE, "agent");
            asm volatile("s_waitcnt vmcnt(0)" ::: "memory");
        }
    }
    __syncthreads();
}

#ifndef TP
#define TP 0xffff
#endif
#ifndef TAILCONV
#define TAILCONV 0
#endif
#ifndef REPMASK
#define REPMASK 0
#endif
#ifndef RN
#define RN 2
#endif
#define REPN(bit) (((REPMASK >> (bit)) & 1) ? RN : 1)
#define GAS __attribute__((address_space(1)))
#ifndef LAS
#define LAS __attribute__((address_space(3)))
#endif
typedef unsigned short bf16;
typedef unsigned v4u __attribute__((ext_vector_type(4)));
typedef unsigned v2u __attribute__((ext_vector_type(2)));
typedef float f32x4 __attribute__((ext_vector_type(4)));
typedef float f32x16 __attribute__((ext_vector_type(16)));
typedef short bf16x8 __attribute__((ext_vector_type(8)));

constexpr int NWAVES = 8, NTHR = 512;
constexpr int DM = 2048, MP = 8192, MS = 64, MR = 8256, MPAD = 8448;
constexpr int DINP = 6912, DFF = 5632, DUP = 11264, PP = 6912  ;
constexpr int C_AX = 0, C_AG = 512, C_Q = 1024, C_K = 1536, C_V = 2048, C_GQ = 2560, C_B = 5632, C_A = 5640, C_Z = 5888;
constexpr float EPS = 1e-6f;
constexpr float LOG2E = 1.4426950408889634f;
constexpr float QSCALE = 0.125f * LOG2E;

constexpr size_t O_Y = 0;
constexpr size_t O_KP = (size_t)MR * DM;
constexpr size_t O_VP = O_KP + (size_t)2 * 4 * 2048 * 512;
constexpr size_t O_KS = O_VP + (size_t)2 * 4 * 2048 * 512;
constexpr size_t O_VS = O_KS + (size_t)2 * 64 * 512;
constexpr size_t O_LCP = O_VS + (size_t)2 * 64 * 512;
constexpr size_t O_LCS = O_LCP + (size_t)2 * 4 * 3 * 512;
constexpr size_t O_LHP = O_LCS + (size_t)2 * 8 * 3 * 512;
constexpr size_t O_LHS = O_LHP + (size_t)2 * 4 * 512;
constexpr size_t O_GCP = O_LHS + (size_t)2 * 8 * 512;
constexpr size_t O_GCS = O_GCP + (size_t)2 * 4 * 3 * 3072;
constexpr size_t O_GP = O_GCS + (size_t)2 * 8 * 3 * 3072;
constexpr size_t O_GS = O_GP + (size_t)2 * 4 * 8 * 128 * 128;
constexpr size_t O_FCP = O_GS + (size_t)2 * 8 * 8 * 128 * 128;
constexpr size_t O_FCS = O_FCP + (size_t)2 * 4 * 2 * 5632;
constexpr size_t O_END = O_FCS + (size_t)2 * 8 * 2 * 5632;
static_assert(O_END == 37502976, "output size");

constexpr size_t MiB = 1u << 20;
constexpr size_t WS_CTL = 0, CTL_ZERO_BYTES = 65536;
constexpr size_t WS_WIN = 1 * MiB;
constexpr size_t WS_WOUT = 55 * MiB;
constexpr size_t WS_WUP = 71 * MiB;
constexpr size_t WS_WDN = 159 * MiB;
constexpr size_t WS_MODP = 203 * MiB;
constexpr size_t WS_MOD = 208 * MiB;
constexpr size_t WS_H = 210 * MiB;
constexpr size_t WS_PROJ = 243 * MiB;
constexpr size_t WS_LH = 355 * MiB;
constexpr size_t WS_LA = 372 * MiB;
constexpr size_t WS_CARRY = 389 * MiB;
constexpr size_t WS_WF = 391 * MiB;
constexpr size_t WS_QEF = 408 * MiB;
constexpr size_t WS_KDF = 425 * MiB;
constexpr size_t WS_QKF = 442 * MiB;
constexpr size_t WS_UF = 451 * MiB;
constexpr size_t WS_GL = 485 * MiB;
constexpr size_t WS_OGDN = 486 * MiB;
constexpr size_t WS_OATT = 519 * MiB;
constexpr size_t WS_SPO = 536 * MiB;
constexpr size_t WS_SPT = 541 * MiB;
constexpr size_t WS_MIX = 542 * MiB;
constexpr size_t WS_MIXO = 575 * MiB;
constexpr size_t WS_GV = 641 * MiB;
constexpr size_t WS_ACT = 823 * MiB;
constexpr size_t WS_TAILG = 914 * MiB;
constexpr size_t WS_HEADG = 920 * MiB;
constexpr size_t WS_HEADV = 926 * MiB;
constexpr size_t WS_END = 932 * MiB;
constexpr size_t WIN_L = (size_t)DINP * DM * 2, WOUT_L = (size_t)DM * DM * 2, WUP_L = (size_t)DUP * DM * 2, WDN_L = (size_t)DM * DFF * 2;

constexpr int CW_BAR = 4096;
constexpr int CW_QUEUE = 8192;

constexpr int LDS_MISC = 147456;
constexpr int LDS_BYTES = 148480;

constexpr int NPHASE = 23;
template <int CTRL> __device__ __forceinline__ float dppf(float x) { return __builtin_bit_cast(float, __builtin_amdgcn_mov_dpp(__builtin_bit_cast(int, x), CTRL, 0xf, 0xf, true)); }

#define LDS_WAIT() asm volatile("s_waitcnt lgkmcnt(0)" ::: "memory")
__device__ __forceinline__ float bf2f(unsigned short u) { return __uint_as_float((unsigned)u << 16); }
__device__ __forceinline__ float bflo(unsigned u) { return __uint_as_float(u << 16); }
__device__ __forceinline__ float bfhi(unsigned u) { return __uint_as_float(u & 0xffff0000u); }
__device__ __forceinline__ unsigned cvtpk(float lo, float hi) {
    typedef float f2_t __attribute__((ext_vector_type(2))); typedef __bf16 b2_t __attribute__((ext_vector_type(2)));
    f2_t v = {lo, hi}; b2_t b = __builtin_convertvector(v, b2_t); return __builtin_bit_cast(unsigned, b); }
__device__ __forceinline__ unsigned short f2bf(float f) { return (unsigned short)(cvtpk(f, 0.f) & 0xffffu); }
__device__ __forceinline__ float wave_sum(float v) {
#pragma unroll
    for (int o = 1; o < 64; o <<= 1) v += __shfl_xor(v, o);
    return v;
}
__device__ __forceinline__ float sigmoidf_(float x) { return __builtin_amdgcn_rcpf(1.0f + __builtin_amdgcn_exp2f(-1.4426950408889634f * x)); }
__device__ __forceinline__ float siluf_(float x) { return x * __builtin_amdgcn_rcpf(1.0f + __builtin_amdgcn_exp2f(-1.4426950408889634f * x)); }
__device__ __forceinline__ float softplusf_(float x) {
    const float t = __builtin_amdgcn_exp2f(-1.4426950408889634f * fabsf(x));
    const float series = t * (1.0f - t * (0.5f - t * (0.33333334f - t * (0.25f - 0.2f * t))));
    const float lg = 0.6931471805599453f * __builtin_amdgcn_logf(1.0f + t);
    return fmaxf(x, 0.f) + (t < 0.03125f ? series : lg);
}
__device__ __forceinline__ float gelu_tanh(float x) { const float u = 0.7978845608028654f * (x + 0.044715f * x * x * x); return x * sigmoidf_(2.0f * u); }
__device__ __forceinline__ int crow(int r, int hi) { return (r & 3) + 8 * (r >> 2) + 4 * hi; }
__device__ __forceinline__ int seq_row0(int s) { return s < 4 ? s * 2048 : 8192 + (s - 4) * 8; }

typedef const __attribute__((address_space(4))) unsigned long long* kptr_t;
struct Ctx {
    kptr_t kp;
    GAS float* out; GAS unsigned char* ws;
    LAS unsigned char* lds;
    int tid, lane, wave, G, bid;
    __device__ __forceinline__ const float* in(int i) const { return (const float*)(GAS const float*)kp[i]; }
};
#define KA_FRESH(C) do { asm volatile("" : "+s"((C).kp)); asm volatile("" : "+s"((C).ws)); asm volatile("" : "+s"((C).out)); asm volatile("" : "+v"((C).tid)); (C).lane = (C).tid & 63; (C).wave = __builtin_amdgcn_readfirstlane((C).tid >> 6); } while (0)
#define WSP(T, off) ((T*)(GAS T*)(C.ws + (off)))
#define OUTB ((float*)C.out)

__device__ __forceinline__ void tr_item(const float* __restrict__ W, int K, int Nsrc, int sc0, int nv, bf16* WT, int n0, int k0, LAS float* scr, int lane) {
    const float* src = W + (size_t)k0 * Nsrc + sc0 + lane;
    const bool ok = lane < nv;
#pragma unroll 32
    for (int i = 0; i < 64; ++i) { const float v = ok ? __builtin_nontemporal_load(src + (size_t)i * Nsrc) : 0.f; scr[i * 65 + lane] = v; }
    LDS_WAIT(); asm volatile("" ::: "memory");
    const int c = lane & 7;
#pragma unroll
    for (int j = 0; j < 8; ++j) { const int n = (lane >> 3) + 8 * j; const LAS float* s = scr + (8 * c) * 65 + n;
        v4u o; o.x = cvtpk(s[0 * 65], s[1 * 65]); o.y = cvtpk(s[2 * 65], s[3 * 65]); o.z = cvtpk(s[4 * 65], s[5 * 65]); o.w = cvtpk(s[6 * 65], s[7 * 65]);
        __builtin_nontemporal_store(o, (GAS v4u*)(WT + (size_t)(n0 + n) * K + k0 + 8 * c)); }
    LDS_WAIT(); asm volatile("" ::: "memory");
}

struct ConvItem { const float* src; size_t stride; bool ok; bf16* dst; int K; };
__device__ __forceinline__ ConvItem conv_item(Ctx& C, int l, int kind, int r, int lane) {
    ConvItem it;
    if (kind == 0) { const int nb = r >> 5, kb = r & 31; const int n0 = nb * 64;
        int sc0, nv; if (n0 < 5632) { sc0 = n0; nv = 64; } else if (n0 == 5632) { sc0 = 6656; nv = 16; } else if (n0 < 5888) { sc0 = 0; nv = 0; } else { sc0 = 5632 + (n0 - 5888); nv = 64; }
        it.src = C.in(18) + (size_t)l * DM * 6672 + (size_t)(kb * 64) * 6672 + sc0 + lane; it.stride = 6672; it.ok = lane < nv; it.K = DM; it.dst = WSP(bf16, WS_WIN + l * WIN_L) + (size_t)n0 * DM + kb * 64;
    } else if (kind == 1) { const int nb = r >> 5, kb = r & 31;
        it.src = C.in(33) + (size_t)l * DM * DM + (size_t)(kb * 64) * DM + nb * 64 + lane; it.stride = DM; it.ok = true; it.K = DM; it.dst = WSP(bf16, WS_WOUT + l * WOUT_L) + (size_t)(nb * 64) * DM + kb * 64;
    } else if (kind == 2) { const int nb = r >> 5, kb = r & 31; const int n0 = nb * 64; const int pn = n0 >> 8, bj = (n0 >> 7) & 1, c0 = n0 & 127;
        it.src = C.in(34) + (size_t)l * DM * DUP + (size_t)(kb * 64) * DUP + bj * DFF + pn * 128 + c0 + lane; it.stride = DUP; it.ok = true; it.K = DM; it.dst = WSP(bf16, WS_WUP + l * WUP_L) + (size_t)n0 * DM + kb * 64;
    } else { const int nb = r / 88, kb = r % 88;
        it.src = C.in(37) + (size_t)l * DFF * DM + (size_t)(kb * 64) * DM + nb * 64 + lane; it.stride = DM; it.ok = true; it.K = DFF; it.dst = WSP(bf16, WS_WDN + l * WDN_L) + (size_t)(nb * 64) * DFF + kb * 64;
    }
    return it;
}
__device__ __forceinline__ void conv_weights(Ctx& C, int l, int kind, int wi, int iend, int wn) {
    KA_FRESH(C);
    LAS float* scr = (LAS float*)(C.lds + C.wave * 16640);
    const int lane = C.lane;
    const int nitems = iend;
    float v[64];
    ConvItem cur;
    if (wi < nitems) { cur = conv_item(C, l, kind, wi, lane);
#pragma unroll
        for (int i = 0; i < 64; ++i) v[i] = cur.ok ? __builtin_nontemporal_load(cur.src + (size_t)i * cur.stride) : 0.f; }
#pragma unroll 1
    for (int r = wi; r < nitems; r += wn) {
#pragma unroll
        for (int i = 0; i < 64; ++i) scr[i * 65 + lane] = v[i];
        asm volatile("" ::: "memory");
        bf16* dst = cur.dst; const int K = cur.K;
        if (r + wn < nitems) { cur = conv_item(C, l, kind, r + wn, lane);
#pragma unroll
            for (int i = 0; i < 64; ++i) v[i] = cur.ok ? __builtin_nontemporal_load(cur.src + (size_t)i * cur.stride) : 0.f; }
        const int c = lane & 7;
#pragma unroll
        for (int j = 0; j < 8; ++j) { const int n = (lane >> 3) + 8 * j; const LAS float* s = scr + (8 * c) * 65 + n;
            v4u o; o.x = cvtpk(s[0 * 65], s[1 * 65]); o.y = cvtpk(s[2 * 65], s[3 * 65]); o.z = cvtpk(s[4 * 65], s[5 * 65]); o.w = cvtpk(s[6 * 65], s[7 * 65]);
            __builtin_nontemporal_store(o, (GAS v4u*)(dst + (size_t)n * K + 8 * c)); }
        asm volatile("" ::: "memory");
    }
}
__device__ __forceinline__ int conv_units(int ll) { return ll == 0 ? 202 : 148; }
__device__ __forceinline__ void conv_unit(Ctx& C, int ll, int cu) {
    int l = ll, kind, r0;
    if (cu < 16) { kind = 1; r0 = cu * 64; } else if (cu < 104) { kind = 2; r0 = (cu - 16) * 64; } else if (cu < 148) { kind = 3; r0 = (cu - 104) * 64; } else { l = 1; kind = 0; r0 = (cu - 148) * 64; }
    conv_weights(C, l, kind, r0 + C.wave, r0 + 64, NWAVES);
}
__device__ __forceinline__ void p0_weights(Ctx& C) {
    const int wi = C.bid * NWAVES + C.wave, wn = C.G * NWAVES;
    conv_weights(C, 0, 0, wi, 108 * 32, wn);
}

__device__ __forceinline__ void p0_ada(Ctx& C) {
    KA_FRESH(C);
    LAS float* sc = (LAS float*)C.lds;
    __syncthreads();
    for (int k = C.tid; k < DM; k += NTHR) {
#pragma unroll
        for (int r = 0; r < 12; ++r) { const float c = (r < 4) ? C.in(2)[r * DM + k] : C.in(3)[(r - 4) * DM + k]; sc[k * 16 + r] = siluf_(c); }
    }
    __syncthreads();
    const int gw = C.bid * NWAVES + C.wave, NGW = C.G * NWAVES;
    for (int task = gw; task < 2 * 192 * 4; task += NGW) {
        const int l = task / 768, rem = task % 768, nb = rem % 192, ks = rem / 192;
        const int n = nb * 64 + C.lane;
        const float* w = C.in(12) + ((size_t)l * DM + ks * 512) * 12288 + n;
        typedef float f2a __attribute__((ext_vector_type(2)));
        f2a ac[6];
#pragma unroll
        for (int r = 0; r < 6; ++r) ac[r] = (f2a){0.f, 0.f};
#pragma unroll 1
        for (int kk = 0; kk < 512; kk += 64) {
        if (C.G == 256) __builtin_amdgcn_s_barrier();
#pragma unroll 8
        for (int k = kk; k < kk + 64; ++k) {
            const float wv = w[(size_t)k * 12288]; const f2a w2 = {wv, wv};
            const LAS f32x4* s = (const LAS f32x4*)(sc + (ks * 512 + k) * 16);
            const f32x4 s0 = s[0], s1 = s[1], s2 = s[2];
            ac[0] = __builtin_elementwise_fma((f2a){s0.x, s0.y}, w2, ac[0]); ac[1] = __builtin_elementwise_fma((f2a){s0.z, s0.w}, w2, ac[1]);
            ac[2] = __builtin_elementwise_fma((f2a){s1.x, s1.y}, w2, ac[2]); ac[3] = __builtin_elementwise_fma((f2a){s1.z, s1.w}, w2, ac[3]);
            ac[4] = __builtin_elementwise_fma((f2a){s2.x, s2.y}, w2, ac[4]); ac[5] = __builtin_elementwise_fma((f2a){s2.z, s2.w}, w2, ac[5]);
        }
        }
        float acc[12];
#pragma unroll
        for (int r = 0; r < 6; ++r) { acc[2 * r] = ac[r].x; acc[2 * r + 1] = ac[r].y; }
        float* mp = WSP(float, WS_MODP) + ((size_t)(l * 4 + ks) * 12) * 12288 + n;
#pragma unroll
        for (int r = 0; r < 12; ++r) mp[(size_t)r * 12288] = acc[r];
    }
    __syncthreads();
}

__device__ __forceinline__ void p0b_modreduce(Ctx& C) {
    KA_FRESH(C);
    const int gt = C.bid * NTHR + C.tid, NGT = C.G * NTHR;
    const float* mp = WSP(float, WS_MODP); float* md = WSP(float, WS_MOD);
    for (int e = gt; e < 2 * 12 * 12288; e += NGT) {
        const int l = e / (12 * 12288), rem = e % (12 * 12288), n = rem % 12288;
        float s = C.in(13)[l * 12288 + n];
#pragma unroll
        for (int ks = 0; ks < 4; ++ks) s += mp[(size_t)(l * 4 + ks) * 12 * 12288 + rem];
        md[e] = s;
    }
}

__device__ __forceinline__ void store_h_row(bf16* hrow, const f32x4 (&v)[8], float rs, const float* g, const float* scale, const float* shift, int lane) {
#pragma unroll
    for (int j = 0; j < 8; ++j) { const int e = 4 * lane + 256 * j;
        const f32x4 gg = *(const f32x4*)(g + e), sc = *(const f32x4*)(scale + e), sh = *(const f32x4*)(shift + e);
        const float a = v[j].x * rs * gg.x * (1.f + sc.x) + sh.x, b = v[j].y * rs * gg.y * (1.f + sc.y) + sh.y;
        const float c = v[j].z * rs * gg.z * (1.f + sc.z) + sh.z, d = v[j].w * rs * gg.w * (1.f + sc.w) + sh.w;
        v2u o; o.x = cvtpk(a, b); o.y = cvtpk(c, d); *(GAS v2u*)(hrow + e) = o; }
}
__device__ __forceinline__ int row_seq(int row) { return row < MP ? (row >> 11) : 4 + ((row - MP) >> 3); }

__device__ __forceinline__ void phase_n1(Ctx& C) {
    KA_FRESH(C);
    const int gw = C.bid * NWAVES + C.wave, NGW = C.G * NWAVES;
    f32x4 nx[8];
    if (gw < MR) { const float* xr = gw < MP ? C.in(0) + (size_t)gw * DM : C.in(1) + (size_t)(gw - MP) * DM;
#pragma unroll
        for (int j = 0; j < 8; ++j) nx[j] = *(const f32x4*)(xr + 4 * C.lane + 256 * j); }
    for (int row = gw; row < MR; row += NGW) {
        f32x4 v[8]; float ss = 0.f;
#pragma unroll
        for (int j = 0; j < 8; ++j) { v[j] = nx[j]; ss += v[j].x * v[j].x + v[j].y * v[j].y + v[j].z * v[j].z + v[j].w * v[j].w; }
        asm volatile("" ::: "memory");
        { const int nrow = row + NGW; if (nrow < MR) { const float* xr = nrow < MP ? C.in(0) + (size_t)nrow * DM : C.in(1) + (size_t)(nrow - MP) * DM;
#pragma unroll
            for (int j = 0; j < 8; ++j) nx[j] = *(const f32x4*)(xr + 4 * C.lane + 256 * j); } }
        const float rs = rsqrtf(wave_sum(ss) * (1.f / DM) + EPS);
        const float* md = WSP(float, WS_MOD) + (size_t)(0 * 12 + row_seq(row)) * 12288;
        store_h_row(WSP(bf16, WS_H) + (size_t)row * DM, v, rs, C.in(14), md + 1 * DM, md + 0 * DM, C.lane);
    }
}

constexpr size_t WS_X16 = WS_MIXO + 33 * MiB;
template <bool FIRST> struct ResidIn { v2u fp[8]; v2u xp[8]; };
template <> struct ResidIn<true> { v2u fp[8]; f32x4 xp[8]; };
template <bool FIRST>
__device__ __forceinline__ void resid_load(Ctx& C, int row, const bf16* src, const bf16* X16, ResidIn<FIRST>& in) {
#pragma unroll
    for (int j = 0; j < 8; ++j) in.fp[j] = *(const v2u*)(src + (size_t)row * DM + 4 * C.lane + 256 * j);
    if constexpr (FIRST) {
        const float* xin = row < MP ? C.in(0) + (size_t)row * DM : C.in(1) + (size_t)(row - MP) * DM;
#pragma unroll
        for (int j = 0; j < 8; ++j) in.xp[j] = *(const f32x4*)(xin + 4 * C.lane + 256 * j);
    } else {
#pragma unroll
        for (int j = 0; j < 8; ++j) in.xp[j] = *(const v2u*)(X16 + (size_t)row * DM + 4 * C.lane + 256 * j);
    }
}
template <bool FIRST>
__device__ __forceinline__ void resid_rows(Ctx& C, int l, int which, bool dry, int row_lo, int nrows) {
    const bf16* src = WSP(bf16, WS_MIXO);
    bf16* X16 = WSP(bf16, WS_X16);
    const bool last = (l == 1 && which == 1);
    const bool has_h = (which == 0) || (l == 0);
    const int s = row_seq(row_lo);
    const float* md = WSP(float, WS_MOD) + (size_t)(l * 12 + s) * 12288;
    f32x4 gg[8]; v2u hsp[8], hbp[8];
    {
        const float* gate = md + (which == 0 ? 2 : 5) * DM;
        const float* gpost = (which == 0 ? C.in(15) : C.in(17)) + l * DM;
        const float* gpre = (which == 0) ? C.in(16) + l * DM : C.in(14) + 1 * DM;
        const float* mdn = (which == 0) ? md : WSP(float, WS_MOD) + (size_t)(1 * 12 + s) * 12288;
        const float* scale = mdn + (which == 0 ? 4 : 1) * DM; const float* shift = mdn + (which == 0 ? 3 : 0) * DM;
#pragma unroll
        for (int j = 0; j < 8; ++j) { const int e = 4 * C.lane + 256 * j;
            gg[j] = *(const f32x4*)(gate + e) * *(const f32x4*)(gpost + e);
            if (has_h) { const f32x4 a = *(const f32x4*)(gpre + e) * (*(const f32x4*)(scale + e) + 1.0f), b = *(const f32x4*)(shift + e);
                hsp[j].x = cvtpk(a.x, a.y); hsp[j].y = cvtpk(a.z, a.w); hbp[j].x = cvtpk(b.x, b.y); hbp[j].y = cvtpk(b.z, b.w); } else { hsp[j] = (v2u){0u, 0u}; hbp[j] = hsp[j]; } }
    }
    ResidIn<FIRST> in;
    resid_load<FIRST>(C, row_lo, src, X16, in);
    bf16* Ho = dry ? WSP(bf16, WS_GV) : WSP(bf16, WS_H);
#pragma unroll 1
    for (int r = 0; r < nrows; ++r) {
        const int row = row_lo + r;
        f32x4 f[8], xv[8]; float ss = 0.f;
#pragma unroll
        for (int j = 0; j < 8; ++j) { f[j].x = bflo(in.fp[j].x); f[j].y = bfhi(in.fp[j].x); f[j].z = bflo(in.fp[j].y); f[j].w = bfhi(in.fp[j].y);
            if constexpr (FIRST) xv[j] = in.xp[j]; else { xv[j].x = bflo(in.xp[j].x); xv[j].y = bfhi(in.xp[j].x); xv[j].z = bflo(in.xp[j].y); xv[j].w = bfhi(in.xp[j].y); } }
        asm volatile("" ::: "memory");
        if constexpr (!FIRST) { if (r + 1 < nrows) resid_load<FIRST>(C, row + 1, src, X16, in); }
#pragma unroll
        for (int j = 0; j < 8; ++j) ss += f[j].x * f[j].x + f[j].y * f[j].y + f[j].z * f[j].z + f[j].w * f[j].w;
        const float rs = rsqrtf(wave_sum(ss) * (1.f / DM) + EPS);
        float ss2 = 0.f;
#pragma unroll
        for (int j = 0; j < 8; ++j) { const int e = 4 * C.lane + 256 * j;
            const f32x4 o = xv[j] + (f[j] * gg[j]) * rs;
            if (!dry) { if (last) *(f32x4*)(OUTB + O_Y + (size_t)row * DM + e) = o; else { v2u w; w.x = cvtpk(o.x, o.y); w.y = cvtpk(o.z, o.w); *(GAS v2u*)(X16 + (size_t)row * DM + e) = w; } }
            f[j] = o; ss2 += o.x * o.x + o.y * o.y + o.z * o.z + o.w * o.w; }
        if (has_h) {
            const float rs2 = rsqrtf(wave_sum(ss2) * (1.f / DM) + EPS);
#pragma unroll
            for (int j = 0; j < 8; ++j) { const int e = 4 * C.lane + 256 * j; const f32x4 hs = {bflo(hsp[j].x), bfhi(hsp[j].x), bflo(hsp[j].y), bfhi(hsp[j].y)}, hb = {bflo(hbp[j].x), bfhi(hbp[j].x), bflo(hbp[j].y), bfhi(hbp[j].y)};
                const f32x4 h = (f[j] * rs2) * hs + hb;
                v2u o; o.x = cvtpk(h.x, h.y); o.y = cvtpk(h.z, h.w); *(GAS v2u*)(Ho + (size_t)row * DM + e) = o; }
        }
        if constexpr (FIRST) { if (r + 1 < nrows) resid_load<FIRST>(C, row + 1, src, X16, in); }
    }
}
template <bool FIRST>
__device__ __forceinline__ void phase_resid_t(Ctx& C, int l, int which, bool dry) {
    KA_FRESH(C);
    const int gw = C.bid * NWAVES + C.wave, NGW = C.G * NWAVES;
#pragma unroll 1
    for (int r0 = 4 * gw; r0 < MP; r0 += 4 * NGW) resid_rows<FIRST>(C, l, which, dry, r0, 4);
    if (gw < MS) resid_rows<FIRST>(C, l, which, dry, MP + gw, 1);
}
__device__ __forceinline__ void phase_resid(Ctx& C, int l, int which, bool dry = false) {
    if (l == 0 && which == 0) phase_resid_t<true>(C, l, which, dry); else phase_resid_t<false>(C, l, which, dry);
}

struct EpiIn {
    static constexpr bool PERM = true, AFTER_DRAIN = false;
    bf16* P; float* out; int layer;
    __device__ __forceinline__ void operator()(const pg8::f32x4 (&acc)[2][2][4][2], const pg8::Unit& u, int wr, int wc, int fr, int fq) const {
        const int pn = u.pn; const int row0 = u.pm * 256 + wr * 64 + fr; const int col0 = pn * 256 + wc * 32 + 8 * fq;
        const float sc = (pn == 4 || pn == 5) ? QSCALE : 1.f;
        const bool kv = (pn >= 6 && pn <= 9); const bool isv = pn >= 8; const int cbase = isv ? C_V : C_K;
#pragma unroll
        for (int ai = 0; ai < 2; ++ai)
#pragma unroll
            for (int m = 0; m < 4; ++m) { const int row = row0 + ai * 128 + m * 16;
#pragma unroll
                for (int bj = 0; bj < 2; ++bj) { const int col = col0 + bj * 128;
                    const pg8::f32x4 v0 = acc[ai][bj][m][0] * sc, v1 = acc[ai][bj][m][1] * sc;
                    v4u w; w.x = cvtpk(v0[0], v0[1]); w.y = cvtpk(v0[2], v0[3]); w.z = cvtpk(v1[0], v1[1]); w.w = cvtpk(v1[2], v1[3]);
                    *(GAS v4u*)(P + (size_t)row * PP + col) = w;
                    if (kv && row < MR) {
                        float* o = (row < MP) ? out + (isv ? O_VP : O_KP) + (size_t)layer * 4194304 + (size_t)row * 512 + (col - cbase)
                                              : out + (isv ? O_VS : O_KS) + (size_t)layer * 32768 + (size_t)(row - MP) * 512 + (col - cbase);
                        *(pg8::f32x4*)o = v0; *(pg8::f32x4*)(o + 4) = v1; }
                } }
    }
};
struct EpiBf {
    static constexpr bool PERM = true, AFTER_DRAIN = false;
    bf16* O; int ldc;
    __device__ __forceinline__ void operator()(const pg8::f32x4 (&acc)[2][2][4][2], const pg8::Unit& u, int wr, int wc, int fr, int fq) const {
        const int row0 = u.pm * 256 + wr * 64 + fr; const int col0 = u.pn * 256 + wc * 32 + 8 * fq;
#pragma unroll
        for (int ai = 0; ai < 2; ++ai)
#pragma unroll
            for (int m = 0; m < 4; ++m) { const int row = row0 + ai * 128 + m * 16;
#pragma unroll
                for (int bj = 0; bj < 2; ++bj) { const int col = col0 + bj * 128;
                    const pg8::f32x4 v0 = acc[ai][bj][m][0], v1 = acc[ai][bj][m][1];
                    v4u w; w.x = cvtpk(v0[0], v0[1]); w.y = cvtpk(v0[2], v0[3]); w.z = cvtpk(v1[0], v1[1]); w.w = cvtpk(v1[2], v1[3]);
                    *(GAS v4u*)(O + (size_t)row * ldc + col) = w; } }
    }
};
struct EpiF32 {
    static constexpr bool PERM = true, AFTER_DRAIN = false;
    float* O; int ldc;
    __device__ __forceinline__ void operator()(const pg8::f32x4 (&acc)[2][2][4][2], const pg8::Unit& u, int wr, int wc, int fr, int fq) const {
        const int row0 = u.pm * 256 + wr * 64 + fr; const int col0 = u.pn * 256 + wc * 32 + 8 * fq;
#pragma unroll
        for (int ai = 0; ai < 2; ++ai)
#pragma unroll
            for (int m = 0; m < 4; ++m) { const int row = row0 + ai * 128 + m * 16;
#pragma unroll
                for (int bj = 0; bj < 2; ++bj) { float* o = O + (size_t)row * ldc + col0 + bj * 128;
                    *(pg8::f32x4*)o = acc[ai][bj][m][0]; *(pg8::f32x4*)(o + 4) = acc[ai][bj][m][1]; } }
    }
};

struct EpiAct {
    static constexpr bool PERM = true, AFTER_DRAIN = false;
    bf16* ACT; float* tailg; float* headg; float* headv; const float* cw; const float* cb;
    __device__ __forceinline__ void operator()(const pg8::f32x4 (&acc)[2][2][4][2], const pg8::Unit& u, int wr, int wc, int fr, int fq) const {
        const int j0 = u.pn * 128 + wc * 32 + 8 * fq;
        float w0[8], w1[8], w2[8], bb[8];
#pragma unroll
        for (int h = 0; h < 2; ++h) { const f32x4 a = *(const f32x4*)(cw + j0 + 4 * h), b = *(const f32x4*)(cw + DFF + j0 + 4 * h), c = *(const f32x4*)(cw + 2 * DFF + j0 + 4 * h), d = *(const f32x4*)(cb + j0 + 4 * h);
#pragma unroll
            for (int e = 0; e < 4; ++e) { w0[4 * h + e] = a[e]; w1[4 * h + e] = b[e]; w2[4 * h + e] = c[e]; bb[4 * h + e] = d[e]; } }
#pragma unroll
        for (int ai = 0; ai < 2; ++ai) {
            const int rbase = u.pm * 256 + ai * 128 + wr * 64; const int rb = rbase >> 6;
#pragma unroll
            for (int m = 0; m < 4; ++m) {
                const int row = rbase + 16 * m + fr;
                float o[8];
#pragma unroll
                for (int e = 0; e < 8; ++e) {
                    const float g = acc[ai][0][m][e >> 2][e & 3], v = acc[ai][1][m][e >> 2][e & 3];
                    const float gp = (m > 0) ? acc[ai][0][m > 0 ? m - 1 : 0][e >> 2][e & 3] : 0.f;
                    const float p1 = dppf<0x121>(g), p2 = dppf<0x122>(g), q1 = dppf<0x121>(gp), q2 = dppf<0x122>(gp);
                    const float g1 = fr >= 1 ? p1 : q1, g2 = fr >= 2 ? p2 : q2;
                    const float y = bb[e] + w0[e] * g2 + w1[e] * g1 + w2[e] * g;
                    o[e] = siluf_(y) * v;
                }
                if (m > 0 || fr >= 2) { v4u w; w.x = cvtpk(o[0], o[1]); w.y = cvtpk(o[2], o[3]); w.z = cvtpk(o[4], o[5]); w.w = cvtpk(o[6], o[7]); *(GAS v4u*)(ACT + (size_t)row * DFF + j0) = w; }
                if (m == 0 && fr < 2) { float* hg = headg + (size_t)(rb * 2 + fr) * DFF + j0; float* hv = headv + (size_t)(rb * 2 + fr) * DFF + j0;
                    *(pg8::f32x4*)hg = acc[ai][0][0][0]; *(pg8::f32x4*)(hg + 4) = acc[ai][0][0][1]; *(pg8::f32x4*)hv = acc[ai][1][0][0]; *(pg8::f32x4*)(hv + 4) = acc[ai][1][0][1]; }
                if (m == 3 && fr >= 14) { float* tg = tailg + (size_t)(rb * 2 + (fr - 14)) * DFF + j0; *(pg8::f32x4*)tg = acc[ai][0][3][0]; *(pg8::f32x4*)(tg + 4) = acc[ai][0][3][1]; }
            }
        }
    }
};

template <int MODE>
__device__ __forceinline__ void sample_gemm_unit(Ctx& C, const bf16* A  , const bf16* Bt  , int K, int n0, int layer) {
    const int lane = C.lane, m = lane & 31, kh = lane >> 5, wave = C.wave;
    const int kw = K >> 3;
    const bf16* a0 = A + (size_t)m * K + wave * kw + 8 * kh; const bf16* a1 = a0 + (size_t)32 * K;
    const bf16* b0 = Bt + (size_t)(n0 + m) * K + wave * kw + 8 * kh;
    f32x16 acc0, acc1;
#pragma unroll
    for (int r = 0; r < 16; ++r) { acc0[r] = 0.f; acc1[r] = 0.f; }
#pragma unroll 1
    for (int k = 0; k < kw; k += 256) {
        bf16x8 fa0[16], fa1[16], fb[16];
#pragma unroll
        for (int s = 0; s < 16; ++s) { const bool ok = k + 16 * s < kw; const int ko = ok ? k + 16 * s : 0;
            fa0[s] = *(const bf16x8*)(a0 + ko); fa1[s] = *(const bf16x8*)(a1 + ko); fb[s] = *(const bf16x8*)(b0 + ko);
            if (!ok) { fb[s] = (bf16x8){0, 0, 0, 0, 0, 0, 0, 0}; } }
#pragma unroll
        for (int s = 0; s < 16; ++s) { acc0 = __builtin_amdgcn_mfma_f32_32x32x16_bf16(fa0[s], fb[s], acc0, 0, 0, 0); acc1 = __builtin_amdgcn_mfma_f32_32x32x16_bf16(fa1[s], fb[s], acc1, 0, 0, 0); }
    }
    LAS float* red = (LAS float*)C.lds;
#pragma unroll
    for (int r = 0; r < 16; ++r) { red[(wave * 64 + crow(r, kh)) * 32 + m] = acc0[r]; red[(wave * 64 + 32 + crow(r, kh)) * 32 + m] = acc1[r]; }
    __syncthreads();
    const int row = C.tid >> 3, c4 = (C.tid & 7) * 4;
    f32x4 v = {0.f, 0.f, 0.f, 0.f};
#pragma unroll
    for (int w = 0; w < 8; ++w) { const f32x4 t = *(const LAS f32x4*)(red + (w * 64 + row) * 32 + c4); v += t; }
    const int n = n0 + c4; const int grow = MP + row;
    if (MODE == 0) {
        if (n >= C_Q && n < C_K) v *= QSCALE;
        v2u o; o.x = cvtpk(v.x, v.y); o.y = cvtpk(v.z, v.w);
        *(GAS v2u*)(WSP(bf16, WS_PROJ) + (size_t)grow * PP + n) = o;
        if (n >= C_K && n < C_GQ) { const bool isv = n >= C_V; float* op = OUTB + (isv ? O_VS : O_KS) + (size_t)layer * 32768 + (size_t)row * 512 + (n - (isv ? C_V : C_K)); *(f32x4*)op = v; }
    } else if (MODE == 1) {
        v2u o; o.x = cvtpk(v.x, v.y); o.y = cvtpk(v.z, v.w);
        *(GAS v2u*)(WSP(bf16, WS_MIXO) + (size_t)grow * DM + n) = o;
    } else {
        v2u o; o.x = cvtpk(v.x, v.y); o.y = cvtpk(v.z, v.w);
        *(GAS v2u*)(WSP(bf16, WS_GV) + (size_t)grow * DUP + n) = o;
    }
    __syncthreads();
}

__device__ __forceinline__ void lru_unit(Ctx& C, int l, int u) {
    KA_FRESH(C);
    int seq, t0, nt, T;
    if (u < 256) { seq = u >> 6; t0 = (u & 63) * 32; nt = 32; T = 2048; } else { seq = 4 + (u - 256); t0 = 0; nt = 8; T = 8; }
    const int d = C.tid, n = C.wave, dd = d & 63;
    const int row0 = seq_row0(seq);
    const bf16* P = WSP(bf16, WS_PROJ);
    LAS float* xs = (LAS float*)C.lds;
    const float cw0 = C.in(19)[(l * 4 + 0) * 512 + d], cw1 = C.in(19)[(l * 4 + 1) * 512 + d], cw2 = C.in(19)[(l * 4 + 2) * 512 + d], cw3 = C.in(19)[(l * 4 + 3) * 512 + d];
    const float cb = C.in(20)[l * 512 + d];
    float xm3, xm2, xm1;
    {
        float pre[3];
#pragma unroll
        for (int i = 0; i < 3; ++i) { const int tt = t0 - 3 + i;
            if (tt >= 0) pre[i] = bf2f(P[(size_t)(row0 + tt) * PP + C_AX + d]);
            else if (seq >= 4) pre[i] = C.in(7)[((size_t)(l * 8 + (seq - 4)) * 3 + (tt + 3)) * 512 + d];
            else pre[i] = 0.f; }
        xm3 = pre[0]; xm2 = pre[1]; xm1 = pre[2];
    }
    {
        float xv[32];
#pragma unroll
        for (int t = 0; t < 32; ++t) xv[t] = (t < nt) ? bf2f(P[(size_t)(row0 + t0 + t) * PP + C_AX + d]) : 0.f;
#pragma unroll
        for (int t = 0; t < 32; ++t) if (t < nt) {
            const float xt = xv[t];
            xs[t * 512 + d] = cb + cw0 * xm3 + cw1 * xm2 + cw2 * xm1 + cw3 * xt;
            xm3 = xm2; xm2 = xm1; xm1 = xt;
        }
    }
    if (t0 + nt == T) {
        float* o = (seq < 4) ? OUTB + O_LCP + (size_t)(l * 4 + seq) * 3 * 512 : OUTB + O_LCS + (size_t)(l * 8 + (seq - 4)) * 3 * 512;
        o[0 * 512 + d] = xm3; o[1 * 512 + d] = xm2; o[2 * 512 + d] = xm1;
    }
    const float br = C.in(22)[l * 512 + d], bi = C.in(24)[l * 512 + d];
    const float lam = C.in(25)[l * 512 + d];
    float L8L2 = -8.0f * softplusf_(-lam) * LOG2E;
    asm volatile("" : "+v"(L8L2) :: "memory");
    typedef float f2v __attribute__((ext_vector_type(2)));
    f2v wri[64];
    {
        const float* pr = C.in(21) + ((size_t)(l * 8 + n) * 64) * 64 + dd;
        const float* pi = C.in(23) + ((size_t)(l * 8 + n) * 64) * 64 + dd;
#pragma unroll
        for (int c = 0; c < 64; ++c) { wri[c].x = pr[c * 64]; wri[c].y = pi[c * 64]; }
    }
    __syncthreads();
    float h = 0.f, ap = 1.f;
    float* HL = WSP(float, WS_LH); float* AL = WSP(float, WS_LA);
    for (int t = 0; t < nt; ++t) {
        f2v a0 = {br, bi}, a1 = {0.f, 0.f};
        const LAS f32x4* xv = (const LAS f32x4*)(xs + t * 512 + n * 64);
#pragma unroll
        for (int c4 = 0; c4 < 16; ++c4) { const f32x4 v = xv[c4];
            a0 = __builtin_elementwise_fma((f2v){v.x, v.x}, wri[4 * c4], a0); a1 = __builtin_elementwise_fma((f2v){v.y, v.y}, wri[4 * c4 + 1], a1);
            a0 = __builtin_elementwise_fma((f2v){v.z, v.z}, wri[4 * c4 + 2], a0); a1 = __builtin_elementwise_fma((f2v){v.w, v.w}, wri[4 * c4 + 3], a1); }
        const float ar = a0.x + a1.x, ai = a0.y + a1.y;
        const float xc = xs[t * 512 + d];
        const float r = __builtin_amdgcn_rcpf(1.0f + __builtin_amdgcn_exp2f(-LOG2E * ar)), ig = __builtin_amdgcn_rcpf(1.0f + __builtin_amdgcn_exp2f(-LOG2E * ai));
        const float a = __builtin_amdgcn_exp2f(r * L8L2);
        const float uu = __builtin_amdgcn_sqrtf(fmaxf(1.0f - a * a, 0.f)) * (ig * xc);
        h = a * h + uu; ap *= a;
        const size_t off = (size_t)(row0 + t0 + t) * 512 + d;
        HL[off] = h; AL[off] = ap;
    }
    __syncthreads();
}

constexpr int GH_Q = 0, GH_K = 18224, GH_V = 36448, GH_L = 54672, GH_S = 72080, GH_BYTES = 73104;
static_assert(2 * GH_BYTES <= LDS_MISC, "gdn prep LDS");

__device__ __forceinline__ void gdn_prep_unit(Ctx& C, int l, int u) {
    KA_FRESH(C);
    int seq, chunk, hp, T;
    if (u < 512) { seq = u >> 7; chunk = (u >> 2) & 31; hp = u & 3; T = 2048; } else { const int v = u - 512; seq = 4 + (v >> 2); chunk = 0; hp = v & 3; T = 8; }
    const int hb = C.tid >> 8, ht = C.tid & 255, lane = C.lane;
    const int head = 2 * hp + hb;
    const int cid = (seq < 4) ? ((seq * 8 + head) * 32 + chunk) : (1024 + (seq - 4) * 8 + head);
    const int srow0 = seq_row0(seq);
    const int row0 = srow0 + chunk * 64;
    const int nvalid = (T - chunk * 64) < 64 ? (T - chunk * 64) : 64;
    const bf16* P = WSP(bf16, WS_PROJ);
    LAS unsigned char* hl = C.lds + hb * GH_BYTES;
    LAS bf16* Kimg = (LAS bf16*)(hl + GH_K); LAS bf16* Qimg = (LAS bf16*)(hl + GH_Q); LAS bf16* Vimg = (LAS bf16*)(hl + GH_V);
    LAS float* Lm = (LAS float*)(hl + GH_L);
    LAS float* s_gc = (LAS float*)(hl + GH_S); LAS float* s_beta = s_gc + 64; LAS float* s_eg = s_gc + 128;
    if (ht < 64) {
        const int t = ht; const bool valid = t < nvalid;
        float beta = 0.f, g = 0.f;
        if (valid) { const float cbv = bf2f(P[(size_t)(row0 + t) * PP + C_B + head]), cav = bf2f(P[(size_t)(row0 + t) * PP + C_A + head]);
            beta = sigmoidf_(cbv); g = -__expf(C.in(30)[l * 8 + head]) * softplusf_(cav + C.in(31)[l * 8 + head]); }
#pragma unroll
        for (int off = 1; off < 64; off <<= 1) { const float v = __shfl_up(g, off); if (lane >= off) g += v; }
        s_gc[t] = g; s_beta[t] = beta; s_eg[t] = __expf(g);
    }
    __syncthreads();
    const float gl = s_gc[63];
    {
        LAS float* wgt = (LAS float*)(hl + GH_L);
        {
            v4u xs[13];
#pragma unroll
            for (int i = 0; i < 13; ++i) {
                const int idx = ht + 256 * i; const int r = idx / 48, chn = idx % 48, part = chn >> 4, col = (chn & 15) * 8;
                const int tt = chunk * 64 - 3 + r;
                v4u x = {0u, 0u, 0u, 0u};
                if (idx < 67 * 48) {
                    if (tt >= 0) x = *(const v4u*)(P + (size_t)(srow0 + tt) * PP + C_GQ + part * 1024 + head * 128 + col);
                    else if (seq >= 4) { const float* bp = C.in(9) + ((size_t)(l * 8 + (seq - 4)) * 3 + (tt + 3)) * 3072 + part * 1024 + head * 128 + col;
                        x.x = cvtpk(bp[0], bp[1]); x.y = cvtpk(bp[2], bp[3]); x.z = cvtpk(bp[4], bp[5]); x.w = cvtpk(bp[6], bp[7]); }
                }
                xs[i] = x;
            }
#pragma unroll
            for (int i = 0; i < 13; ++i) {
                const int idx = ht + 256 * i; const int r = idx / 48, chn = idx % 48, part = chn >> 4, col = (chn & 15) * 8;
                if (idx < 67 * 48) *(LAS v4u*)((LAS bf16*)(hl + part * 18224) + r * 136 + col) = xs[i];
            }
        }
        for (int e = ht; e < 4 * 384; e += 256) { const int i = e / 384, cc = e % 384; wgt[e] = C.in(29)[(size_t)(l * 4 + i) * 3072 + (cc >> 7) * 1024 + head * 128 + (cc & 127)]; }
        __syncthreads();
        const int t = ht >> 2, cgp = ht & 3; const bool valid = t < nvalid;
#pragma unroll 1
        for (int part = 0; part < 3; ++part) {
            LAS bf16* reg = (LAS bf16*)(hl + part * 18224);
            float acc[32];
#pragma unroll
            for (int c = 0; c < 32; ++c) acc[c] = 0.f;
#pragma unroll
            for (int i = 0; i < 4; ++i) {
                const LAS v4u* rp = (const LAS v4u*)(reg + (t + i) * 136 + cgp * 32);
                const LAS f32x4* wp = (const LAS f32x4*)(wgt + i * 384 + part * 128 + cgp * 32);
#pragma unroll
                for (int q4 = 0; q4 < 4; ++q4) { const v4u x = rp[q4]; const f32x4 w0 = wp[2 * q4], w1 = wp[2 * q4 + 1];
                    acc[8 * q4 + 0] += w0.x * bflo(x.x); acc[8 * q4 + 1] += w0.y * bfhi(x.x); acc[8 * q4 + 2] += w0.z * bflo(x.y); acc[8 * q4 + 3] += w0.w * bfhi(x.y);
                    acc[8 * q4 + 4] += w1.x * bflo(x.z); acc[8 * q4 + 5] += w1.y * bfhi(x.z); acc[8 * q4 + 6] += w1.z * bflo(x.w); acc[8 * q4 + 7] += w1.w * bfhi(x.w); }
            }
            float ss = 0.f;
#pragma unroll
            for (int c = 0; c < 32; ++c) { const float v = valid ? siluf_(acc[c]) : 0.f; acc[c] = v; ss += v * v; }
            float scl = 1.f;
            if (part < 2) { ss += __shfl_xor(ss, 1); ss += __shfl_xor(ss, 2); scl = rsqrtf(ss + EPS); if (part == 0) scl *= 0.08838834764831845f; }
            v4u outp[4];
#pragma unroll
            for (int q4 = 0; q4 < 4; ++q4) {
                outp[q4].x = cvtpk(acc[8 * q4 + 0] * scl, acc[8 * q4 + 1] * scl); outp[q4].y = cvtpk(acc[8 * q4 + 2] * scl, acc[8 * q4 + 3] * scl);
                outp[q4].z = cvtpk(acc[8 * q4 + 4] * scl, acc[8 * q4 + 5] * scl); outp[q4].w = cvtpk(acc[8 * q4 + 6] * scl, acc[8 * q4 + 7] * scl); }
            __syncthreads();
#pragma unroll
            for (int q4 = 0; q4 < 4; ++q4) *(LAS v4u*)(reg + t * 136 + cgp * 32 + 8 * q4) = outp[q4];
        }
        if (chunk * 64 + 64 >= T) {
            float* o = (seq < 4) ? OUTB + O_GCP + (size_t)(l * 4 + seq) * 3 * 3072 : OUTB + O_GCS + (size_t)(l * 8 + (seq - 4)) * 3 * 3072;
            for (int e = ht; e < 3 * 384; e += 256) { const int i = e / 384, cc = e % 384, part = cc >> 7, c = cc & 127; const int col = part * 1024 + head * 128 + c;
                o[i * 3072 + col] = bf2f(P[(size_t)(srow0 + T - 3 + i) * PP + C_GQ + col]); }
        }
    }
    __syncthreads();
    {
        v4u* QEf = WSP(v4u, WS_QEF) + (size_t)cid * 1024; v4u* KDf = WSP(v4u, WS_KDF) + (size_t)cid * 1024;
#pragma unroll 1
        for (int f = 0; f < 4; ++f) {
            const int task = ht + 256 * f, frag = task >> 6, ln = task & 63, h = ln >> 5;
            {
                const int ti = frag >> 3, ks = frag & 7, tok = 32 * ti + (ln & 31), dkb = 32 * (ks >> 1) + 16 * (ks & 1) + 4 * h;
                const float sc = s_eg[tok];
                const v2u a = *(const LAS v2u*)(Qimg + tok * 136 + dkb), b = *(const LAS v2u*)(Qimg + tok * 136 + dkb + 8);
                v4u o; o.x = cvtpk(bflo(a.x) * sc, bfhi(a.x) * sc); o.y = cvtpk(bflo(a.y) * sc, bfhi(a.y) * sc); o.z = cvtpk(bflo(b.x) * sc, bfhi(b.x) * sc); o.w = cvtpk(bflo(b.y) * sc, bfhi(b.y) * sc);
                QEf[frag * 64 + ln] = o;
            }
            {
                const int dt = frag >> 2, ks2 = frag & 3, dk = 32 * dt + (ln & 31), tb = 32 * (ks2 >> 1) + 16 * (ks2 & 1) + 4 * h;
                float v[8];
#pragma unroll
                for (int j = 0; j < 8; ++j) { const int tok = tb + 8 * (j >> 2) + (j & 3); v[j] = bf2f(Kimg[tok * 136 + dk]) * __expf(gl - s_gc[tok]); }
                v4u o; o.x = cvtpk(v[0], v[1]); o.y = cvtpk(v[2], v[3]); o.z = cvtpk(v[4], v[5]); o.w = cvtpk(v[6], v[7]);
                KDf[frag * 64 + ln] = o;
            }
        }
    }
    {
        const int wv = ht >> 6, tj = wv >> 1, ti = wv & 1, m = lane & 31, kh = lane >> 5;
        f32x16 akk, aqk;
#pragma unroll
        for (int r = 0; r < 16; ++r) { akk[r] = 0.f; aqk[r] = 0.f; }
#pragma unroll
        for (int ks = 0; ks < 8; ++ks) {
            const bf16x8 a = *(const LAS bf16x8*)(Kimg + (32 * tj + m) * 136 + 16 * ks + 8 * kh);
            const bf16x8 bk = *(const LAS bf16x8*)(Kimg + (32 * ti + m) * 136 + 16 * ks + 8 * kh);
            const bf16x8 bq = *(const LAS bf16x8*)(Qimg + (32 * ti + m) * 136 + 16 * ks + 8 * kh);
            akk = __builtin_amdgcn_mfma_f32_32x32x16_bf16(a, bk, akk, 0, 0, 0);
            aqk = __builtin_amdgcn_mfma_f32_32x32x16_bf16(a, bq, aqk, 0, 0, 0);
        }
        const int i = 32 * ti + m; const float gci = s_gc[i], bi = s_beta[i];
        float lv[16], qv[16];
#pragma unroll
        for (int r = 0; r < 16; ++r) { const int j = 32 * tj + crow(r, kh); const float dec = __expf(fminf(gci - s_gc[j], 0.f));
            lv[r] = (i > j) ? bi * akk[r] * dec : 0.f; qv[r] = (i >= j) ? aqk[r] * dec : 0.f; }
#pragma unroll
        for (int rq = 0; rq < 4; ++rq) { f32x4 o; o.x = lv[4 * rq]; o.y = lv[4 * rq + 1]; o.z = lv[4 * rq + 2]; o.w = lv[4 * rq + 3];
            *(LAS f32x4*)(Lm + i * 68 + 32 * tj + 8 * rq + 4 * kh) = o; }
        v4u* QKf = WSP(v4u, WS_QKF) + (size_t)cid * 512;
#pragma unroll
        for (int s = 0; s < 2; ++s) { v4u o; o.x = cvtpk(qv[8 * s + 0], qv[8 * s + 1]); o.y = cvtpk(qv[8 * s + 2], qv[8 * s + 3]); o.z = cvtpk(qv[8 * s + 4], qv[8 * s + 5]); o.w = cvtpk(qv[8 * s + 6], qv[8 * s + 7]);
            QKf[(ti * 4 + 2 * tj + s) * 64 + lane] = o; }
    }
    __syncthreads();
    {
        const int c = ht;
        float sol[64];
#pragma unroll 1
        for (int r12 = 0; r12 < REPN(12); ++r12) {
        if (c < 128) {
#pragma unroll
            for (int i = 0; i < 64; ++i) sol[i] = bf2f(Vimg[i * 136 + c]) * s_beta[i];
        } else {
#pragma unroll
            for (int i = 0; i < 64; ++i) sol[i] = bf2f(Kimg[i * 136 + (c - 128)]) * (s_beta[i] * s_eg[i]);
        }
#pragma unroll
        for (int i = 1; i < 64; ++i) {
            float s = sol[i];
#pragma unroll
            for (int j4 = 0; j4 <= ((i - 1) >> 2); ++j4) { const f32x4 Lv = *(const LAS f32x4*)(Lm + i * 68 + 4 * j4);
                s -= Lv.x * sol[4 * j4]; if (4 * j4 + 1 < i) s -= Lv.y * sol[4 * j4 + 1]; if (4 * j4 + 2 < i) s -= Lv.z * sol[4 * j4 + 2]; if (4 * j4 + 3 < i) s -= Lv.w * sol[4 * j4 + 3]; }
            sol[i] = s;
        }
        }
        __syncthreads();
        if (c < 128) {
            const int ds = c >> 5, col = c & 31;
            bf16* Uf = WSP(bf16, WS_UF) + (size_t)cid * 8192;
#pragma unroll
            for (int a = 0; a < 8; ++a)
#pragma unroll
                for (int hi = 0; hi < 2; ++hi) { const int ti = a >> 2; v2u o; o.x = cvtpk(sol[8 * a + 4 * hi], sol[8 * a + 4 * hi + 1]); o.y = cvtpk(sol[8 * a + 4 * hi + 2], sol[8 * a + 4 * hi + 3]);
                    *(GAS v2u*)(Uf + ((size_t)((ds * 2 + ti) * 64 + col + 32 * hi)) * 16 + 4 * (a & 3)) = o; }
        } else {
            const int dk = c - 128;
#pragma unroll
            for (int i = 0; i < 64; ++i) Qimg[i * 136 + dk] = f2bf(-sol[i]);
        }
        if (ht == 0) WSP(float, WS_GL)[cid] = __expf(gl);
    }
    __syncthreads();
    {
        v4u* Wf = WSP(v4u, WS_WF) + (size_t)cid * 1024;
#pragma unroll 1
        for (int f = 0; f < 4; ++f) {
            const int task = ht + 256 * f, frag = task >> 6, ln = task & 63, h = ln >> 5;
            const int ti = frag >> 3, ks = frag & 7, tok = 32 * ti + (ln & 31), dkb = 32 * (ks >> 1) + 16 * (ks & 1) + 4 * h;
            const v2u a = *(const LAS v2u*)(Qimg + tok * 136 + dkb), b = *(const LAS v2u*)(Qimg + tok * 136 + dkb + 8);
            v4u o; o.x = a.x; o.y = a.y; o.z = b.x; o.w = b.y;
            Wf[frag * 64 + ln] = o;
        }
    }
    __syncthreads();
}

__device__ __forceinline__ void phase_act(Ctx& C, int l) {
    KA_FRESH(C);
    const bf16* GV = WSP(bf16, WS_GV); bf16* ACT = WSP(bf16, WS_ACT);
    const long gt = (long)C.bid * NTHR + C.tid, NGT = (long)C.G * NTHR;
    const float* cw = C.in(35) + (size_t)l * 3 * DFF; const float* cb = C.in(36) + (size_t)l * DFF;
    for (long it = gt; it < (long)MS * 704; it += NGT) {
        const int row = MP + (int)(it / 704), grp = (int)(it % 704);
        const int j0 = grp * 8; const int gcol = (j0 >> 7) * 256 + (j0 & 127);
        const int s = row_seq(row); const int t = row - seq_row0(s); const int T = 8;
        float x[3][8];
#pragma unroll
        for (int i = 0; i < 3; ++i) {
            const int tt = t - 2 + i;
            if (tt >= 0) { const v4u g = *(const v4u*)(GV + (size_t)(row - 2 + i) * DUP + gcol);
                x[i][0] = bflo(g.x); x[i][1] = bfhi(g.x); x[i][2] = bflo(g.y); x[i][3] = bfhi(g.y); x[i][4] = bflo(g.z); x[i][5] = bfhi(g.z); x[i][6] = bflo(g.w); x[i][7] = bfhi(g.w);
            } else { const float* bp = C.in(11) + ((size_t)(l * 8 + (s - 4)) * 2 + (tt + 2)) * DFF + j0;
#pragma unroll
                for (int e = 0; e < 8; ++e) x[i][e] = bp[e]; }
        }
        const v4u vv = *(const v4u*)(GV + (size_t)row * DUP + gcol + 128);
        const float val[8] = {bflo(vv.x), bfhi(vv.x), bflo(vv.y), bfhi(vv.y), bflo(vv.z), bfhi(vv.z), bflo(vv.w), bfhi(vv.w)};
        float o[8];
#pragma unroll
        for (int e = 0; e < 8; ++e) { const float y = cb[j0 + e] + cw[0 * DFF + j0 + e] * x[0][e] + cw[1 * DFF + j0 + e] * x[1][e] + cw[2 * DFF + j0 + e] * x[2][e]; o[e] = siluf_(y) * val[e]; }
        v4u w; w.x = cvtpk(o[0], o[1]); w.y = cvtpk(o[2], o[3]); w.z = cvtpk(o[4], o[5]); w.w = cvtpk(o[6], o[7]);
        *(GAS v4u*)(ACT + (size_t)row * DFF + j0) = w;
        if (t >= T - 2) {
            float* fo = OUTB + O_FCS + ((size_t)(l * 8 + (s - 4)) * 2 + (t - (T - 2))) * DFF + j0;
#pragma unroll
            for (int e = 0; e < 8; ++e) fo[e] = x[2][e];
        }
    }
    const float* TG = WSP(float, WS_TAILG); const float* HG = WSP(float, WS_HEADG); const float* HV = WSP(float, WS_HEADV);
    for (long it = gt; it < (long)256 * 704; it += NGT) {
        const int rr = (int)(it / 704), grp = (int)(it % 704), rb = rr >> 1, i = rr & 1, j0 = grp * 8;
        const bool first = (rb & 31) == 0;
        float g2[8], g1[8], g0[8], vv[8];
#pragma unroll
        for (int e = 0; e < 8; ++e) {
            const float t0 = first ? 0.f : TG[(size_t)((rb - 1) * 2 + 0) * DFF + j0 + e], t1 = first ? 0.f : TG[(size_t)((rb - 1) * 2 + 1) * DFF + j0 + e];
            const float h0 = HG[(size_t)(rb * 2 + 0) * DFF + j0 + e], h1 = HG[(size_t)(rb * 2 + 1) * DFF + j0 + e];
            g2[e] = i == 0 ? t0 : t1; g1[e] = i == 0 ? t1 : h0; g0[e] = i == 0 ? h0 : h1; vv[e] = HV[(size_t)(rb * 2 + i) * DFF + j0 + e];
        }
        float o[8];
#pragma unroll
        for (int e = 0; e < 8; ++e) { const float y = cb[j0 + e] + cw[0 * DFF + j0 + e] * g2[e] + cw[1 * DFF + j0 + e] * g1[e] + cw[2 * DFF + j0 + e] * g0[e]; o[e] = siluf_(y) * vv[e]; }
        v4u w; w.x = cvtpk(o[0], o[1]); w.y = cvtpk(o[2], o[3]); w.z = cvtpk(o[4], o[5]); w.w = cvtpk(o[6], o[7]);
        *(GAS v4u*)(ACT + (size_t)(rb * 64 + i) * DFF + j0) = w;
        if ((rb & 31) == 31) {
            float* fo = OUTB + O_FCP + ((size_t)(l * 4 + (rb >> 5)) * 2 + i) * DFF + j0;
#pragma unroll
            for (int e = 0; e < 8; ++e) fo[e] = TG[(size_t)(rb * 2 + i) * DFF + j0 + e];
        }
    }
}

struct FinIn { f32x4 hl[2], al[2]; v4u ag, oatt, og[2], z[2]; };
__device__ __forceinline__ void fin_load(Ctx& C, int row, FinIn& in, int lane) {
    const bf16* P = WSP(bf16, WS_PROJ);
    const float* hl = WSP(float, WS_LH) + (size_t)row * 512 + 8 * lane; const float* al = WSP(float, WS_LA) + (size_t)row * 512 + 8 * lane;
    in.hl[0] = *(const f32x4*)hl; in.hl[1] = *(const f32x4*)(hl + 4); in.al[0] = *(const f32x4*)al; in.al[1] = *(const f32x4*)(al + 4);
    in.ag = *(const v4u*)(P + (size_t)row * PP + C_AG + 8 * lane);
    in.oatt = (row < MP) ? *(const v4u*)(WSP(bf16, WS_OATT) + (size_t)row * 512 + 8 * lane) : (v4u){0u, 0u, 0u, 0u};
    const v4u* op = (const v4u*)(WSP(bf16, WS_OGDN) + (size_t)row * 1024 + 16 * lane); in.og[0] = op[0]; in.og[1] = op[1];
    const v4u* zp = (const v4u*)(P + (size_t)row * PP + C_Z + 16 * lane); in.z[0] = zp[0]; in.z[1] = zp[1];
}
__device__ __forceinline__ void phase_finalize(Ctx& C, int l) {
    KA_FRESH(C);
    const int gw = C.bid * NWAVES + C.wave, NGW = C.G * NWAVES, lane = C.lane;
    bf16* MIX = WSP(bf16, WS_MIX);
    float ga[8], gb[8], gc[16];
    {
        const float* pa = C.in(26) + l * 512 + 8 * lane; const float* pb = C.in(27) + l * 512 + 8 * lane; const float* pc = C.in(32) + l * 128 + ((16 * lane) & 127);
#pragma unroll
        for (int e = 0; e < 8; ++e) { ga[e] = pa[e]; gb[e] = pb[e]; }
#pragma unroll
        for (int e = 0; e < 16; ++e) gc[e] = pc[e];
    }
    FinIn in;
    if (gw < MR) fin_load(C, gw, in, lane);
    for (int row = gw; row < MR; row += NGW) {
        const int s = row_seq(row); const int t = row - seq_row0(s);
        const int chunk = t >> 5;
        const float* cr = WSP(float, WS_CARRY) + (size_t)(s * 64 + chunk) * 512 + 8 * lane;
        const f32x4 c0v = *(const f32x4*)cr, c1v = *(const f32x4*)(cr + 4);
        float y[8], o[8], og[16], zz[16];
        {
            const float hv[8] = {in.hl[0].x, in.hl[0].y, in.hl[0].z, in.hl[0].w, in.hl[1].x, in.hl[1].y, in.hl[1].z, in.hl[1].w};
            const float av[8] = {in.al[0].x, in.al[0].y, in.al[0].z, in.al[0].w, in.al[1].x, in.al[1].y, in.al[1].z, in.al[1].w};
            const float cv[8] = {c0v.x, c0v.y, c0v.z, c0v.w, c1v.x, c1v.y, c1v.z, c1v.w};
            const float gv[8] = {bflo(in.ag.x), bfhi(in.ag.x), bflo(in.ag.y), bfhi(in.ag.y), bflo(in.ag.z), bfhi(in.ag.z), bflo(in.ag.w), bfhi(in.ag.w)};
#pragma unroll
            for (int e = 0; e < 8; ++e) { const float h = hv[e] + av[e] * cv[e]; y[e] = h * gelu_tanh(gv[e]); }
            o[0] = bflo(in.oatt.x); o[1] = bfhi(in.oatt.x); o[2] = bflo(in.oatt.y); o[3] = bfhi(in.oatt.y); o[4] = bflo(in.oatt.z); o[5] = bfhi(in.oatt.z); o[6] = bflo(in.oatt.w); o[7] = bfhi(in.oatt.w);
#pragma unroll
            for (int h2 = 0; h2 < 2; ++h2) { const v4u a = in.og[h2], b = in.z[h2];
                og[8 * h2 + 0] = bflo(a.x); og[8 * h2 + 1] = bfhi(a.x); og[8 * h2 + 2] = bflo(a.y); og[8 * h2 + 3] = bfhi(a.y); og[8 * h2 + 4] = bflo(a.z); og[8 * h2 + 5] = bfhi(a.z); og[8 * h2 + 6] = bflo(a.w); og[8 * h2 + 7] = bfhi(a.w);
                zz[8 * h2 + 0] = bflo(b.x); zz[8 * h2 + 1] = bfhi(b.x); zz[8 * h2 + 2] = bflo(b.y); zz[8 * h2 + 3] = bfhi(b.y); zz[8 * h2 + 4] = bflo(b.z); zz[8 * h2 + 5] = bfhi(b.z); zz[8 * h2 + 6] = bflo(b.w); zz[8 * h2 + 7] = bfhi(b.w); }
        }
        asm volatile("" ::: "memory");
        const int nrow = row + NGW;
        if (nrow < MR) fin_load(C, nrow, in, lane);
        {
            float ss = 0.f;
#pragma unroll
            for (int e = 0; e < 8; ++e) ss += y[e] * y[e];
            const float rs = rsqrtf(wave_sum(ss) * (1.f / 512.f) + EPS);
            v4u w; w.x = cvtpk(y[0] * rs * ga[0], y[1] * rs * ga[1]); w.y = cvtpk(y[2] * rs * ga[2], y[3] * rs * ga[3]); w.z = cvtpk(y[4] * rs * ga[4], y[5] * rs * ga[5]); w.w = cvtpk(y[6] * rs * ga[6], y[7] * rs * ga[7]);
            *(GAS v4u*)(MIX + (size_t)row * DM + 8 * lane) = w;
        }
        {
            if (row >= MP) {
                const int b = (row - MP) >> 3, q = (row - MP) & 7, head = lane >> 3, dd = 8 * (lane & 7), bh = b * 8 + head;
                const float* spo = WSP(float, WS_SPO); const float* spt = WSP(float, WS_SPT);
                float R = 1.f;
#pragma unroll
                for (int e = 0; e < 8; ++e) o[e] = 0.f;
                const float* tp = spt + (size_t)(bh * 33) * 8 + q; const float* pb = spo + ((size_t)(bh * 33) * 8 + q) * 64 + dd;
#pragma unroll 1
                for (int rb = 22; rb >= 0; rb -= 11) {
                    float t[11]; f32x4 p0[11], p1[11];
#pragma unroll
                    for (int i = 0; i < 11; ++i) { t[i] = tp[(rb + i) * 8]; p0[i] = *(const f32x4*)(pb + (size_t)(rb + i) * 512); p1[i] = *(const f32x4*)(pb + (size_t)(rb + i) * 512 + 4); }
#pragma unroll
                    for (int i = 10; i >= 0; --i) {
                        o[0] += R * p0[i].x; o[1] += R * p0[i].y; o[2] += R * p0[i].z; o[3] += R * p0[i].w; o[4] += R * p1[i].x; o[5] += R * p1[i].y; o[6] += R * p1[i].z; o[7] += R * p1[i].w;
                        R *= t[i];
                    }
                }
            }
            float ss = 0.f;
#pragma unroll
            for (int e = 0; e < 8; ++e) ss += o[e] * o[e];
            const float rs = rsqrtf(wave_sum(ss) * (1.f / 512.f) + EPS);
            v4u w; w.x = cvtpk(o[0] * rs * gb[0], o[1] * rs * gb[1]); w.y = cvtpk(o[2] * rs * gb[2], o[3] * rs * gb[3]); w.z = cvtpk(o[4] * rs * gb[4], o[5] * rs * gb[5]); w.w = cvtpk(o[6] * rs * gb[6], o[7] * rs * gb[7]);
            *(GAS v4u*)(MIX + (size_t)row * DM + 512 + 8 * lane) = w;
        }
        {
            float ss = 0.f;
#pragma unroll
            for (int e = 0; e < 16; ++e) ss += og[e] * og[e];
            ss += __shfl_xor(ss, 1); ss += __shfl_xor(ss, 2); ss += __shfl_xor(ss, 4);
            const float rs = rsqrtf(ss * (1.f / 128.f) + EPS);
            float yc[16];
#pragma unroll
            for (int e = 0; e < 16; ++e) yc[e] = og[e] * rs * gc[e] * siluf_(zz[e]);
            v4u w0, w1; w0.x = cvtpk(yc[0], yc[1]); w0.y = cvtpk(yc[2], yc[3]); w0.z = cvtpk(yc[4], yc[5]); w0.w = cvtpk(yc[6], yc[7]);
            w1.x = cvtpk(yc[8], yc[9]); w1.y = cvtpk(yc[10], yc[11]); w1.z = cvtpk(yc[12], yc[13]); w1.w = cvtpk(yc[14], yc[15]);
            *(GAS v4u*)(MIX + (size_t)row * DM + 1024 + 16 * lane) = w0; *(GAS v4u*)(MIX + (size_t)row * DM + 1024 + 16 * lane + 8) = w1;
        }
    }
}

template <bool MASK>
__device__ __forceinline__ void sb_core(const bf16x8 (&kf)[4], const bf16x8 (&qf)[4], float bias2, int kbase, int qpos, int hi, float& R, v4u (&pw)[2]) {
    f32x16 p;
#pragma unroll
    for (int r = 0; r < 16; ++r) p[r] = bias2;
#pragma unroll
    for (int ks = 0; ks < 4; ++ks) p = __builtin_amdgcn_mfma_f32_32x32x16_bf16(kf[ks], qf[ks], p, 0, 0, 0);
    float w[16];
    float L = 1.f;
#pragma unroll
    for (int r = 0; r < 16; ++r) {
        float e = __builtin_amdgcn_exp2f(__builtin_amdgcn_fmed3f(p[r], -126.f, 7.f));
        if (MASK) { if (kbase + 16 * hi + r >= qpos) e = 0.f; }
        w[r] = e * L; L *= (1.f + e);
    }
    const float Pr = __builtin_amdgcn_rcpf(L);
    const float other = __shfl_xor(Pr, 32);
    const float F = (hi ? R : R * other) * Pr;
    R = R * Pr * other;
#pragma unroll
    for (int s = 0; s < 2; ++s) {
        pw[s].x = cvtpk(w[8 * s + 0] * F, w[8 * s + 1] * F); pw[s].y = cvtpk(w[8 * s + 2] * F, w[8 * s + 3] * F); pw[s].z = cvtpk(w[8 * s + 4] * F, w[8 * s + 5] * F); pw[s].w = cvtpk(w[8 * s + 6] * F, w[8 * s + 7] * F);
    }
}
__device__ __forceinline__ void sb_pv(f32x16 (&o)[2], const v4u (&pw)[2], const bf16x8 (&vf)[2][2]) {
#pragma unroll
    for (int dt = 0; dt < 2; ++dt)
#pragma unroll
        for (int st = 0; st < 2; ++st) o[dt] = __builtin_amdgcn_mfma_f32_32x32x16_bf16(__builtin_bit_cast(bf16x8, pw[st]), vf[dt][st], o[dt], 0, 0, 0);
}
constexpr int VT_PITCH = 72, VT_BYTES = 2 * 32 * VT_PITCH * 2;
struct RawBf { v4u k[4]; v4u v[4]; };
struct RawF32 { f32x4 k[8]; f32x4 v[8]; };
__device__ __forceinline__ void raw_load_bf16(RawBf& t, const bf16* Kb, const bf16* Vb, int pitch, int tile_base, int maxrow, int lane) {
#pragma unroll
    for (int i = 0; i < 4; ++i) { int row = tile_base + 8 * i + (lane >> 3); row = row > maxrow ? maxrow : row;
        t.k[i] = *(const v4u*)(Kb + (size_t)row * pitch + 8 * (lane & 7)); t.v[i] = *(const v4u*)(Vb + (size_t)row * pitch + 8 * (lane & 7)); }
}
__device__ __forceinline__ void raw_load_f32(RawF32& t, const float* Kt, const float* Vt, int lane) {
#pragma unroll
    for (int i = 0; i < 8; ++i) { t.k[i] = *(const f32x4*)(Kt + (size_t)(4 * i + (lane >> 4)) * 512 + 4 * (lane & 15)); t.v[i] = *(const f32x4*)(Vt + (size_t)(4 * i + (lane >> 4)) * 512 + 4 * (lane & 15)); }
}
__device__ __forceinline__ void vfrags_from_lds(const LAS bf16* vt, bf16x8 (&vf)[2][2], int lane) {
    typedef short s16x4v __attribute__((ext_vector_type(4)));
    const int g16 = lane >> 4, q = (lane & 15) >> 2, p = lane & 3, kh = g16 >> 1, cg = g16 & 1;
    const LAS bf16* base = vt + (16 * kh + q) * VT_PITCH + 16 * cg + 4 * p;
#pragma unroll
    for (int st = 0; st < 2; ++st)
#pragma unroll
        for (int dt = 0; dt < 2; ++dt) {
            const s16x4v lo = __builtin_bit_cast(s16x4v, __builtin_amdgcn_ds_read_tr16_b64_v4i16((LAS s16x4v*)(base + (8 * st + 0) * VT_PITCH + 32 * dt)));
            const s16x4v hi = __builtin_bit_cast(s16x4v, __builtin_amdgcn_ds_read_tr16_b64_v4i16((LAS s16x4v*)(base + (8 * st + 4) * VT_PITCH + 32 * dt)));
            vf[dt][st] = (bf16x8){lo[0], lo[1], lo[2], lo[3], hi[0], hi[1], hi[2], hi[3]};
        }
}
__device__ __forceinline__ void kfrags_from_lds(const LAS bf16* kt, bf16x8 (&kf)[4], int lane) {
    const int m = lane & 31, kh = lane >> 5;
    const LAS bf16* kp = kt + (16 * ((m >> 2) & 1) + (m & 3) + 4 * (m >> 3)) * VT_PITCH + 8 * kh;
#pragma unroll
    for (int ks = 0; ks < 4; ++ks) kf[ks] = *(const LAS bf16x8*)(kp + 16 * ks);
}
__device__ __forceinline__ void stage_bf16(const RawBf& t, LAS bf16* vt, bf16x8 (&kf)[4], int lane) {
    LAS bf16* kt = vt + 32 * VT_PITCH;
#pragma unroll
    for (int i = 0; i < 4; ++i) { *(LAS v4u*)(kt + (8 * i + (lane >> 3)) * VT_PITCH + 8 * (lane & 7)) = t.k[i]; *(LAS v4u*)(vt + (8 * i + (lane >> 3)) * VT_PITCH + 8 * (lane & 7)) = t.v[i]; }
    kfrags_from_lds(kt, kf, lane);
}
__device__ __forceinline__ void stage_f32(const RawF32& t, LAS bf16* vt, bf16x8 (&kf)[4], int lane) {
    LAS bf16* kt = vt + 32 * VT_PITCH;
#pragma unroll
    for (int i = 0; i < 8; ++i) { v2u w; w.x = cvtpk(t.k[i].x, t.k[i].y); w.y = cvtpk(t.k[i].z, t.k[i].w); *(LAS v2u*)(kt + (4 * i + (lane >> 4)) * VT_PITCH + 4 * (lane & 15)) = w;
        v2u u; u.x = cvtpk(t.v[i].x, t.v[i].y); u.y = cvtpk(t.v[i].z, t.v[i].w); *(LAS v2u*)(vt + (4 * i + (lane >> 4)) * VT_PITCH + 4 * (lane & 15)) = u; }
    kfrags_from_lds(kt, kf, lane);
}
template <bool MASK>
__device__ __forceinline__ void sb_compute(const bf16x8 (&kf)[4], const LAS bf16* vt, int tile_base, const bf16x8 (&qf)[4], float bias2, int qpos, int lane, float& R, f32x16 (&o)[2]) {
    v4u pw[2];
    sb_core<MASK>(kf, qf, bias2, tile_base, qpos, lane >> 5, R, pw);
    bf16x8 vf[2][2];
    vfrags_from_lds(vt, vf, lane);
    sb_pv(o, pw, vf);
}

constexpr int NATT_S = 64 * 33, NATT = NATT_S + 2048;
constexpr int SG_BYTES = 2 * 64 * VT_PITCH * 2;
struct RawG { f32x4 k[16]; f32x4 v[16]; };
__device__ __forceinline__ void rawg_load(RawG& t, const float* Kt, const float* Vt, int lane) {
#pragma unroll
    for (int i = 0; i < 16; ++i) { t.k[i] = *(const f32x4*)(Kt + (size_t)(4 * i + (lane >> 4)) * 512 + 4 * (lane & 15)); t.v[i] = *(const f32x4*)(Vt + (size_t)(4 * i + (lane >> 4)) * 512 + 4 * (lane & 15)); }
}
__device__ __forceinline__ void rawg_stage(const RawG& t, LAS bf16* vt, int lane) {
    LAS bf16* kt = vt + 64 * VT_PITCH;
#pragma unroll
    for (int i = 0; i < 16; ++i) { v2u w; w.x = cvtpk(t.k[i].x, t.k[i].y); w.y = cvtpk(t.k[i].z, t.k[i].w); *(LAS v2u*)(kt + (4 * i + (lane >> 4)) * VT_PITCH + 4 * (lane & 15)) = w;
        v2u u; u.x = cvtpk(t.v[i].x, t.v[i].y); u.y = cvtpk(t.v[i].z, t.v[i].w); *(LAS v2u*)(vt + (4 * i + (lane >> 4)) * VT_PITCH + 4 * (lane & 15)) = u; }
}
template <bool MASK>
__device__ __forceinline__ void sb16(const LAS bf16* vth, const LAS bf16* kth, const bf16x8 (&qf)[2], float bias2, int kbase, int qpos, int lane, float& R, f32x4 (&o)[4]) {
    typedef short s16x4v __attribute__((ext_vector_type(4)));
    const int i = lane & 15, g = lane >> 4;
    f32x4 p[2];
    {
        bf16x8 kf[2][2];
        const LAS bf16* kp = kth + (8 * (i >> 2) + (i & 3)) * VT_PITCH + 8 * g;
#pragma unroll
        for (int j2 = 0; j2 < 2; ++j2)
#pragma unroll
            for (int ks = 0; ks < 2; ++ks) kf[j2][ks] = *(const LAS bf16x8*)(kp + 4 * j2 * VT_PITCH + 32 * ks);
#pragma unroll
        for (int j2 = 0; j2 < 2; ++j2) { p[j2] = (f32x4){bias2, bias2, bias2, bias2};
#pragma unroll
            for (int ks = 0; ks < 2; ++ks) p[j2] = __builtin_amdgcn_mfma_f32_16x16x32_bf16(kf[j2][ks], qf[ks], p[j2], 0, 0, 0); }
    }
    float w[8]; float L = 1.f;
#pragma unroll
    for (int x = 0; x < 8; ++x) {
        float e = __builtin_amdgcn_exp2f(__builtin_amdgcn_fmed3f(p[x >> 2][x & 3], -126.f, 7.f));
        if (MASK) { if (kbase + 8 * g + x >= qpos) e = 0.f; }
        w[x] = e * L; L *= (1.f + e);
    }
    const float Pr = __builtin_amdgcn_rcpf(L);
    const float a = __shfl_xor(Pr, 16); const float pp = Pr * a; const float b = __shfl_xor(pp, 32);
    const float suf = (g == 3) ? 1.f : (g == 2) ? a : (g == 1) ? b : a * b;
    const float F = R * suf * Pr;
    R = R * pp * b;
    v4u pw; pw.x = cvtpk(w[0] * F, w[1] * F); pw.y = cvtpk(w[2] * F, w[3] * F); pw.z = cvtpk(w[4] * F, w[5] * F); pw.w = cvtpk(w[6] * F, w[7] * F);
    const LAS bf16* vb = vth + (8 * g + ((lane & 15) >> 2)) * VT_PITCH + 4 * (lane & 3);
#pragma unroll
    for (int dt = 0; dt < 4; ++dt) {
        const s16x4v lo = __builtin_bit_cast(s16x4v, __builtin_amdgcn_ds_read_tr16_b64_v4i16((LAS s16x4v*)(vb + 16 * dt)));
        const s16x4v hi = __builtin_bit_cast(s16x4v, __builtin_amdgcn_ds_read_tr16_b64_v4i16((LAS s16x4v*)(vb + 4 * VT_PITCH + 16 * dt)));
        const bf16x8 vf = (bf16x8){lo[0], lo[1], lo[2], lo[3], hi[0], hi[1], hi[2], hi[3]};
        o[dt] = __builtin_amdgcn_mfma_f32_16x16x32_bf16(vf, __builtin_bit_cast(bf16x8, pw), o[dt], 0, 0, 0);
    }
}
__device__ __forceinline__ void team_barrier(volatile LAS unsigned* tb, unsigned& kb);
__device__ __forceinline__ void attn_unit(Ctx& C, int l, int a, LAS bf16* vt, volatile LAS unsigned* tb, unsigned& kbar) {
    KA_FRESH(C);
    const int lane = C.lane, q = lane & 15, g = lane >> 4;
    const bf16* P = WSP(bf16, WS_PROJ);
    f32x4 o[4];
#pragma unroll
    for (int dt = 0; dt < 4; ++dt) o[dt] = (f32x4){0.f, 0.f, 0.f, 0.f};
    float R = 1.f;
    const int head = a & 7, b = (a >> 3) & 7, rg = a >> 6, bh = b * 8 + head;
    const float bias2 = C.in(28)[l * 8 + head] * LOG2E;
    const int row0 = MP + 8 * b;
    bf16x8 qf[2];
    { const int qr = q < 8 ? q : 7; const bf16* qp = P + (size_t)(row0 + qr) * PP + C_Q + 64 * head + 8 * g;
#pragma unroll
      for (int ks = 0; ks < 2; ++ks) { v4u x = *(const v4u*)(qp + 32 * ks); if (q >= 8) { x.x = 0u; x.y = 0u; x.z = 0u; x.w = 0u; } qf[ks] = __builtin_bit_cast(bf16x8, x); } }
    LAS bf16* kt = vt + 64 * VT_PITCH;
    if (rg < 32) {
        const int* pt = (const int*)C.in(6) + b * 128;
        const float* ck = C.in(4) + (size_t)l * 1280 * 128 * 512 + 64 * head; const float* cv = C.in(5) + (size_t)l * 1280 * 128 * 512 + 64 * head;
        RawG ra;
        const int p0 = __builtin_amdgcn_readfirstlane(pt[4 * rg + 0]), p1 = __builtin_amdgcn_readfirstlane(pt[4 * rg + 1]), p2 = __builtin_amdgcn_readfirstlane(pt[4 * rg + 2]), p3 = __builtin_amdgcn_readfirstlane(pt[4 * rg + 3]);
#define GOFF(j) (((size_t)(((j) >> 1) == 0 ? p0 : ((j) >> 1) == 1 ? p1 : ((j) >> 1) == 2 ? p2 : p3) * 128 + ((j) & 1) * 64) * 512)
        { const size_t off = GOFF(7); rawg_load(ra, ck + off, cv + off, lane); }
#pragma unroll 1
        for (int j = 7; j >= 0; --j) {
            team_barrier(tb, kbar);
            rawg_stage(ra, vt, lane);
            asm volatile("" ::: "memory");
            if (j > 0) { const size_t off = GOFF(j - 1); rawg_load(ra, ck + off, cv + off, lane); }
            sb16<false>(vt + 32 * VT_PITCH, kt + 32 * VT_PITCH, qf, bias2, 0, 0x7fffffff, lane, R, o);
            sb16<false>(vt, kt, qf, bias2, 0, 0x7fffffff, lane, R, o);
        }
#undef GOFF
    } else {
        RawBf cur; raw_load_bf16(cur, P + (size_t)row0 * PP + C_K + 64 * head, P + (size_t)row0 * PP + C_V + 64 * head, PP, 0, 7, lane);
#pragma unroll
        for (int i = 0; i < 4; ++i) { *(LAS v4u*)(kt + (8 * i + (lane >> 3)) * VT_PITCH + 8 * (lane & 7)) = cur.k[i]; *(LAS v4u*)(vt + (8 * i + (lane >> 3)) * VT_PITCH + 8 * (lane & 7)) = cur.v[i]; }
        sb16<true>(vt, kt, qf, bias2, 0, q, lane, R, o);
    }
    float* spo = WSP(float, WS_SPO) + (size_t)(bh * 33 + rg) * 8 * 64; float* spt = WSP(float, WS_SPT) + (size_t)(bh * 33 + rg) * 8;
    if (q < 8) {
#pragma unroll
        for (int dt = 0; dt < 4; ++dt) *(f32x4*)(spo + q * 64 + 16 * dt + 4 * g) = o[dt];
    }
    if (lane < 8) spt[lane] = R;
}

constexpr int PB_SLOT = 2 * 32 * VT_PITCH * 2;
__device__ __forceinline__ void team_barrier(volatile LAS unsigned* tb, unsigned& kb) {
    kb += 1u;
    const unsigned target = 4u * kb;
    const unsigned addr = (unsigned)(uintptr_t)tb;
    unsigned tmp, sc, cnt; unsigned long long sv;
    asm volatile(
        "s_waitcnt lgkmcnt(0)\n\t"
        "s_mov_b64 %[sv], exec\n\t"
        "s_mov_b64 exec, 1\n\t"
        "ds_add_u32 %[addr], %[one]\n\t"
        "s_mov_b64 exec, %[sv]\n\t"
        "s_mov_b32 %[cnt], 0\n\t"
        "1:\n\t"
        "ds_read_b32 %[tmp], %[addr]\n\t"
        "s_waitcnt lgkmcnt(0)\n\t"
        "v_readfirstlane_b32 %[sc], %[tmp]\n\t"
        "s_cmp_ge_u32 %[sc], %[target]\n\t"
        "s_cbranch_scc1 2f\n\t"
        "s_add_u32 %[cnt], %[cnt], 1\n\t"
        "s_cmp_gt_u32 %[cnt], 0x2000000\n\t"
        "s_cbranch_scc1 2f\n\t"
        "s_sleep 1\n\t"
        "s_branch 1b\n\t"
        "2:\n\t"
        : [tmp] "=&v"(tmp), [sc] "=&s"(sc), [cnt] "=&s"(cnt), [sv] "=&s"(sv)
        : [addr] "v"(addr), [one] "v"(1u), [target] "s"(target)
        : "memory", "scc");
}
__device__ __forceinline__ void prompt_team_unit(Ctx& C, int l, int u, LAS bf16* ring, volatile LAS unsigned* tb, unsigned& kb) {
    KA_FRESH(C);
    const int lane = C.lane, m = lane & 31, kh = lane >> 5, w4 = C.wave & 3;
    const int qb = 15 - (u >> 5), sh = u & 31, seq = sh >> 3, head = sh & 7;
    const int g = 4 * qb + w4, T0 = 4 * qb + 3;
    const bf16* P = WSP(bf16, WS_PROJ);
    const float bias2 = C.in(28)[l * 8 + head] * LOG2E;
    const int row0 = seq * 2048;
    bf16x8 qf[4];
    { const bf16* qp = P + (size_t)(row0 + 32 * g + m) * PP + C_Q + 64 * head + 8 * kh;
#pragma unroll
      for (int ks = 0; ks < 4; ++ks) qf[ks] = *(const bf16x8*)(qp + 16 * ks); }
    const int tt = C.tid & 255, lrow = tt >> 3, lch = tt & 7;
    const bf16* srck = P + (size_t)row0 * PP + C_K + 64 * head + 8 * lch; const bf16* srcv = P + (size_t)row0 * PP + C_V + 64 * head + 8 * lch;
    const int ldst = lrow * VT_PITCH + 8 * lch;
    const int qpos = 32 * g + m;
    f32x16 o[2];
#pragma unroll
    for (int r = 0; r < 16; ++r) { o[0][r] = 0.f; o[1][r] = 0.f; }
    float R = 1.f;
#define PT_LDK(t) (*(const v4u*)(srck + (size_t)(32 * ((t) > 0 ? (t) : 0) + lrow) * PP))
#define PT_LDV(t) (*(const v4u*)(srcv + (size_t)(32 * ((t) > 0 ? (t) : 0) + lrow) * PP))
    v4u rak = PT_LDK(T0), rav = PT_LDV(T0), rbk = PT_LDK(T0 - 1), rbv = PT_LDV(T0 - 1);
#pragma unroll 1
    for (int t = T0; t >= 0; t -= 2) {
        *(LAS v4u*)(ring + 32 * VT_PITCH + ldst) = rak; *(LAS v4u*)(ring + ldst) = rav;
        rak = PT_LDK(t - 2); rav = PT_LDV(t - 2);
        team_barrier(tb, kb);
        if (t <= g) {
            LAS bf16* vt = ring; bf16x8 kf[4]; kfrags_from_lds(vt + 32 * VT_PITCH, kf, lane);
            if (t == g) sb_compute<true>(kf, vt, 32 * t, qf, bias2, qpos, lane, R, o); else sb_compute<false>(kf, vt, 32 * t, qf, bias2, qpos, lane, R, o);
        }
        *(LAS v4u*)(ring + PB_SLOT / 2 + 32 * VT_PITCH + ldst) = rbk; *(LAS v4u*)(ring + PB_SLOT / 2 + ldst) = rbv;
        rbk = PT_LDK(t - 3); rbv = PT_LDV(t - 3);
        team_barrier(tb, kb);
        if (t - 1 <= g) {
            LAS bf16* vt = ring + PB_SLOT / 2; bf16x8 kf[4]; kfrags_from_lds(vt + 32 * VT_PITCH, kf, lane);
            if (t - 1 == g) sb_compute<true>(kf, vt, 32 * (t - 1), qf, bias2, qpos, lane, R, o); else sb_compute<false>(kf, vt, 32 * (t - 1), qf, bias2, qpos, lane, R, o);
        }
    }
#undef PT_LDK
#undef PT_LDV
    bf16* oa = WSP(bf16, WS_OATT) + (size_t)(row0 + 32 * g) * 512 + 64 * head;
#pragma unroll
    for (int dt = 0; dt < 2; ++dt)
#pragma unroll
        for (int r = 0; r < 16; ++r) oa[(size_t)crow(r, kh) * 512 + 32 * dt + m] = f2bf(o[dt][r]);
    team_barrier(tb, kb);
}
constexpr int PB_SLOT_FWD = 0;
__device__ __forceinline__ void prompt_block_unit(Ctx& C, int l, int u) {
    KA_FRESH(C);
    const int lane = C.lane, m = lane & 31, kh = lane >> 5, wave = C.wave;
    const int qb = 7 - (u >> 5), sh = u & 31, seq = sh >> 3, head = sh & 7;
    const int g = 8 * qb + wave, T0 = 8 * qb + 7;
    const bf16* P = WSP(bf16, WS_PROJ);
    const float bias2 = C.in(28)[l * 8 + head] * LOG2E;
    const int row0 = seq * 2048;
    bf16x8 qf[4];
    { const bf16* qp = P + (size_t)(row0 + 32 * g + m) * PP + C_Q + 64 * head + 8 * kh;
#pragma unroll
      for (int ks = 0; ks < 4; ++ks) qf[ks] = *(const bf16x8*)(qp + 16 * ks); }
    const int part = C.tid >> 8, lrow = (C.tid & 255) >> 3, lch = C.tid & 7;
    const bf16* src = P + (size_t)row0 * PP + (part == 0 ? C_K : C_V) + 64 * head + 8 * lch;
    const int ldst = (part == 0 ? 32 * VT_PITCH : 0) + lrow * VT_PITCH + 8 * lch;
    LAS bf16* ring = (LAS bf16*)C.lds;
    const int qpos = 32 * g + m;
    f32x16 o[2];
#pragma unroll
    for (int r = 0; r < 16; ++r) { o[0][r] = 0.f; o[1][r] = 0.f; }
    float R = 1.f;
#define PB_LD(t) (*(const v4u*)(src + (size_t)(32 * ((t) > 0 ? (t) : 0) + lrow) * PP))
    v4u ra = PB_LD(T0), rb = PB_LD(T0 - 1);
#pragma unroll 1
    for (int t = T0; t >= 0; t -= 2) {
        *(LAS v4u*)(ring + ldst) = ra;
        ra = PB_LD(t - 2);
        __syncthreads();
        if (t <= g) {
            LAS bf16* vt = ring; bf16x8 kf[4]; kfrags_from_lds(vt + 32 * VT_PITCH, kf, lane);
            if (t == g) sb_compute<true>(kf, vt, 32 * t, qf, bias2, qpos, lane, R, o); else sb_compute<false>(kf, vt, 32 * t, qf, bias2, qpos, lane, R, o);
        }
        *(LAS v4u*)(ring + PB_SLOT / 2 + ldst) = rb;
        rb = PB_LD(t - 3);
        __syncthreads();
        if (t - 1 <= g) {
            LAS bf16* vt = ring + PB_SLOT / 2; bf16x8 kf[4]; kfrags_from_lds(vt + 32 * VT_PITCH, kf, lane);
            if (t - 1 == g) sb_compute<true>(kf, vt, 32 * (t - 1), qf, bias2, qpos, lane, R, o); else sb_compute<false>(kf, vt, 32 * (t - 1), qf, bias2, qpos, lane, R, o);
        }
    }
#undef PB_LD
    bf16* oa = WSP(bf16, WS_OATT) + (size_t)(row0 + 32 * g) * 512 + 64 * head;
#pragma unroll
    for (int dt = 0; dt < 2; ++dt)
#pragma unroll
        for (int r = 0; r < 16; ++r) oa[(size_t)crow(r, kh) * 512 + 32 * dt + m] = f2bf(o[dt][r]);
    __syncthreads();
}

__device__ __forceinline__ bf16x8 pack8(const f32x16& a, int s) {
    v4u w;
    if (s == 0) { w.x = cvtpk(a[0], a[1]); w.y = cvtpk(a[2], a[3]); w.z = cvtpk(a[4], a[5]); w.w = cvtpk(a[6], a[7]); }
    else { w.x = cvtpk(a[8], a[9]); w.y = cvtpk(a[10], a[11]); w.z = cvtpk(a[12], a[13]); w.w = cvtpk(a[14], a[15]); }
    return __builtin_bit_cast(bf16x8, w);
}
__device__ __forceinline__ void bf16x16_to_f32(f32x16& a, const v4u x, const v4u y) {
    a[0] = bflo(x.x); a[1] = bfhi(x.x); a[2] = bflo(x.y); a[3] = bfhi(x.y); a[4] = bflo(x.z); a[5] = bfhi(x.z); a[6] = bflo(x.w); a[7] = bfhi(x.w);
    a[8] = bflo(y.x); a[9] = bfhi(y.x); a[10] = bflo(y.y); a[11] = bfhi(y.y); a[12] = bflo(y.z); a[13] = bfhi(y.z); a[14] = bflo(y.w); a[15] = bfhi(y.w);
}
__device__ __forceinline__ void gdn_scan_unit(Ctx& C, int l, int su) {
    KA_FRESH(C);
    const int lane = C.lane, m = lane & 31, hi = lane >> 5;
    int seq, head, ds, nch, cid0;
    if (su < 128) { const int sh = su >> 2; ds = su & 3; seq = sh >> 3; head = sh & 7; nch = 32; cid0 = sh * 32; }
    else { const int v = su - 128; const int sh = v >> 2; ds = v & 3; seq = 4 + (sh >> 3); head = sh & 7; nch = 1; cid0 = 1024 + sh; }
    const int row0 = seq_row0(seq);
    f32x16 S[4];
    if (seq >= 4) {
        const float* s0 = C.in(10) + ((size_t)(l * 8 + (seq - 4)) * 8 + head) * 16384 + 32 * ds + m;
#pragma unroll
        for (int dt = 0; dt < 4; ++dt)
#pragma unroll
            for (int r = 0; r < 16; ++r) S[dt][r] = s0[(size_t)(32 * dt + crow(r, hi)) * 128];
    } else {
#pragma unroll
        for (int dt = 0; dt < 4; ++dt)
#pragma unroll
            for (int r = 0; r < 16; ++r) S[dt][r] = 0.f;
    }
    bf16* OG = WSP(bf16, WS_OGDN);
#pragma unroll 1
    for (int ch = 0; ch < nch; ++ch) {
        const int cid = cid0 + ch;
        const bf16x8* Wf = (const bf16x8*)(WSP(v4u, WS_WF) + (size_t)cid * 1024) + lane;
        const bf16x8* QEf = (const bf16x8*)(WSP(v4u, WS_QEF) + (size_t)cid * 1024) + lane;
        const bf16x8* KDf = (const bf16x8*)(WSP(v4u, WS_KDF) + (size_t)cid * 1024) + lane;
        const bf16x8* QKf = (const bf16x8*)(WSP(v4u, WS_QKF) + (size_t)cid * 512) + lane;
        const v4u* Uf = (const v4u*)(WSP(bf16, WS_UF) + (size_t)cid * 8192);
        const float egl = WSP(float, WS_GL)[cid];
        bf16x8 Sf[8];
#pragma unroll
        for (int dt = 0; dt < 4; ++dt) { Sf[2 * dt] = pack8(S[dt], 0); Sf[2 * dt + 1] = pack8(S[dt], 1); }
        f32x16 av[2], ao[2];
#pragma unroll
        for (int ti = 0; ti < 2; ++ti) {
            { const v4u* up = Uf + ((ds * 2 + ti) * 64 + lane) * 2; bf16x16_to_f32(av[ti], up[0], up[1]); }
#pragma unroll
            for (int ks = 0; ks < 8; ++ks) av[ti] = __builtin_amdgcn_mfma_f32_32x32x16_bf16(Wf[(ti * 8 + ks) * 64], Sf[ks], av[ti], 0, 0, 0);
#pragma unroll
            for (int r = 0; r < 16; ++r) ao[ti][r] = 0.f;
#pragma unroll
            for (int ks = 0; ks < 8; ++ks) ao[ti] = __builtin_amdgcn_mfma_f32_32x32x16_bf16(QEf[(ti * 8 + ks) * 64], Sf[ks], ao[ti], 0, 0, 0);
        }
        bf16x8 Vf[4];
        Vf[0] = pack8(av[0], 0); Vf[1] = pack8(av[0], 1); Vf[2] = pack8(av[1], 0); Vf[3] = pack8(av[1], 1);
#pragma unroll
        for (int ti = 0; ti < 2; ++ti)
#pragma unroll
            for (int k2 = 0; k2 < 4; ++k2) ao[ti] = __builtin_amdgcn_mfma_f32_32x32x16_bf16(QKf[(ti * 4 + k2) * 64], Vf[k2], ao[ti], 0, 0, 0);
#pragma unroll
        for (int dt = 0; dt < 4; ++dt) {
#pragma unroll
            for (int r = 0; r < 16; ++r) S[dt][r] *= egl;
#pragma unroll
            for (int k2 = 0; k2 < 4; ++k2) S[dt] = __builtin_amdgcn_mfma_f32_32x32x16_bf16(KDf[(dt * 4 + k2) * 64], Vf[k2], S[dt], 0, 0, 0);
        }
        if (seq < 4) {
#pragma unroll
            for (int ti = 0; ti < 2; ++ti)
#pragma unroll
                for (int r = 0; r < 16; ++r) OG[(size_t)(row0 + ch * 64 + 32 * ti + crow(r, hi)) * 1024 + head * 128 + 32 * ds + m] = f2bf(ao[ti][r]);
        } else {
#pragma unroll
            for (int r = 0; r < 4; ++r) OG[(size_t)(row0 + crow(r, hi)) * 1024 + head * 128 + 32 * ds + m] = f2bf(ao[0][r]);
        }
    }
    float* so = (seq < 4) ? OUTB + O_GP + ((size_t)(l * 4 + seq) * 8 + head) * 16384 : OUTB + O_GS + ((size_t)(l * 8 + (seq - 4)) * 8 + head) * 16384;
#pragma unroll
    for (int dt = 0; dt < 4; ++dt)
#pragma unroll
        for (int r = 0; r < 16; ++r) so[(size_t)(32 * dt + crow(r, hi)) * 128 + 32 * ds + m] = S[dt][r];
}

constexpr int SCAN_BUF = 73728;
static_assert(2 * SCAN_BUF <= LDS_MISC, "scan LDS");
__device__ __forceinline__ void scan_load(Ctx& C, int cid, int lt, v4u (&t)[18]) {
#pragma unroll
    for (int i = 0; i < 18; ++i) { const int idx = lt + 256 * i;
        const v4u* src = (i < 4) ? WSP(v4u, WS_WF) + (size_t)cid * 1024 + idx : (i < 8) ? WSP(v4u, WS_QEF) + (size_t)cid * 1024 + (idx - 1024) : (i < 12) ? WSP(v4u, WS_KDF) + (size_t)cid * 1024 + (idx - 2048)
                       : (i < 14) ? WSP(v4u, WS_QKF) + (size_t)cid * 512 + (idx - 3072) : WSP(v4u, WS_UF) + (size_t)cid * 1024 + (idx - 3584);
        t[i] = *src; }
}
__device__ __forceinline__ void scan_store(LAS unsigned char* dst, int lt, const v4u (&t)[18]) {
#pragma unroll
    for (int i = 0; i < 18; ++i) *(LAS v4u*)(dst + (size_t)(lt + 256 * i) * 16) = t[i];
}
__device__ __forceinline__ void gdn_scan_block(Ctx& C, int l, int sh) {
    KA_FRESH(C);
    const int lane = C.lane, m = lane & 31, hi = lane >> 5, wave = C.wave;
    const int seq = sh >> 3, head = sh & 7, ds = wave & 3, cid0 = sh * 32;
    const int row0 = seq * 2048;
    const int lt = C.tid & 255;
    if (wave >= 4) {
        v4u tst[18];
        scan_load(C, cid0, lt, tst); scan_store(C.lds, lt, tst); scan_load(C, cid0 + 1, lt, tst);
        __syncthreads();
#pragma unroll 1
        for (int ch = 0; ch < 32; ++ch) {
            if (ch + 1 < 32) { scan_store(C.lds + ((ch + 1) & 1) * SCAN_BUF, lt, tst); if (ch + 2 < 32) scan_load(C, cid0 + ch + 2, lt, tst); }
            __syncthreads();
        }
    } else {
        const unsigned olane = (unsigned)(4 * hi * 1024 + m);
        f32x16 S[4];
#pragma unroll
        for (int dt = 0; dt < 4; ++dt)
#pragma unroll
            for (int r = 0; r < 16; ++r) S[dt][r] = 0.f;
        bf16* OG = WSP(bf16, WS_OGDN);
        float egl_next = WSP(float, WS_GL)[cid0];
        __syncthreads();
#pragma unroll 1
        for (int ch = 0; ch < 32; ++ch) {
            const int cid = cid0 + ch;
            const LAS bf16x8* Wf = (const LAS bf16x8*)(C.lds + (ch & 1) * SCAN_BUF) + lane;
            const LAS bf16x8* QEf = Wf + 1024; const LAS bf16x8* KDf = Wf + 2048; const LAS bf16x8* QKf = Wf + 3072;
            const LAS v4u* Ub = (const LAS v4u*)(C.lds + (ch & 1) * SCAN_BUF + 57344) + (ds * 2) * 128 + lane * 2;
            const float egl = egl_next; egl_next = WSP(float, WS_GL)[cid0 + (ch + 1 < 32 ? ch + 1 : ch)];
            f32x16 av[2], ao[2];
            bf16x16_to_f32(av[0], Ub[0], Ub[1]); bf16x16_to_f32(av[1], Ub[128], Ub[129]);
#pragma unroll
            for (int r = 0; r < 16; ++r) { ao[0][r] = 0.f; ao[1][r] = 0.f; }
#pragma unroll
            for (int dt = 0; dt < 4; ++dt)
#pragma unroll
                for (int sx = 0; sx < 2; ++sx) { const int ks = 2 * dt + sx; const bf16x8 sf = pack8(S[dt], sx);
                    av[0] = __builtin_amdgcn_mfma_f32_32x32x16_bf16(Wf[(0 * 8 + ks) * 64], sf, av[0], 0, 0, 0);
                    av[1] = __builtin_amdgcn_mfma_f32_32x32x16_bf16(Wf[(1 * 8 + ks) * 64], sf, av[1], 0, 0, 0);
                    ao[0] = __builtin_amdgcn_mfma_f32_32x32x16_bf16(QEf[(0 * 8 + ks) * 64], sf, ao[0], 0, 0, 0);
                    ao[1] = __builtin_amdgcn_mfma_f32_32x32x16_bf16(QEf[(1 * 8 + ks) * 64], sf, ao[1], 0, 0, 0); }
            bf16x8 Vf[4];
            Vf[0] = pack8(av[0], 0); Vf[1] = pack8(av[0], 1); Vf[2] = pack8(av[1], 0); Vf[3] = pack8(av[1], 1);
#pragma unroll
            for (int ti = 0; ti < 2; ++ti)
#pragma unroll
                for (int k2 = 0; k2 < 4; ++k2) ao[ti] = __builtin_amdgcn_mfma_f32_32x32x16_bf16(QKf[(ti * 4 + k2) * 64], Vf[k2], ao[ti], 0, 0, 0);
#pragma unroll
            for (int dt = 0; dt < 4; ++dt) {
#pragma unroll
                for (int r = 0; r < 16; ++r) S[dt][r] *= egl;
#pragma unroll
                for (int k2 = 0; k2 < 4; ++k2) S[dt] = __builtin_amdgcn_mfma_f32_32x32x16_bf16(KDf[(dt * 4 + k2) * 64], Vf[k2], S[dt], 0, 0, 0);
            }
#pragma unroll
            for (int ti = 0; ti < 2; ++ti)
#pragma unroll
                for (int r = 0; r < 16; ++r) { bf16* p = OG + (size_t)(row0 + ch * 64 + 32 * ti + (r & 3) + 8 * (r >> 2)) * 1024 + head * 128 + 32 * ds; p[olane] = f2bf(ao[ti][r]); }
            __syncthreads();
        }
        float* so = OUTB + O_GP + ((size_t)(l * 4 + seq) * 8 + head) * 16384;
#pragma unroll
        for (int dt = 0; dt < 4; ++dt)
#pragma unroll
            for (int r = 0; r < 16; ++r) { float* p = so + (32 * dt + (r & 3) + 8 * (r >> 2)) * 128 + 32 * ds; p[(unsigned)(4 * hi * 128 + m)] = S[dt][r]; }
    }
}

__device__ __forceinline__ void lru_carry_task(Ctx& C, int l, int task) {
    KA_FRESH(C);
    const int s = task >> 3, d = (task & 7) * 64 + C.lane;
    const int nchunk = s < 4 ? 64 : 1, len = s < 4 ? 32 : 8, row0 = seq_row0(s);
    float H = s < 4 ? 0.f : C.in(8)[(size_t)(l * 8 + (s - 4)) * 512 + d];
    const float* HL = WSP(float, WS_LH); const float* AL = WSP(float, WS_LA); float* CR = WSP(float, WS_CARRY);
#pragma unroll 8
    for (int c = 0; c < nchunk; ++c) {
        CR[(size_t)(s * 64 + c) * 512 + d] = H;
        const size_t off = (size_t)(row0 + c * len + len - 1) * 512 + d;
        H = AL[off] * H + HL[off];
    }
    float* o = s < 4 ? OUTB + O_LHP + (size_t)(l * 4 + s) * 512 : OUTB + O_LHS + (size_t)(l * 8 + (s - 4)) * 512;
    o[d] = H;
}

__device__ __forceinline__ void phase_m4(Ctx& C, int l, int rep, unsigned& kbar) {
    if (C.bid >= 160 && C.G == 256) {
        pg8::Gemm g{WSP(bf16, WS_H), WSP(bf16, WS_WIN + l * WIN_L) + (size_t)6144 * DM, MP, 768, DM}; pg8::StaticOrder S; S.init(MP, 768, 96, C.bid - 160);
        EpiBf E{WSP(bf16, WS_PROJ) + 6144, PP};
        pg8::gemm_phase<EpiBf, pg8::StaticOrder, true, true>(C.lds, g, S, E);
    }
    for (int r7 = 0; r7 < REPN(7); ++r7) {
        if (C.bid < 32) gdn_scan_block(C, l, C.bid);
        else if (C.bid < 96) {
            if (C.wave < 4) gdn_scan_unit(C, l, 128 + (C.bid - 32) * 4 + C.wave);
            else if (C.wave < 6) { const int t = (C.bid - 32) * 2 + (C.wave - 4); if (t < 96) lru_carry_task(C, l, t); }
        }
    }
    {
    unsigned* qs = (unsigned*)(C.ws + WS_CTL) + CW_QUEUE + 64 * l;
    unsigned* qp = (unsigned*)(C.ws + WS_CTL) + CW_QUEUE + 64 * (16 + l);
    const int team = C.wave >> 2;
    volatile LAS unsigned* tb = (volatile LAS unsigned*)(C.lds + LDS_MISC) + 32 + 8 * team;
    LAS unsigned char* treg = C.lds + team * 73728;
    __syncthreads();
#pragma unroll 1
    for (int pass = 0; pass < 2; ++pass) {
        const bool prompt_first = (team == 0);
        const bool do_prompt = prompt_first == (pass == 0);
        if (do_prompt) {
            for (;;) {
                if ((C.tid & 255) == 0) tb[2] = __hip_atomic_fetch_add(qp, 1u, __ATOMIC_RELAXED, __HIP_MEMORY_SCOPE_AGENT);
                team_barrier(tb, kbar);
                const unsigned u = (unsigned)__builtin_amdgcn_readfirstlane((int)tb[2]);
                team_barrier(tb, kbar);
                if (u >= 512u) break;
                prompt_team_unit(C, l, (int)u, (LAS bf16*)treg, tb, kbar);
            }
        } else {
            for (;;) {
                if ((C.tid & 255) == 0) tb[2] = __hip_atomic_fetch_add(qs, 1u, __ATOMIC_RELAXED, __HIP_MEMORY_SCOPE_AGENT);
                team_barrier(tb, kbar);
                const unsigned u = (unsigned)__builtin_amdgcn_readfirstlane((int)tb[2]);
                team_barrier(tb, kbar);
                if (u >= (unsigned)(NATT_S / 4)) break;
                attn_unit(C, l, (int)(4u * u) + (C.wave & 3), (LAS bf16*)(treg + (C.wave & 3) * SG_BYTES), tb, kbar);
            }
        }
    }
    }
}

struct Args { const void* in[38]; float* out; unsigned char* ws; int ph_lo, ph_hi; };

__global__ void __launch_bounds__(NTHR, 2) hymba_fwd(Args args) {
    extern __shared__ __attribute__((aligned(16))) unsigned char lds_raw[];
    Ctx C;
    C.kp = (kptr_t)__builtin_amdgcn_kernarg_segment_ptr();
    C.out = (GAS float*)args.out; C.ws = (GAS unsigned char*)args.ws; C.lds = (LAS unsigned char*)lds_raw;
    C.tid = threadIdx.x; C.lane = C.tid & 63; C.wave = __builtin_amdgcn_readfirstlane(C.tid >> 6); C.G = gridDim.x; C.bid = blockIdx.x;
    volatile LAS unsigned* MISC = (volatile LAS unsigned*)(C.lds + LDS_MISC);
    if (C.tid < 64) MISC[C.tid] = 0u;
    __syncthreads();
    unsigned* ctl = (unsigned*)(C.ws + WS_CTL);
    XcdBarrier bar = xcd_barrier_post(ctl + CW_BAR, MISC + 8);
    const int lo = args.ph_lo, hi = args.ph_hi;
#define IN(k) (lo <= (k) && (k) < hi)
#define SEAM(k) do { if (IN(k) && IN((k) + 1)) { xcd_barrier(bar); if (REPN(6) > 1) { xcd_barrier(bar); xcd_barrier(bar); } } } while (0)

        if (IN(0)) { for (int rp = 0; rp < REPN(0); ++rp) { p0_weights(C); p0_ada(C); } } SEAM(0);
    if (IN(1)) { for (int rp = 0; rp < REPN(4); ++rp) p0b_modreduce(C); } SEAM(1);
    if (IN(2)) { for (int rp = 0; rp < REPN(4); ++rp) phase_n1(C); } SEAM(2);
    unsigned kbar = 0u;
#pragma unroll 1
    for (int l = 0; l < 2; ++l) {
        const int pb = 3 + 10 * l;
#define LF ({ int l_ = l; asm volatile("" : "+s"(l_)); l_; })
        if (IN(pb + 0)) {
            const int ll = LF; KA_FRESH(C); pg8::Gemm g{WSP(bf16, WS_H), WSP(bf16, WS_WIN + ll * WIN_L), MP, 6144, DM}; pg8::StaticOrder S; S.init(MP, 6144, C.G, C.bid); S.rep = REPN(1);
            EpiIn E{WSP(bf16, WS_PROJ), OUTB, ll};
            pg8::gemm_phase<EpiIn, pg8::StaticOrder, true, true>(C.lds, g, S, E);
            for (int su = C.bid; su < 216; su += C.G) sample_gemm_unit<0>(C, WSP(bf16, WS_H) + (size_t)MP * DM, WSP(bf16, WS_WIN + ll * WIN_L), DM, su * 32, ll);

        }
        SEAM(pb + 0);
        if (IN(pb + 1)) {
            { const int ll = LF; unsigned* q3 = ctl + CW_QUEUE + 64 * (8 + ll); volatile LAS unsigned* slot = (volatile LAS unsigned*)(C.lds + LDS_MISC) + 16;
              for (;;) {
                  if (C.tid == 0) *slot = __hip_atomic_fetch_add(q3, 1u, __ATOMIC_RELAXED, __HIP_MEMORY_SCOPE_AGENT);
                  __syncthreads();
                  const unsigned u = *slot;
                  __syncthreads();
                  const unsigned NC = (unsigned)conv_units(ll), T = 808u + NC;
                  if (u >= T) break;
                  const unsigned cb = u * NC / T, ca = (u + 1u) * NC / T;
                  if (ca > cb) conv_unit(C, ll, (int)cb);
                  else { const unsigned w = u - cb; if (w < 544u) gdn_prep_unit(C, ll, (int)w); else lru_unit(C, ll, (int)w - 544); }
              }
            }
        }
        SEAM(pb + 1);
        if (IN(pb + 2)) { for (int rp = 0; rp < REPN(3); ++rp) phase_m4(C, LF, rp, kbar); }
        SEAM(pb + 2);
        if (IN(pb + 3)) { for (int rp = 0; rp < REPN(4); ++rp) phase_finalize(C, LF); }
        SEAM(pb + 3);
        if (IN(pb + 4)) {
            const int ll = LF; KA_FRESH(C); pg8::Gemm g{WSP(bf16, WS_MIX), WSP(bf16, WS_WOUT + ll * WOUT_L), MP, DM, DM}; pg8::StaticOrder S; S.init(MP, DM, C.G, C.bid); S.rep = REPN(1);
            EpiBf E{WSP(bf16, WS_MIXO), DM};
            pg8::gemm_phase<EpiBf, pg8::StaticOrder, true, true>(C.lds, g, S, E);
            for (int su = C.bid; su < 64; su += C.G) sample_gemm_unit<1>(C, WSP(bf16, WS_MIX) + (size_t)MP * DM, WSP(bf16, WS_WOUT + ll * WOUT_L), DM, su * 32, ll);
        }
        SEAM(pb + 4);
        if (IN(pb + 5)) { for (int rp = REPN(5) - 1; rp >= 0; --rp) phase_resid(C, LF, 0, rp > 0); }
        SEAM(pb + 5);
        if (IN(pb + 6)) {
            const int ll = LF; KA_FRESH(C); pg8::Gemm g{WSP(bf16, WS_H), WSP(bf16, WS_WUP + ll * WUP_L), MP, DUP, DM}; pg8::StaticOrder S; S.init(MP, DUP, C.G, C.bid); S.rep = REPN(1);
            EpiAct E{WSP(bf16, WS_ACT), WSP(float, WS_TAILG), WSP(float, WS_HEADG), WSP(float, WS_HEADV), C.in(35) + (size_t)ll * 3 * DFF, C.in(36) + (size_t)ll * DFF};
            pg8::gemm_phase<EpiAct, pg8::StaticOrder, true, true>(C.lds, g, S, E);
            if (C.bid >= 128) for (int su = C.bid - 128; su < 352; su += 128) sample_gemm_unit<2>(C, WSP(bf16, WS_H) + (size_t)MP * DM, WSP(bf16, WS_WUP + ll * WUP_L), DM, su * 32, ll);

        }
        SEAM(pb + 6);
        if (IN(pb + 7)) { for (int rp = 0; rp < REPN(4); ++rp) phase_act(C, LF); }
        SEAM(pb + 7);
        if (IN(pb + 8)) {
            const int ll = LF; KA_FRESH(C); pg8::Gemm g{WSP(bf16, WS_ACT), WSP(bf16, WS_WDN + ll * WDN_L), MP, DM, DFF}; pg8::StaticOrder S; S.init(MP, DM, C.G, C.bid); S.rep = REPN(1);
            EpiBf E{WSP(bf16, WS_MIXO), DM};
            pg8::gemm_phase<EpiBf, pg8::StaticOrder, true, true>(C.lds, g, S, E);
            for (int su = C.bid; su < 64; su += C.G) sample_gemm_unit<1>(C, WSP(bf16, WS_ACT) + (size_t)MP * DFF, WSP(bf16, WS_WDN + ll * WDN_L), DFF, su * 32, ll);
        }
        SEAM(pb + 8);
        if (IN(pb + 9)) { for (int rp = REPN(5) - 1; rp >= 0; --rp) phase_resid(C, LF, 1, rp > 0); }
        if (l == 0) SEAM(pb + 9);
    }
#undef IN
#undef SEAM
}

#ifndef MK_PER_PHASE
#define MK_PER_PHASE 0
#endif
extern "C" void kernel_launch(void* const* d_in, const int* in_sizes, int n_in, void* d_out, int out_size, void* d_ws, size_t ws_size, hipStream_t stream) {
    static int grid = 0;
    if (grid == 0) {
        if (n_in != 38 || out_size != (int)O_END || ws_size < WS_END) { fprintf(stderr, "kernel_launch: unexpected shapes: n_in %d out %d ws %zu\n", n_in, out_size, ws_size); grid = -1; return; }
        int dev = 0, cus = 0, per_cu = 0;
        if (hipGetDevice(&dev) != hipSuccess || hipDeviceGetAttribute(&cus, hipDeviceAttributeMultiprocessorCount, dev) != hipSuccess) { grid = -1; return; }
        if (hipFuncSetAttribute((const void*)hymba_fwd, hipFuncAttributeMaxDynamicSharedMemorySize, LDS_BYTES) != hipSuccess) { fprintf(stderr, "kernel_launch: hipFuncSetAttribute failed\n"); grid = -1; return; }
        if (hipOccupancyMaxActiveBlocksPerMultiprocessor(&per_cu, (const void*)hymba_fwd, NTHR, LDS_BYTES) != hipSuccess || per_cu < 1) { fprintf(stderr, "kernel_launch: occupancy query says %d\n", per_cu); }
        (void)hipGetLastError();
        grid = cus;
    }
    if (grid < 0) return;
    (void)hipMemsetAsync((char*)d_ws + WS_CTL, 0, CTL_ZERO_BYTES, stream);
    Args a{};
    for (int i = 0; i < 38; ++i) a.in[i] = d_in[i];
    a.out = (float*)d_out; a.ws = (unsigned char*)d_ws;
#if MK_PER_PHASE
    for (int p = 0; p < NPHASE; ++p) { a.ph_lo = p; a.ph_hi = p + 1; hipLaunchKernelGGL(hymba_fwd, dim3(grid), dim3(NTHR), LDS_BYTES, stream, a); }
#else
    a.ph_lo = 0; a.ph_hi = NPHASE;
    hipLaunchKernelGGL(hymba_fwd, dim3(grid), dim3(NTHR), LDS_BYTES, stream, a);
#endif
    const hipError_t le = hipPeekAtLastError();
    if (le != hipSuccess) fprintf(stderr, "kernel_launch: launch failed: %s\n", hipGetErrorName(le));
}
```

```cpp
#include <hip/hip_runtime.h>
#include <cstdio>
#include <cstdint>
namespace pg8 {
#define PG8_LAS __attribute__((address_space(3)))
typedef unsigned short bf16_t;
typedef short bf16x8 __attribute__((ext_vector_type(8)));
typedef float f32x4 __attribute__((ext_vector_type(4)));
typedef unsigned u32x4 __attribute__((ext_vector_type(4)));
constexpr int BM = 256, BK = 64, HALF = 128, HTB = HALF * BK * 2  , STAGE_BYTES = 8 * HTB, NXCD = 8, WGM = 8;

__host__ __device__ __forceinline__ int lds_byte(int r, int c) { const int st = (r >> 4) * 2 + (c >> 5), rr = r & 15, cc = c & 31, ob = rr * 64 + cc * 2; return st * 1024 + (ob ^ (((ob >> 9) & 1) << 5)); }
__host__ __device__ __forceinline__ void stage_rc(int b, int& R, int& C) { const int st = b / 1024, sb = b % 1024, swz = sb ^ (((sb >> 9) & 1) << 5); R = (st >> 1) * 16 + swz / 64; C = (st & 1) * 32 + (swz % 64) / 2; }
__host__ __device__ __forceinline__ int perm32(int rho) { const int n = rho >> 4, i = rho & 15; return 8 * (i >> 2) + 4 * n + (i & 3); }

struct Unit { int pm, pn; };
struct Gemm { const bf16_t* A; const bf16_t* Bt; int M, N, K; };

struct StaticOrder {
    int nM, nN, nwg, G, c, rep;
    __host__ __device__ void init(int M, int N, int G_, int c_) { nM = M / BM; nN = N / BM; nwg = nM * nN; G = G_; c = c_; rep = 1; }
    __host__ __device__ bool next(int i, Unit& u) const {
        const long L = (long)i * G + c; if (L >= (long)nwg * rep) return false;
        int wgid = (int)(L % nwg); { const int q = nwg / NXCD, r = nwg % NXCD, xcd = wgid % NXCD, off = wgid / NXCD; wgid = (xcd < r ? xcd * (q + 1) : r * (q + 1) + (xcd - r) * q) + off; }
        const int nig = WGM * nN, gid = wgid / nig, fm = gid * WGM, gsz = (nM - fm) < WGM ? (nM - fm) : WGM;
        u.pm = fm + ((wgid % nig) % gsz); u.pn = (wgid % nig) / gsz; return true;
    }
    __device__ __forceinline__ void a_ready(const Unit&) const {}
    __device__ __forceinline__ void done(const Unit&) const {}
};

__device__ __forceinline__ unsigned cvt_pk_bf16(float lo, float hi) { unsigned r; asm volatile("v_cvt_pk_bf16_f32 %0, %1, %2" : "=v"(r) : "v"(lo), "v"(hi)); return r; }
typedef float f32x2 __attribute__((ext_vector_type(2)));
template <class Epi, class Sched, bool ALIGN_EPI = false, bool SP2 = false>
__device__ __forceinline__ void gemm_phase(PG8_LAS unsigned char* lds, const Gemm g, const Sched& S, const Epi& E) {
    int tid_ = threadIdx.x; asm volatile("" : "+v"(tid_)); const int tid = tid_, wid = __builtin_amdgcn_readfirstlane(tid >> 6), lane = tid & 63, wr = wid >> 2, wc = wid & 3, fr = lane & 15, fq = lane >> 4;
    const int K = g.K, nt = K / BK;
    unsigned voffA[2], voffB[2];
#pragma unroll
    for (int i = 0; i < 2; ++i) { int R, C; stage_rc(tid * 16 + i * 8192, R, C); const int Rb = Epi::PERM ? ((R & ~31) + perm32(R & 31)) : R;
        voffA[i] = (unsigned)(R * K + C) * 2u; voffB[i] = (unsigned)(Rb * K + C) * 2u; }
    const size_t kstep = (size_t)(BK * 2);
    const size_t hstep = (size_t)HALF * K * 2;
    const size_t tstep = 2 * hstep;
    const unsigned ldsw = (unsigned)wid * 1024u;
    const int aoff = lds_byte(wr * 64 + fr, fq * 8), boff = lds_byte(wc * 32 + fr, fq * 8);
#define PG8_SA(b, h) (((b) * 2 + (h)) * HTB)
#define PG8_SB(b, h) ((4 + (b) * 2 + (h)) * HTB)
#define PG8_STAGE(bufoff, gbase, voff) do { _Pragma("unroll") for (int _i = 0; _i < 2; ++_i) \
        __builtin_amdgcn_global_load_lds((const unsigned*)((const char*)(gbase) + (voff)[_i]), (PG8_LAS unsigned*)(lds + (bufoff) + ldsw + _i * 8192), 16, 0, 0); } while (0)
#define PG8_LDA(dst, b, h) do { _Pragma("unroll") for (int m = 0; m < 4; ++m) _Pragma("unroll") for (int k = 0; k < 2; ++k) dst[m][k] = *(const PG8_LAS bf16x8*)(lds + PG8_SA(b, h) + aoff + m * 2048 + k * 1024); } while (0)
#define PG8_LDB(dst, b, h) do { _Pragma("unroll") for (int n = 0; n < 2; ++n) _Pragma("unroll") for (int k = 0; k < 2; ++k) dst[n][k] = *(const PG8_LAS bf16x8*)(lds + PG8_SB(b, h) + boff + n * 2048 + k * 1024); } while (0)
#define PG8_MMA(ai, bj, At, Bt) do { __builtin_amdgcn_s_setprio(1); _Pragma("unroll") for (int m = 0; m < 4; ++m) _Pragma("unroll") for (int n = 0; n < 2; ++n) _Pragma("unroll") for (int k = 0; k < 2; ++k) \
        acc[ai][bj][m][n] = __builtin_amdgcn_mfma_f32_16x16x32_bf16(Bt[n][k], At[m][k], acc[ai][bj][m][n], 0, 0, 0); __builtin_amdgcn_s_setprio(0); } while (0)
#define PG8_WAIT_V(n) asm volatile("s_waitcnt vmcnt(" #n ")" ::: "memory")
#define PG8_WAIT_L(n) asm volatile("s_waitcnt lgkmcnt(" #n ")" ::: "memory")
#define PG8_BAR __builtin_amdgcn_s_barrier()
#define PG8_SCHED __builtin_amdgcn_sched_barrier(0)
    Unit cur, nxt; int ui = 0;
    if (!S.next(0, cur)) return;
    f32x4 acc[2][2][4][2];
#pragma unroll
    for (int a = 0; a < 2; ++a)
#pragma unroll
        for (int b = 0; b < 2; ++b)
#pragma unroll
            for (int m = 0; m < 4; ++m)
#pragma unroll
                for (int n = 0; n < 2; ++n) acc[a][b][m][n] = (f32x4){0.f, 0.f, 0.f, 0.f};
    bf16x8 At[4][2], B0[2][2], B1[2][2];
    const char* cA = (const char*)g.A + (size_t)cur.pm * tstep; const char* cB = (const char*)g.Bt + (size_t)cur.pn * tstep;
    S.a_ready(cur);
    if constexpr (SP2) {
        PG8_STAGE(PG8_SB(0, 0), cB, voffB); PG8_STAGE(PG8_SB(0, 1), cB + hstep, voffB); PG8_STAGE(PG8_SA(0, 0), cA, voffA); PG8_STAGE(PG8_SA(0, 1), cA + hstep, voffA);
        if (wr == 1) PG8_BAR;
        PG8_WAIT_V(2); PG8_BAR;
        PG8_STAGE(PG8_SB(1, 0), cB + kstep, voffB); PG8_STAGE(PG8_SA(1, 0), cA + kstep, voffA); PG8_STAGE(PG8_SB(1, 1), cB + hstep + kstep, voffB);
        PG8_WAIT_V(6); PG8_BAR;
    } else {
        PG8_STAGE(PG8_SB(0, 0), cB, voffB); PG8_STAGE(PG8_SA(0, 0), cA, voffA); PG8_STAGE(PG8_SB(0, 1), cB + hstep, voffB); PG8_STAGE(PG8_SA(0, 1), cA + hstep, voffA);
        if (wr == 1) PG8_BAR;
        PG8_WAIT_V(4); PG8_BAR;
        PG8_STAGE(PG8_SB(1, 0), cB + kstep, voffB); PG8_STAGE(PG8_SA(1, 0), cA + kstep, voffA); PG8_STAGE(PG8_SB(1, 1), cB + hstep + kstep, voffB);
        PG8_WAIT_V(6); PG8_BAR;
    }
    for (;;) {
        const bool has_next = S.next(ui + 1, nxt);
        const char* nA = has_next ? (const char*)g.A + (size_t)nxt.pm * tstep : cA; const char* nB = has_next ? (const char*)g.Bt + (size_t)nxt.pn * tstep : cB;
        for (int t = 0; t < nt; t += 2) {
            const bool last = (t == nt - 2);
            const char* a1 = cA + (size_t)(t + 1) * kstep;
            const char* a2 = last ? nA : cA + (size_t)(t + 2) * kstep; const char* b2 = last ? nB : cB + (size_t)(t + 2) * kstep;
            const char* a3 = a2 + kstep; const char* b3 = b2 + kstep;
            if (last && has_next) S.a_ready(nxt);
            if constexpr (SP2) {
            PG8_LDB(B0, 0, 0); PG8_LDB(B1, 0, 1); PG8_SCHED; PG8_LDA(At, 0, 0); PG8_STAGE(PG8_SA(1, 1), a1 + hstep, voffA);
            PG8_WAIT_V(8); PG8_WAIT_L(0); PG8_BAR; PG8_MMA(0, 0, At, B0); PG8_MMA(0, 1, At, B1); PG8_BAR; PG8_SCHED;
            PG8_LDA(At, 0, 1); PG8_STAGE(PG8_SB(0, 0), b2, voffB); PG8_STAGE(PG8_SB(0, 1), b2 + hstep, voffB); PG8_STAGE(PG8_SA(0, 0), a2, voffA);
            PG8_WAIT_V(8); PG8_WAIT_L(0); PG8_BAR; PG8_MMA(1, 0, At, B0); PG8_MMA(1, 1, At, B1); PG8_BAR; PG8_SCHED;
            PG8_LDB(B0, 1, 0); PG8_LDB(B1, 1, 1); PG8_SCHED; PG8_LDA(At, 1, 0); PG8_STAGE(PG8_SA(0, 1), a2 + hstep, voffA);
            PG8_WAIT_V(8); PG8_WAIT_L(0); PG8_BAR; PG8_MMA(0, 0, At, B0); PG8_MMA(0, 1, At, B1); PG8_BAR; PG8_SCHED;
            PG8_LDA(At, 1, 1); PG8_STAGE(PG8_SB(1, 0), b3, voffB); PG8_STAGE(PG8_SB(1, 1), b3 + hstep, voffB); PG8_STAGE(PG8_SA(1, 0), a3, voffA);
            PG8_WAIT_V(8); PG8_WAIT_L(0); PG8_BAR; PG8_MMA(1, 0, At, B0); PG8_MMA(1, 1, At, B1); PG8_BAR; PG8_SCHED;
            } else {
            PG8_LDB(B0, 0, 0); PG8_SCHED; PG8_LDA(At, 0, 0); PG8_STAGE(PG8_SA(1, 1), a1 + hstep, voffA);
            PG8_WAIT_L(8); PG8_BAR; PG8_WAIT_L(0); PG8_MMA(0, 0, At, B0); PG8_BAR; PG8_SCHED;
            PG8_LDB(B1, 0, 1); PG8_STAGE(PG8_SB(0, 0), b2, voffB);
            PG8_BAR; PG8_WAIT_L(0); PG8_MMA(0, 1, At, B1); PG8_BAR;
            PG8_LDA(At, 0, 1); PG8_STAGE(PG8_SA(0, 0), a2, voffA);
            PG8_BAR; PG8_WAIT_L(0); PG8_MMA(1, 0, At, B0); PG8_BAR; PG8_SCHED;
            PG8_STAGE(PG8_SB(0, 1), b2 + hstep, voffB);
            PG8_WAIT_V(6); PG8_BAR; PG8_MMA(1, 1, At, B1); PG8_BAR;
            PG8_LDB(B0, 1, 0); PG8_SCHED; PG8_LDA(At, 1, 0); PG8_STAGE(PG8_SA(0, 1), a2 + hstep, voffA);
            PG8_WAIT_L(8); PG8_BAR; PG8_WAIT_L(0); PG8_MMA(0, 0, At, B0); PG8_BAR; PG8_SCHED;
            PG8_LDB(B1, 1, 1); PG8_STAGE(PG8_SB(1, 0), b3, voffB);
            PG8_BAR; PG8_WAIT_L(0); PG8_MMA(0, 1, At, B1); PG8_BAR;
            PG8_LDA(At, 1, 1); PG8_STAGE(PG8_SA(1, 0), a3, voffA);
            PG8_BAR; PG8_WAIT_L(0); PG8_MMA(1, 0, At, B0); PG8_BAR; PG8_SCHED;
            PG8_STAGE(PG8_SB(1, 1), b3 + hstep, voffB);
            PG8_WAIT_V(6); PG8_BAR; PG8_MMA(1, 1, At, B1); PG8_BAR;
            }
        }
        if constexpr (ALIGN_EPI) { if (wr == 0) PG8_BAR; }
        if constexpr (!Epi::AFTER_DRAIN) { E(acc, cur, wr, wc, fr, fq); S.done(cur); }
        if (!has_next) break;
#pragma unroll
        for (int a = 0; a < 2; ++a)
#pragma unroll
            for (int b = 0; b < 2; ++b)
#pragma unroll
                for (int m = 0; m < 4; ++m)
#pragma unroll
                    for (int n = 0; n < 2; ++n) acc[a][b][m][n] = (f32x4){0.f, 0.f, 0.f, 0.f};
        cur = nxt; cA = nA; cB = nB; ++ui;
        if constexpr (ALIGN_EPI) { if (wr == 1) PG8_BAR; }
    }
    PG8_WAIT_V(0);
    if constexpr (!ALIGN_EPI) { if (wr == 0) PG8_BAR; }
    PG8_BAR;
    if constexpr (Epi::AFTER_DRAIN) { E.fused(acc, cur, wr, wc, fr, fq, lds, wid, lane); S.done(cur); }
#undef PG8_SA
#undef PG8_SB
#undef PG8_STAGE
#undef PG8_LDA
#undef PG8_LDB
#undef PG8_MMA
#undef PG8_WAIT_V
#undef PG8_WAIT_L
#undef PG8_BAR
#undef PG8_SCHED
}
}
#define LAS __attribute__((address_space(3)))
#define XB_TMO      128
#define XB_XCNT(j)  (256  + 64 * (j))
#define XB_XSUB(j)  (1280 + 64 * (j))
#define XB_XGEN(j)  (2304 + 64 * (j))
#define XB_TOP      3328
#define XB_TOPGEN   3392
#define XCD_BAR_WORDS 3456
#define XB_SPIN_CAP (1u << 18)

__device__ __forceinline__ unsigned xb_ld(unsigned* p)              { return __hip_atomic_load(p, __ATOMIC_RELAXED, __HIP_MEMORY_SCOPE_AGENT); }
__device__ __forceinline__ unsigned xb_add(unsigned* p, unsigned v) { return __hip_atomic_fetch_add(p, v, __ATOMIC_RELAXED, __HIP_MEMORY_SCOPE_AGENT); }
__device__ __forceinline__ unsigned xb_xcc_id() { return (unsigned)__builtin_amdgcn_s_getreg((3 << 11) | 20) & 0xFu; }
#define XB_SPIN(cond, bar) do { unsigned _sp = 0; while (cond) { __builtin_amdgcn_s_sleep(1); \
    if ((++_sp & 255u) == 0u) { if (xb_ld(&(bar)[XB_TMO])) break; if (_sp > XB_SPIN_CAP) { atomicAdd(&(bar)[XB_TMO], 1u); break; } } } } while (0)

struct XcdBarrier {
    unsigned* bar; unsigned x;
    volatile LAS unsigned* st;
};

__device__ __forceinline__ XcdBarrier xcd_barrier_post(unsigned* bar, volatile LAS unsigned* st) {
    XcdBarrier b; b.bar = bar; b.x = xb_xcc_id(); b.st = st;
    if (threadIdx.x == 0) (void)xb_add(&bar[XB_XCNT(b.x)], 1u);
    return b;
}
__device__ __forceinline__ void xcd_barrier_complete(unsigned* bar, unsigned x, unsigned& nloc, unsigned& nx) {
    const unsigned G = gridDim.x * gridDim.y * gridDim.z;
    unsigned sum, cnt, mine, sp = 0u;
    for (;;) {
        sum = 0u; cnt = 0u; mine = 0u;
#pragma unroll
        for (unsigned j = 0; j < 16; ++j) { const unsigned c = xb_ld(&bar[XB_XCNT(j)]); sum += c; cnt += (c > 0u) ? 1u : 0u; mine = (j == x) ? c : mine; }
        if (sum == G) break;
        __builtin_amdgcn_s_sleep(1);
        if ((++sp & 255u) == 0u) { if (xb_ld(&bar[XB_TMO])) break; if (sp > XB_SPIN_CAP) { atomicAdd(&bar[XB_TMO], 1u); break; } }
    }
    nloc = mine > 0u ? mine : 1u; nx = cnt > 0u ? cnt : 1u;
}

__device__ __forceinline__ void xcd_barrier(const XcdBarrier& b) {
    asm volatile("s_waitcnt vmcnt(0)" ::: "memory");
    __syncthreads();
    if (threadIdx.x == 0) {
        unsigned* bar = b.bar;
        __builtin_amdgcn_s_waitcnt(0);
        unsigned nloc = b.st[0], nx = b.st[1];
        if (nloc == 0u) { xcd_barrier_complete(bar, b.x, nloc, nx); b.st[0] = nloc; b.st[1] = nx; }
        const unsigned old = xb_add(&bar[XB_XSUB(b.x)], 1u);
        const unsigned gen = old / nloc;
        if (old + 1u == (gen + 1u) * nloc) {
            __builtin_amdgcn_fence(__ATOMIC_RELEASE, "agent");
            asm volatile("s_waitcnt vmcnt(0)" ::: "memory");
            const unsigned og = xb_add(&bar[XB_TOP], 1u);
            const unsigned tg = og / nx;
            if (og + 1u == (tg + 1u) * nx) xb_add(&bar[XB_TOPGEN], 1u);
            else XB_SPIN(xb_ld(&bar[XB_TOPGEN]) == tg, bar);
            __builtin_amdgcn_fence(__ATOMIC_ACQUIRE, "agent");
            xb_add(&bar[XB_XGEN(b.x)], 1u);
            asm volatile("s_waitcnt vmcnt(0)" ::: "memory");
        } else {
            XB_SPIN(xb_ld(&bar[XB_XGEN(b.x)]) == gen, bar);
            __builtin_amdgcn_fence(__ATOMIC_ACQUIRE, "agent");
            asm volatile("s_waitcnt vmcnt(0)" ::: "memory");
        }
    }
    __syncthreads();
}

#ifndef TP
#define TP 0xffff
#endif
#ifndef TAILCONV
#define TAILCONV 0
#endif
#ifndef REPMASK
#define REPMASK 0
#endif
#ifndef RN
#define RN 2
#endif
#define REPN(bit) (((REPMASK >> (bit)) & 1) ? RN : 1)
#define GAS __attribute__((address_space(1)))
#ifndef LAS
#define LAS __attribute__((address_space(3)))
#endif
typedef unsigned short bf16;
typedef unsigned v4u __attribute__((ext_vector_type(4)));
typedef unsigned v2u __attribute__((ext_vector_type(2)));
typedef float f32x4 __attribute__((ext_vector_type(4)));
typedef float f32x16 __attribute__((ext_vector_type(16)));
typedef short bf16x8 __attribute__((ext_vector_type(8)));

constexpr int NWAVES = 8, NTHR = 512;
constexpr int DM = 2048, MP = 8192, MS = 64, MR = 8256, MPAD = 8448;
constexpr int DINP = 6912, DFF = 5632, DUP = 11264, PP = 6912  ;
constexpr int C_AX = 0, C_AG = 512, C_Q = 1024, C_K = 1536, C_V = 2048, C_GQ = 2560, C_B = 5632, C_A = 5640, C_Z = 5888;
constexpr float EPS = 1e-6f;
constexpr float LOG2E = 1.4426950408889634f;
constexpr float QSCALE = 0.125f * LOG2E;

constexpr size_t O_Y = 0;
constexpr size_t O_KP = (size_t)MR * DM;
constexpr size_t O_VP = O_KP + (size_t)2 * 4 * 2048 * 512;
constexpr size_t O_KS = O_VP + (size_t)2 * 4 * 2048 * 512;
constexpr size_t O_VS = O_KS + (size_t)2 * 64 * 512;
constexpr size_t O_LCP = O_VS + (size_t)2 * 64 * 512;
constexpr size_t O_LCS = O_LCP + (size_t)2 * 4 * 3 * 512;
constexpr size_t O_LHP = O_LCS + (size_t)2 * 8 * 3 * 512;
constexpr size_t O_LHS = O_LHP + (size_t)2 * 4 * 512;
constexpr size_t O_GCP = O_LHS + (size_t)2 * 8 * 512;
constexpr size_t O_GCS = O_GCP + (size_t)2 * 4 * 3 * 3072;
constexpr size_t O_GP = O_GCS + (size_t)2 * 8 * 3 * 3072;
constexpr size_t O_GS = O_GP + (size_t)2 * 4 * 8 * 128 * 128;
constexpr size_t O_FCP = O_GS + (size_t)2 * 8 * 8 * 128 * 128;
constexpr size_t O_FCS = O_FCP + (size_t)2 * 4 * 2 * 5632;
constexpr size_t O_END = O_FCS + (size_t)2 * 8 * 2 * 5632;
static_assert(O_END == 37502976, "output size");

constexpr size_t MiB = 1u << 20;
constexpr size_t WS_CTL = 0, CTL_ZERO_BYTES = 65536;
constexpr size_t WS_WIN = 1 * MiB;
constexpr size_t WS_WOUT = 55 * MiB;
constexpr size_t WS_WUP = 71 * MiB;
constexpr size_t WS_WDN = 159 * MiB;
constexpr size_t WS_MODP = 203 * MiB;
constexpr size_t WS_MOD = 208 * MiB;
constexpr size_t WS_H = 210 * MiB;
constexpr size_t WS_PROJ = 243 * MiB;
constexpr size_t WS_LH = 355 * MiB;
constexpr size_t WS_LA = 372 * MiB;
constexpr size_t WS_CARRY = 389 * MiB;
constexpr size_t WS_WF = 391 * MiB;
constexpr size_t WS_QEF = 408 * MiB;
constexpr size_t WS_KDF = 425 * MiB;
constexpr size_t WS_QKF = 442 * MiB;
constexpr size_t WS_UF = 451 * MiB;
constexpr size_t WS_GL = 485 * MiB;
constexpr size_t WS_OGDN = 486 * MiB;
constexpr size_t WS_OATT = 519 * MiB;
constexpr size_t WS_SPO = 536 * MiB;
constexpr size_t WS_SPT = 541 * MiB;
constexpr size_t WS_MIX = 542 * MiB;
constexpr size_t WS_MIXO = 575 * MiB;
constexpr size_t WS_GV = 641 * MiB;
constexpr size_t WS_ACT = 823 * MiB;
constexpr size_t WS_TAILG = 914 * MiB;
constexpr size_t WS_HEADG = 920 * MiB;
constexpr size_t WS_HEADV = 926 * MiB;
constexpr size_t WS_END = 932 * MiB;
constexpr size_t WIN_L = (size_t)DINP * DM * 2, WOUT_L = (size_t)DM * DM * 2, WUP_L = (size_t)DUP * DM * 2, WDN_L = (size_t)DM * DFF * 2;

constexpr int CW_BAR = 4096;
constexpr int CW_QUEUE = 8192;

constexpr int LDS_MISC = 147456;
constexpr int LDS_BYTES = 148480;

constexpr int NPHASE = 23;
template <int CTRL> __device__ __forceinline__ float dppf(float x) { return __builtin_bit_cast(float, __builtin_amdgcn_mov_dpp(__builtin_bit_cast(int, x), CTRL, 0xf, 0xf, true)); }

#define LDS_WAIT() asm volatile("s_waitcnt lgkmcnt(0)" ::: "memory")
__device__ __forceinline__ float bf2f(unsigned short u) { return __uint_as_float((unsigned)u << 16); }
__device__ __forceinline__ float bflo(unsigned u) { return __uint_as_float(u << 16); }
__device__ __forceinline__ float bfhi(unsigned u) { return __uint_as_float(u & 0xffff0000u); }
__device__ __forceinline__ unsigned cvtpk(float lo, float hi) {
    typedef float f2_t __attribute__((ext_vector_type(2))); typedef __bf16 b2_t __attribute__((ext_vector_type(2)));
    f2_t v = {lo, hi}; b2_t b = __builtin_convertvector(v, b2_t); return __builtin_bit_cast(unsigned, b); }
__device__ __forceinline__ unsigned short f2bf(float f) { return (unsigned short)(cvtpk(f, 0.f) & 0xffffu); }
__device__ __forceinline__ float wave_sum(float v) {
#pragma unroll
    for (int o = 1; o < 64; o <<= 1) v += __shfl_xor(v, o);
    return v;
}
__device__ __forceinline__ float sigmoidf_(float x) { return __builtin_amdgcn_rcpf(1.0f + __builtin_amdgcn_exp2f(-1.4426950408889634f * x)); }
__device__ __forceinline__ float siluf_(float x) { return x * __builtin_amdgcn_rcpf(1.0f + __builtin_amdgcn_exp2f(-1.4426950408889634f * x)); }
__device__ __forceinline__ float softplusf_(float x) {
    const float t = __builtin_amdgcn_exp2f(-1.4426950408889634f * fabsf(x));
    const float series = t * (1.0f - t * (0.5f - t * (0.33333334f - t * (0.25f - 0.2f * t))));
    const float lg = 0.6931471805599453f * __builtin_amdgcn_logf(1.0f + t);
    return fmaxf(x, 0.f) + (t < 0.03125f ? series : lg);
}
__device__ __forceinline__ float gelu_tanh(float x) { const float u = 0.7978845608028654f * (x + 0.044715f * x * x * x); return x * sigmoidf_(2.0f * u); }
__device__ __forceinline__ int crow(int r, int hi) { return (r & 3) + 8 * (r >> 2) + 4 * hi; }
__device__ __forceinline__ int seq_row0(int s) { return s < 4 ? s * 2048 : 8192 + (s - 4) * 8; }

typedef const __attribute__((address_space(4))) unsigned long long* kptr_t;
struct Ctx {
    kptr_t kp;
    GAS float* out; GAS unsigned char* ws;
    LAS unsigned char* lds;
    int tid, lane, wave, G, bid;
    __device__ __forceinline__ const float* in(int i) const { return (const float*)(GAS const float*)kp[i]; }
};
#define KA_FRESH(C) do { asm volatile("" : "+s"((C).kp)); asm volatile("" : "+s"((C).ws)); asm volatile("" : "+s"((C).out)); asm volatile("" : "+v"((C).tid)); (C).lane = (C).tid & 63; (C).wave = __builtin_amdgcn_readfirstlane((C).tid >> 6); } while (0)
#define WSP(T, off) ((T*)(GAS T*)(C.ws + (off)))
#define OUTB ((float*)C.out)

__device__ __forceinline__ void tr_item(const float* __restrict__ W, int K, int Nsrc, int sc0, int nv, bf16* WT, int n0, int k0, LAS float* scr, int lane) {
    const float* src = W + (size_t)k0 * Nsrc + sc0 + lane;
    const bool ok = lane < nv;
#pragma unroll 32
    for (int i = 0; i < 64; ++i) { const float v = ok ? __builtin_nontemporal_load(src + (size_t)i * Nsrc) : 0.f; scr[i * 65 + lane] = v; }
    LDS_WAIT(); asm volatile("" ::: "memory");
    const int c = lane & 7;
#pragma unroll
    for (int j = 0; j < 8; ++j) { const int n = (lane >> 3) + 8 * j; const LAS float* s = scr + (8 * c) * 65 + n;
        v4u o; o.x = cvtpk(s[0 * 65], s[1 * 65]); o.y = cvtpk(s[2 * 65], s[3 * 65]); o.z = cvtpk(s[4 * 65], s[5 * 65]); o.w = cvtpk(s[6 * 65], s[7 * 65]);
        __builtin_nontemporal_store(o, (GAS v4u*)(WT + (size_t)(n0 + n) * K + k0 + 8 * c)); }
    LDS_WAIT(); asm volatile("" ::: "memory");
}

struct ConvItem { const float* src; size_t stride; bool ok; bf16* dst; int K; };
__device__ __forceinline__ ConvItem conv_item(Ctx& C, int l, int kind, int r, int lane) {
    ConvItem it;
    if (kind == 0) { const int nb = r >> 5, kb = r & 31; const int n0 = nb * 64;
        int sc0, nv; if (n0 < 5632) { sc0 = n0; nv = 64; } else if (n0 == 5632) { sc0 = 6656; nv = 16; } else if (n0 < 5888) { sc0 = 0; nv = 0; } else { sc0 = 5632 + (n0 - 5888); nv = 64; }
        it.src = C.in(18) + (size_t)l * DM * 6672 + (size_t)(kb * 64) * 6672 + sc0 + lane; it.stride = 6672; it.ok = lane < nv; it.K = DM; it.dst = WSP(bf16, WS_WIN + l * WIN_L) + (size_t)n0 * DM + kb * 64;
    } else if (kind == 1) { const int nb = r >> 5, kb = r & 31;
        it.src = C.in(33) + (size_t)l * DM * DM + (size_t)(kb * 64) * DM + nb * 64 + lane; it.stride = DM; it.ok = true; it.K = DM; it.dst = WSP(bf16, WS_WOUT + l * WOUT_L) + (size_t)(nb * 64) * DM + kb * 64;
    } else if (kind == 2) { const int nb = r >> 5, kb = r & 31; const int n0 = nb * 64; const int pn = n0 >> 8, bj = (n0 >> 7) & 1, c0 = n0 & 127;
        it.src = C.in(34) + (size_t)l * DM * DUP + (size_t)(kb * 64) * DUP + bj * DFF + pn * 128 + c0 + lane; it.stride = DUP; it.ok = true; it.K = DM; it.dst = WSP(bf16, WS_WUP + l * WUP_L) + (size_t)n0 * DM + kb * 64;
    } else { const int nb = r / 88, kb = r % 88;
        it.src = C.in(37) + (size_t)l * DFF * DM + (size_t)(kb * 64) * DM + nb * 64 + lane; it.stride = DM; it.ok = true; it.K = DFF; it.dst = WSP(bf16, WS_WDN + l * WDN_L) + (size_t)(nb * 64) * DFF + kb * 64;
    }
    return it;
}
__device__ __forceinline__ void conv_weights(Ctx& C, int l, int kind, int wi, int iend, int wn) {
    KA_FRESH(C);
    LAS float* scr = (LAS float*)(C.lds + C.wave * 16640);
    const int lane = C.lane;
    const int nitems = iend;
    float va[64], vb[64];
    bf16* dsta = nullptr; bf16* dstb = nullptr; int Ka = 0, Kb = 0;
#define CV_LOAD(V, R, DST, KK) do { const ConvItem it_ = conv_item(C, l, kind, (R), lane); DST = it_.dst; KK = it_.K; \
        _Pragma("unroll") for (int i = 0; i < 64; ++i) V[i] = it_.ok ? __builtin_nontemporal_load(it_.src + (size_t)i * it_.stride) : 0.f; } while (0)
#define CV_EMIT(DST, KK) do { const int c = lane & 7; \
        _Pragma("unroll") for (int j = 0; j < 8; ++j) { const int n = (lane >> 3) + 8 * j; const LAS float* s = scr + (8 * c) * 65 + n; \
            v4u o; o.x = cvtpk(s[0 * 65], s[1 * 65]); o.y = cvtpk(s[2 * 65], s[3 * 65]); o.z = cvtpk(s[4 * 65], s[5 * 65]); o.w = cvtpk(s[6 * 65], s[7 * 65]); \
            __builtin_nontemporal_store(o, (GAS v4u*)((DST) + (size_t)n * (KK) + 8 * c)); } \
        asm volatile("" ::: "memory"); } while (0)
    if (wi < nitems) CV_LOAD(va, wi, dsta, Ka);
    if (wi + wn < nitems) CV_LOAD(vb, wi + wn, dstb, Kb);
#pragma unroll 1
    for (int r = wi; r < nitems; r += 2 * wn) {
        {
#pragma unroll
            for (int i = 0; i < 64; ++i) scr[i * 65 + lane] = va[i];
            asm volatile("" ::: "memory");
            bf16* dst = dsta; const int K = Ka;
            if (r + 2 * wn < nitems) CV_LOAD(va, r + 2 * wn, dsta, Ka);
            CV_EMIT(dst, K);
        }
        if (r + wn < nitems) {
#pragma unroll
            for (int i = 0; i < 64; ++i) scr[i * 65 + lane] = vb[i];
            asm volatile("" ::: "memory");
            bf16* dst = dstb; const int K = Kb;
            if (r + 3 * wn < nitems) CV_LOAD(vb, r + 3 * wn, dstb, Kb);
            CV_EMIT(dst, K);
        }
    }
#undef CV_LOAD
#undef CV_EMIT
}
__device__ __forceinline__ int conv_units(int ll) { return ll == 0 ? 202 : 148; }
__device__ __forceinline__ void conv_unit(Ctx& C, int ll, int cu) {
    int l = ll, kind, r0;
    if (cu < 16) { kind = 1; r0 = cu * 64; } else if (cu < 104) { kind = 2; r0 = (cu - 16) * 64; } else if (cu < 148) { kind = 3; r0 = (cu - 104) * 64; } else { l = 1; kind = 0; r0 = (cu - 148) * 64; }
    conv_weights(C, l, kind, r0 + C.wave, r0 + 64, NWAVES);
}
__device__ __forceinline__ void p0_weights(Ctx& C) {
    const int wi = C.bid * NWAVES + C.wave, wn = C.G * NWAVES;
    conv_weights(C, 0, 0, wi, 108 * 32, wn);
}

__device__ __forceinline__ void p0_ada(Ctx& C) {
    KA_FRESH(C);
    LAS float* sc = (LAS float*)C.lds;
    __syncthreads();
    for (int k = C.tid; k < DM; k += NTHR) {
#pragma unroll
        for (int r = 0; r < 12; ++r) { const float c = (r < 4) ? C.in(2)[r * DM + k] : C.in(3)[(r - 4) * DM + k]; sc[k * 16 + r] = siluf_(c); }
    }
    __syncthreads();
    const int gw = C.bid * NWAVES + C.wave, NGW = C.G * NWAVES;
    for (int task = gw; task < 2 * 192 * 4; task += NGW) {
        const int l = task / 768, rem = task % 768, nb = rem % 192, ks = rem / 192;
        const int n = nb * 64 + C.lane;
        const float* w = C.in(12) + ((size_t)l * DM + ks * 512) * 12288 + n;
        typedef float f2a __attribute__((ext_vector_type(2)));
        f2a ac[6];
#pragma unroll
        for (int r = 0; r < 6; ++r) ac[r] = (f2a){0.f, 0.f};
#pragma unroll 1
        for (int kk = 0; kk < 512; kk += 64) {
        if (C.G == 256) __builtin_amdgcn_s_barrier();
#pragma unroll 8
        for (int k = kk; k < kk + 64; ++k) {
            const float wv = w[(size_t)k * 12288]; const f2a w2 = {wv, wv};
            const LAS f32x4* s = (const LAS f32x4*)(sc + (ks * 512 + k) * 16);
            const f32x4 s0 = s[0], s1 = s[1], s2 = s[2];
            ac[0] = __builtin_elementwise_fma((f2a){s0.x, s0.y}, w2, ac[0]); ac[1] = __builtin_elementwise_fma((f2a){s0.z, s0.w}, w2, ac[1]);
            ac[2] = __builtin_elementwise_fma((f2a){s1.x, s1.y}, w2, ac[2]); ac[3] = __builtin_elementwise_fma((f2a){s1.z, s1.w}, w2, ac[3]);
            ac[4] = __builtin_elementwise_fma((f2a){s2.x, s2.y}, w2, ac[4]); ac[5] = __builtin_elementwise_fma((f2a){s2.z, s2.w}, w2, ac[5]);
        }
        }
        float acc[12];
#pragma unroll
        for (int r = 0; r < 6; ++r) { acc[2 * r] = ac[r].x; acc[2 * r + 1] = ac[r].y; }
        float* mp = WSP(float, WS_MODP) + ((size_t)(l * 4 + ks) * 12) * 12288 + n;
#pragma unroll
        for (int r = 0; r < 12; ++r) mp[(size_t)r * 12288] = acc[r];
    }
    __syncthreads();
}

__device__ __forceinline__ void p0b_modreduce(Ctx& C) {
    KA_FRESH(C);
    const int gt = C.bid * NTHR + C.tid, NGT = C.G * NTHR;
    const float* mp = WSP(float, WS_MODP); float* md = WSP(float, WS_MOD);
    for (int e = gt; e < 2 * 12 * 12288; e += NGT) {
        const int l = e / (12 * 12288), rem = e % (12 * 12288), n = rem % 12288;
        float s = C.in(13)[l * 12288 + n];
#pragma unroll
        for (int ks = 0; ks < 4; ++ks) s += mp[(size_t)(l * 4 + ks) * 12 * 12288 + rem];
        md[e] = s;
    }
}

__device__ __forceinline__ void store_h_row(bf16* hrow, const f32x4 (&v)[8], float rs, const float* g, const float* scale, const float* shift, int lane) {
#pragma unroll
    for (int j = 0; j < 8; ++j) { const int e = 4 * lane + 256 * j;
        const f32x4 gg = *(const f32x4*)(g + e), sc = *(const f32x4*)(scale + e), sh = *(const f32x4*)(shift + e);
        const float a = v[j].x * rs * gg.x * (1.f + sc.x) + sh.x, b = v[j].y * rs * gg.y * (1.f + sc.y) + sh.y;
        const float c = v[j].z * rs * gg.z * (1.f + sc.z) + sh.z, d = v[j].w * rs * gg.w * (1.f + sc.w) + sh.w;
        v2u o; o.x = cvtpk(a, b); o.y = cvtpk(c, d); *(GAS v2u*)(hrow + e) = o; }
}
__device__ __forceinline__ int row_seq(int row) { return row < MP ? (row >> 11) : 4 + ((row - MP) >> 3); }

__device__ __forceinline__ void phase_n1(Ctx& C) {
    KA_FRESH(C);
    const int gw = C.bid * NWAVES + C.wave, NGW = C.G * NWAVES;
    f32x4 nx[8];
    if (gw < MR) { const float* xr = gw < MP ? C.in(0) + (size_t)gw * DM : C.in(1) + (size_t)(gw - MP) * DM;
#pragma unroll
        for (int j = 0; j < 8; ++j) nx[j] = *(const f32x4*)(xr + 4 * C.lane + 256 * j); }
    for (int row = gw; row < MR; row += NGW) {
        f32x4 v[8]; float ss = 0.f;
#pragma unroll
        for (int j = 0; j < 8; ++j) { v[j] = nx[j]; ss += v[j].x * v[j].x + v[j].y * v[j].y + v[j].z * v[j].z + v[j].w * v[j].w; }
        asm volatile("" ::: "memory");
        { const int nrow = row + NGW; if (nrow < MR) { const float* xr = nrow < MP ? C.in(0) + (size_t)nrow * DM : C.in(1) + (size_t)(nrow - MP) * DM;
#pragma unroll
            for (int j = 0; j < 8; ++j) nx[j] = *(const f32x4*)(xr + 4 * C.lane + 256 * j); } }
        const float rs = rsqrtf(wave_sum(ss) * (1.f / DM) + EPS);
        const float* md = WSP(float, WS_MOD) + (size_t)(0 * 12 + row_seq(row)) * 12288;
        store_h_row(WSP(bf16, WS_H) + (size_t)row * DM, v, rs, C.in(14), md + 1 * DM, md + 0 * DM, C.lane);
    }
}

constexpr size_t WS_X16 = WS_MIXO + 33 * MiB;
template <bool FIRST> struct ResidIn { v2u fp[8]; v2u xp[8]; };
template <> struct ResidIn<true> { v2u fp[8]; f32x4 xp[8]; };
template <bool FIRST>
__device__ __forceinline__ void resid_load(Ctx& C, int row, const bf16* src, const bf16* X16, ResidIn<FIRST>& in) {
#pragma unroll
    for (int j = 0; j < 8; ++j) in.fp[j] = *(const v2u*)(src + (size_t)row * DM + 4 * C.lane + 256 * j);
    if constexpr (FIRST) {
        const float* xin = row < MP ? C.in(0) + (size_t)row * DM : C.in(1) + (size_t)(row - MP) * DM;
#pragma unroll
        for (int j = 0; j < 8; ++j) in.xp[j] = *(const f32x4*)(xin + 4 * C.lane + 256 * j);
    } else {
#pragma unroll
        for (int j = 0; j < 8; ++j) in.xp[j] = *(const v2u*)(X16 + (size_t)row * DM + 4 * C.lane + 256 * j);
    }
}
template <bool FIRST>
__device__ __forceinline__ void resid_rows(Ctx& C, int l, int which, bool dry, int row_lo, int nrows) {
    const bf16* src = WSP(bf16, WS_MIXO);
    bf16* X16 = WSP(bf16, WS_X16);
    const bool last = (l == 1 && which == 1);
    const bool has_h = (which == 0) || (l == 0);
    const int s = row_seq(row_lo);
    const float* md = WSP(float, WS_MOD) + (size_t)(l * 12 + s) * 12288;
    f32x4 gg[8]; v2u hsp[8], hbp[8];
    {
        const float* gate = md + (which == 0 ? 2 : 5) * DM;
        const float* gpost = (which == 0 ? C.in(15) : C.in(17)) + l * DM;
        const float* gpre = (which == 0) ? C.in(16) + l * DM : C.in(14) + 1 * DM;
        const float* mdn = (which == 0) ? md : WSP(float, WS_MOD) + (size_t)(1 * 12 + s) * 12288;
        const float* scale = mdn + (which == 0 ? 4 : 1) * DM; const float* shift = mdn + (which == 0 ? 3 : 0) * DM;
#pragma unroll
        for (int j = 0; j < 8; ++j) { const int e = 4 * C.lane + 256 * j;
            gg[j] = *(const f32x4*)(gate + e) * *(const f32x4*)(gpost + e);
            if (has_h) { const f32x4 a = *(const f32x4*)(gpre + e) * (*(const f32x4*)(scale + e) + 1.0f), b = *(const f32x4*)(shift + e);
                hsp[j].x = cvtpk(a.x, a.y); hsp[j].y = cvtpk(a.z, a.w); hbp[j].x = cvtpk(b.x, b.y); hbp[j].y = cvtpk(b.z, b.w); } else { hsp[j] = (v2u){0u, 0u}; hbp[j] = hsp[j]; } }
    }
    ResidIn<FIRST> in;
    resid_load<FIRST>(C, row_lo, src, X16, in);
    bf16* Ho = dry ? WSP(bf16, WS_GV) : WSP(bf16, WS_H);
#pragma unroll 1
    for (int r = 0; r < nrows; ++r) {
        const int row = row_lo + r;
        f32x4 f[8], xv[8]; float ss = 0.f;
#pragma unroll
        for (int j = 0; j < 8; ++j) { f[j].x = bflo(in.fp[j].x); f[j].y = bfhi(in.fp[j].x); f[j].z = bflo(in.fp[j].y); f[j].w = bfhi(in.fp[j].y);
            if constexpr (FIRST) xv[j] = in.xp[j]; else { xv[j].x = bflo(in.xp[j].x); xv[j].y = bfhi(in.xp[j].x); xv[j].z = bflo(in.xp[j].y); xv[j].w = bfhi(in.xp[j].y); } }
        asm volatile("" ::: "memory");
        if constexpr (!FIRST) { if (r + 1 < nrows) resid_load<FIRST>(C, row + 1, src, X16, in); }
#pragma unroll
        for (int j = 0; j < 8; ++j) ss += f[j].x * f[j].x + f[j].y * f[j].y + f[j].z * f[j].z + f[j].w * f[j].w;
        const float rs = rsqrtf(wave_sum(ss) * (1.f / DM) + EPS);
        float ss2 = 0.f;
#pragma unroll
        for (int j = 0; j < 8; ++j) { const int e = 4 * C.lane + 256 * j;
            const f32x4 o = xv[j] + (f[j] * gg[j]) * rs;
            if (!dry) { if (last) *(f32x4*)(OUTB + O_Y + (size_t)row * DM + e) = o; else { v2u w; w.x = cvtpk(o.x, o.y); w.y = cvtpk(o.z, o.w); *(GAS v2u*)(X16 + (size_t)row * DM + e) = w; } }
            f[j] = o; ss2 += o.x * o.x + o.y * o.y + o.z * o.z + o.w * o.w; }
        if (has_h) {
            const float rs2 = rsqrtf(wave_sum(ss2) * (1.f / DM) + EPS);
#pragma unroll
            for (int j = 0; j < 8; ++j) { const int e = 4 * C.lane + 256 * j; const f32x4 hs = {bflo(hsp[j].x), bfhi(hsp[j].x), bflo(hsp[j].y), bfhi(hsp[j].y)}, hb = {bflo(hbp[j].x), bfhi(hbp[j].x), bflo(hbp[j].y), bfhi(hbp[j].y)};
                const f32x4 h = (f[j] * rs2) * hs + hb;
                v2u o; o.x = cvtpk(h.x, h.y); o.y = cvtpk(h.z, h.w); *(GAS v2u*)(Ho + (size_t)row * DM + e) = o; }
        }
        if constexpr (FIRST) { if (r + 1 < nrows) resid_load<FIRST>(C, row + 1, src, X16, in); }
    }
}
template <bool FIRST>
__device__ __forceinline__ void phase_resid_t(Ctx& C, int l, int which, bool dry) {
    KA_FRESH(C);
    const int gw = C.bid * NWAVES + C.wave, NGW = C.G * NWAVES;
#pragma unroll 1
    for (int r0 = 4 * gw; r0 < MP; r0 += 4 * NGW) resid_rows<FIRST>(C, l, which, dry, r0, 4);
    if (gw < MS) resid_rows<FIRST>(C, l, which, dry, MP + gw, 1);
}
__device__ __forceinline__ void phase_resid(Ctx& C, int l, int which, bool dry = false) {
    if (l == 0 && which == 0) phase_resid_t<true>(C, l, which, dry); else phase_resid_t<false>(C, l, which, dry);
}

struct EpiIn {
    static constexpr bool PERM = true, AFTER_DRAIN = false;
    bf16* P; float* out; int layer;
    __device__ __forceinline__ void operator()(const pg8::f32x4 (&acc)[2][2][4][2], const pg8::Unit& u, int wr, int wc, int fr, int fq) const {
        const int pn = u.pn; const int row0 = u.pm * 256 + wr * 64 + fr; const int col0 = pn * 256 + wc * 32 + 8 * fq;
        const float sc = (pn == 4 || pn == 5) ? QSCALE : 1.f;
        const bool kv = (pn >= 6 && pn <= 9); const bool isv = pn >= 8; const int cbase = isv ? C_V : C_K;
#pragma unroll
        for (int ai = 0; ai < 2; ++ai)
#pragma unroll
            for (int m = 0; m < 4; ++m) { const int row = row0 + ai * 128 + m * 16;
#pragma unroll
                for (int bj = 0; bj < 2; ++bj) { const int col = col0 + bj * 128;
                    const pg8::f32x4 v0 = acc[ai][bj][m][0] * sc, v1 = acc[ai][bj][m][1] * sc;
                    v4u w; w.x = cvtpk(v0[0], v0[1]); w.y = cvtpk(v0[2], v0[3]); w.z = cvtpk(v1[0], v1[1]); w.w = cvtpk(v1[2], v1[3]);
                    *(GAS v4u*)(P + (size_t)row * PP + col) = w;
                    if (kv && row < MR) {
                        float* o = (row < MP) ? out + (isv ? O_VP : O_KP) + (size_t)layer * 4194304 + (size_t)row * 512 + (col - cbase)
                                              : out + (isv ? O_VS : O_KS) + (size_t)layer * 32768 + (size_t)(row - MP) * 512 + (col - cbase);
                        *(pg8::f32x4*)o = v0; *(pg8::f32x4*)(o + 4) = v1; }
                } }
    }
};
struct EpiBf {
    static constexpr bool PERM = true, AFTER_DRAIN = false;
    bf16* O; int ldc;
    __device__ __forceinline__ void operator()(const pg8::f32x4 (&acc)[2][2][4][2], const pg8::Unit& u, int wr, int wc, int fr, int fq) const {
        const int row0 = u.pm * 256 + wr * 64 + fr; const int col0 = u.pn * 256 + wc * 32 + 8 * fq;
#pragma unroll
        for (int ai = 0; ai < 2; ++ai)
#pragma unroll
            for (int m = 0; m < 4; ++m) { const int row = row0 + ai * 128 + m * 16;
#pragma unroll
                for (int bj = 0; bj < 2; ++bj) { const int col = col0 + bj * 128;
                    const pg8::f32x4 v0 = acc[ai][bj][m][0], v1 = acc[ai][bj][m][1];
                    v4u w; w.x = cvtpk(v0[0], v0[1]); w.y = cvtpk(v0[2], v0[3]); w.z = cvtpk(v1[0], v1[1]); w.w = cvtpk(v1[2], v1[3]);
                    *(GAS v4u*)(O + (size_t)row * ldc + col) = w; } }
    }
};
struct EpiF32 {
    static constexpr bool PERM = true, AFTER_DRAIN = false;
    float* O; int ldc;
    __device__ __forceinline__ void operator()(const pg8::f32x4 (&acc)[2][2][4][2], const pg8::Unit& u, int wr, int wc, int fr, int fq) const {
        const int row0 = u.pm * 256 + wr * 64 + fr; const int col0 = u.pn * 256 + wc * 32 + 8 * fq;
#pragma unroll
        for (int ai = 0; ai < 2; ++ai)
#pragma unroll
            for (int m = 0; m < 4; ++m) { const int row = row0 + ai * 128 + m * 16;
#pragma unroll
                for (int bj = 0; bj < 2; ++bj) { float* o = O + (size_t)row * ldc + col0 + bj * 128;
                    *(pg8::f32x4*)o = acc[ai][bj][m][0]; *(pg8::f32x4*)(o + 4) = acc[ai][bj][m][1]; } }
    }
};

struct EpiAct {
    static constexpr bool PERM = true, AFTER_DRAIN = false;
    bf16* ACT; float* tailg; float* headg; float* headv; const float* cw; const float* cb;
    __device__ __forceinline__ void operator()(const pg8::f32x4 (&acc)[2][2][4][2], const pg8::Unit& u, int wr, int wc, int fr, int fq) const {
        const int j0 = u.pn * 128 + wc * 32 + 8 * fq;
        float w0[8], w1[8], w2[8], bb[8];
#pragma unroll
        for (int h = 0; h < 2; ++h) { const f32x4 a = *(const f32x4*)(cw + j0 + 4 * h), b = *(const f32x4*)(cw + DFF + j0 + 4 * h), c = *(const f32x4*)(cw + 2 * DFF + j0 + 4 * h), d = *(const f32x4*)(cb + j0 + 4 * h);
#pragma unroll
            for (int e = 0; e < 4; ++e) { w0[4 * h + e] = a[e]; w1[4 * h + e] = b[e]; w2[4 * h + e] = c[e]; bb[4 * h + e] = d[e]; } }
#pragma unroll
        for (int ai = 0; ai < 2; ++ai) {
            const int rbase = u.pm * 256 + ai * 128 + wr * 64; const int rb = rbase >> 6;
#pragma unroll
            for (int m = 0; m < 4; ++m) {
                const int row = rbase + 16 * m + fr;
                float o[8];
#pragma unroll
                for (int e = 0; e < 8; ++e) {
                    const float g = acc[ai][0][m][e >> 2][e & 3], v = acc[ai][1][m][e >> 2][e & 3];
                    const float gp = (m > 0) ? acc[ai][0][m > 0 ? m - 1 : 0][e >> 2][e & 3] : 0.f;
                    const float p1 = dppf<0x121>(g), p2 = dppf<0x122>(g), q1 = dppf<0x121>(gp), q2 = dppf<0x122>(gp);
                    const float g1 = fr >= 1 ? p1 : q1, g2 = fr >= 2 ? p2 : q2;
                    const float y = bb[e] + w0[e] * g2 + w1[e] * g1 + w2[e] * g;
                    o[e] = siluf_(y) * v;
                }
                if (m > 0 || fr >= 2) { v4u w; w.x = cvtpk(o[0], o[1]); w.y = cvtpk(o[2], o[3]); w.z = cvtpk(o[4], o[5]); w.w = cvtpk(o[6], o[7]); *(GAS v4u*)(ACT + (size_t)row * DFF + j0) = w; }
                if (m == 0 && fr < 2) { float* hg = headg + (size_t)(rb * 2 + fr) * DFF + j0; float* hv = headv + (size_t)(rb * 2 + fr) * DFF + j0;
                    *(pg8::f32x4*)hg = acc[ai][0][0][0]; *(pg8::f32x4*)(hg + 4) = acc[ai][0][0][1]; *(pg8::f32x4*)hv = acc[ai][1][0][0]; *(pg8::f32x4*)(hv + 4) = acc[ai][1][0][1]; }
                if (m == 3 && fr >= 14) { float* tg = tailg + (size_t)(rb * 2 + (fr - 14)) * DFF + j0; *(pg8::f32x4*)tg = acc[ai][0][3][0]; *(pg8::f32x4*)(tg + 4) = acc[ai][0][3][1]; }
            }
        }
    }
};

template <int MODE>
__device__ __forceinline__ void sample_gemm_unit(Ctx& C, const bf16* A  , const bf16* Bt  , int K, int n0, int layer) {
    const int lane = C.lane, m = lane & 31, kh = lane >> 5, wave = C.wave;
    const int kw = K >> 3;
    const bf16* a0 = A + (size_t)m * K + wave * kw + 8 * kh; const bf16* a1 = a0 + (size_t)32 * K;
    const bf16* b0 = Bt + (size_t)(n0 + m) * K + wave * kw + 8 * kh;
    f32x16 acc0, acc1;
#pragma unroll
    for (int r = 0; r < 16; ++r) { acc0[r] = 0.f; acc1[r] = 0.f; }
#pragma unroll 1
    for (int k = 0; k < kw; k += 256) {
        bf16x8 fa0[16], fa1[16], fb[16];
#pragma unroll
        for (int s = 0; s < 16; ++s) { const bool ok = k + 16 * s < kw; const int ko = ok ? k + 16 * s : 0;
            fa0[s] = *(const bf16x8*)(a0 + ko); fa1[s] = *(const bf16x8*)(a1 + ko); fb[s] = *(const bf16x8*)(b0 + ko);
            if (!ok) { fb[s] = (bf16x8){0, 0, 0, 0, 0, 0, 0, 0}; } }
#pragma unroll
        for (int s = 0; s < 16; ++s) { acc0 = __builtin_amdgcn_mfma_f32_32x32x16_bf16(fa0[s], fb[s], acc0, 0, 0, 0); acc1 = __builtin_amdgcn_mfma_f32_32x32x16_bf16(fa1[s], fb[s], acc1, 0, 0, 0); }
    }
    LAS float* red = (LAS float*)C.lds;
#pragma unroll
    for (int r = 0; r < 16; ++r) { red[(wave * 64 + crow(r, kh)) * 32 + m] = acc0[r]; red[(wave * 64 + 32 + crow(r, kh)) * 32 + m] = acc1[r]; }
    __syncthreads();
    const int row = C.tid >> 3, c4 = (C.tid & 7) * 4;
    f32x4 v = {0.f, 0.f, 0.f, 0.f};
#pragma unroll
    for (int w = 0; w < 8; ++w) { const f32x4 t = *(const LAS f32x4*)(red + (w * 64 + row) * 32 + c4); v += t; }
    const int n = n0 + c4; const int grow = MP + row;
    if (MODE == 0) {
        if (n >= C_Q && n < C_K) v *= QSCALE;
        v2u o; o.x = cvtpk(v.x, v.y); o.y = cvtpk(v.z, v.w);
        *(GAS v2u*)(WSP(bf16, WS_PROJ) + (size_t)grow * PP + n) = o;
        if (n >= C_K && n < C_GQ) { const bool isv = n >= C_V; float* op = OUTB + (isv ? O_VS : O_KS) + (size_t)layer * 32768 + (size_t)row * 512 + (n - (isv ? C_V : C_K)); *(f32x4*)op = v; }
    } else if (MODE == 1) {
        v2u o; o.x = cvtpk(v.x, v.y); o.y = cvtpk(v.z, v.w);
        *(GAS v2u*)(WSP(bf16, WS_MIXO) + (size_t)grow * DM + n) = o;
    } else {
        v2u o; o.x = cvtpk(v.x, v.y); o.y = cvtpk(v.z, v.w);
        *(GAS v2u*)(WSP(bf16, WS_GV) + (size_t)grow * DUP + n) = o;
    }
    __syncthreads();
}

__device__ __forceinline__ void lru_unit(Ctx& C, int l, int u) {
    KA_FRESH(C);
    int seq, t0, nt, T;
    if (u < 256) { seq = u >> 6; t0 = (u & 63) * 32; nt = 32; T = 2048; } else { seq = 4 + (u - 256); t0 = 0; nt = 8; T = 8; }
    const int d = C.tid, n = C.wave, dd = d & 63;
    const int row0 = seq_row0(seq);
    const bf16* P = WSP(bf16, WS_PROJ);
    LAS float* xs = (LAS float*)C.lds;
    const float cw0 = C.in(19)[(l * 4 + 0) * 512 + d], cw1 = C.in(19)[(l * 4 + 1) * 512 + d], cw2 = C.in(19)[(l * 4 + 2) * 512 + d], cw3 = C.in(19)[(l * 4 + 3) * 512 + d];
    const float cb = C.in(20)[l * 512 + d];
    float xm3, xm2, xm1;
    {
        float pre[3];
#pragma unroll
        for (int i = 0; i < 3; ++i) { const int tt = t0 - 3 + i;
            if (tt >= 0) pre[i] = bf2f(P[(size_t)(row0 + tt) * PP + C_AX + d]);
            else if (seq >= 4) pre[i] = C.in(7)[((size_t)(l * 8 + (seq - 4)) * 3 + (tt + 3)) * 512 + d];
            else pre[i] = 0.f; }
        xm3 = pre[0]; xm2 = pre[1]; xm1 = pre[2];
    }
    {
        float xv[32];
#pragma unroll
        for (int t = 0; t < 32; ++t) xv[t] = (t < nt) ? bf2f(P[(size_t)(row0 + t0 + t) * PP + C_AX + d]) : 0.f;
#pragma unroll
        for (int t = 0; t < 32; ++t) if (t < nt) {
            const float xt = xv[t];
            xs[t * 512 + d] = cb + cw0 * xm3 + cw1 * xm2 + cw2 * xm1 + cw3 * xt;
            xm3 = xm2; xm2 = xm1; xm1 = xt;
        }
    }
    if (t0 + nt == T) {
        float* o = (seq < 4) ? OUTB + O_LCP + (size_t)(l * 4 + seq) * 3 * 512 : OUTB + O_LCS + (size_t)(l * 8 + (seq - 4)) * 3 * 512;
        o[0 * 512 + d] = xm3; o[1 * 512 + d] = xm2; o[2 * 512 + d] = xm1;
    }
    const float br = C.in(22)[l * 512 + d], bi = C.in(24)[l * 512 + d];
    const float lam = C.in(25)[l * 512 + d];
    float L8L2 = -8.0f * softplusf_(-lam) * LOG2E;
    asm volatile("" : "+v"(L8L2) :: "memory");
    typedef float f2v __attribute__((ext_vector_type(2)));
    f2v wri[64];
    {
        const float* pr = C.in(21) + ((size_t)(l * 8 + n) * 64) * 64 + dd;
        const float* pi = C.in(23) + ((size_t)(l * 8 + n) * 64) * 64 + dd;
#pragma unroll
        for (int c = 0; c < 64; ++c) { wri[c].x = pr[c * 64]; wri[c].y = pi[c * 64]; }
    }
    __syncthreads();
    float h = 0.f, ap = 1.f;
    float* HL = WSP(float, WS_LH); float* AL = WSP(float, WS_LA);
    for (int t = 0; t < nt; ++t) {
        f2v a0 = {br, bi}, a1 = {0.f, 0.f};
        const LAS f32x4* xv = (const LAS f32x4*)(xs + t * 512 + n * 64);
#pragma unroll
        for (int c4 = 0; c4 < 16; ++c4) { const f32x4 v = xv[c4];
            a0 = __builtin_elementwise_fma((f2v){v.x, v.x}, wri[4 * c4], a0); a1 = __builtin_elementwise_fma((f2v){v.y, v.y}, wri[4 * c4 + 1], a1);
            a0 = __builtin_elementwise_fma((f2v){v.z, v.z}, wri[4 * c4 + 2], a0); a1 = __builtin_elementwise_fma((f2v){v.w, v.w}, wri[4 * c4 + 3], a1); }
        const float ar = a0.x + a1.x, ai = a0.y + a1.y;
        const float xc = xs[t * 512 + d];
        const float r = __builtin_amdgcn_rcpf(1.0f + __builtin_amdgcn_exp2f(-LOG2E * ar)), ig = __builtin_amdgcn_rcpf(1.0f + __builtin_amdgcn_exp2f(-LOG2E * ai));
        const float a = __builtin_amdgcn_exp2f(r * L8L2);
        const float uu = __builtin_amdgcn_sqrtf(fmaxf(1.0f - a * a, 0.f)) * (ig * xc);
        h = a * h + uu; ap *= a;
        const size_t off = (size_t)(row0 + t0 + t) * 512 + d;
        HL[off] = h; AL[off] = ap;
    }
    __syncthreads();
}

constexpr int GH_Q = 0, GH_K = 18224, GH_V = 36448, GH_L = 54672, GH_S = 72080, GH_BYTES = 73104;
static_assert(2 * GH_BYTES <= LDS_MISC, "gdn prep LDS");

__device__ __forceinline__ void gdn_prep_unit(Ctx& C, int l, int u) {
    KA_FRESH(C);
    int seq, chunk, hp, T;
    if (u < 512) { seq = u >> 7; chunk = (u >> 2) & 31; hp = u & 3; T = 2048; } else { const int v = u - 512; seq = 4 + (v >> 2); chunk = 0; hp = v & 3; T = 8; }
    const int hb = C.tid >> 8, ht = C.tid & 255, lane = C.lane;
    const int head = 2 * hp + hb;
    const int cid = (seq < 4) ? ((seq * 8 + head) * 32 + chunk) : (1024 + (seq - 4) * 8 + head);
    const int srow0 = seq_row0(seq);
    const int row0 = srow0 + chunk * 64;
    const int nvalid = (T - chunk * 64) < 64 ? (T - chunk * 64) : 64;
    const bf16* P = WSP(bf16, WS_PROJ);
    LAS unsigned char* hl = C.lds + hb * GH_BYTES;
    LAS bf16* Kimg = (LAS bf16*)(hl + GH_K); LAS bf16* Qimg = (LAS bf16*)(hl + GH_Q); LAS bf16* Vimg = (LAS bf16*)(hl + GH_V);
    LAS float* Lm = (LAS float*)(hl + GH_L);
    LAS float* s_gc = (LAS float*)(hl + GH_S); LAS float* s_beta = s_gc + 64; LAS float* s_eg = s_gc + 128;
    if (ht < 64) {
        const int t = ht; const bool valid = t < nvalid;
        float beta = 0.f, g = 0.f;
        if (valid) { const float cbv = bf2f(P[(size_t)(row0 + t) * PP + C_B + head]), cav = bf2f(P[(size_t)(row0 + t) * PP + C_A + head]);
            beta = sigmoidf_(cbv); g = -__expf(C.in(30)[l * 8 + head]) * softplusf_(cav + C.in(31)[l * 8 + head]); }
#pragma unroll
        for (int off = 1; off < 64; off <<= 1) { const float v = __shfl_up(g, off); if (lane >= off) g += v; }
        s_gc[t] = g; s_beta[t] = beta; s_eg[t] = __expf(g);
    }
    __syncthreads();
    const float gl = s_gc[63];
    {
        LAS float* wgt = (LAS float*)(hl + GH_L);
        {
            v4u xs[13];
#pragma unroll
            for (int i = 0; i < 13; ++i) {
                const int idx = ht + 256 * i; const int r = idx / 48, chn = idx % 48, part = chn >> 4, col = (chn & 15) * 8;
                const int tt = chunk * 64 - 3 + r;
                v4u x = {0u, 0u, 0u, 0u};
                if (idx < 67 * 48) {
                    if (tt >= 0) x = *(const v4u*)(P + (size_t)(srow0 + tt) * PP + C_GQ + part * 1024 + head * 128 + col);
                    else if (seq >= 4) { const float* bp = C.in(9) + ((size_t)(l * 8 + (seq - 4)) * 3 + (tt + 3)) * 3072 + part * 1024 + head * 128 + col;
                        x.x = cvtpk(bp[0], bp[1]); x.y = cvtpk(bp[2], bp[3]); x.z = cvtpk(bp[4], bp[5]); x.w = cvtpk(bp[6], bp[7]); }
                }
                xs[i] = x;
            }
#pragma unroll
            for (int i = 0; i < 13; ++i) {
                const int idx = ht + 256 * i; const int r = idx / 48, chn = idx % 48, part = chn >> 4, col = (chn & 15) * 8;
                if (idx < 67 * 48) *(LAS v4u*)((LAS bf16*)(hl + part * 18224) + r * 136 + col) = xs[i];
            }
        }
        for (int e = ht; e < 4 * 384; e += 256) { const int i = e / 384, cc = e % 384; wgt[e] = C.in(29)[(size_t)(l * 4 + i) * 3072 + (cc >> 7) * 1024 + head * 128 + (cc & 127)]; }
        __syncthreads();
        const int t = ht >> 2, cgp = ht & 3; const bool valid = t < nvalid;
#pragma unroll 1
        for (int part = 0; part < 3; ++part) {
            LAS bf16* reg = (LAS bf16*)(hl + part * 18224);
            float acc[32];
#pragma unroll
            for (int c = 0; c < 32; ++c) acc[c] = 0.f;
#pragma unroll
            for (int i = 0; i < 4; ++i) {
                const LAS v4u* rp = (const LAS v4u*)(reg + (t + i) * 136 + cgp * 32);
                const LAS f32x4* wp = (const LAS f32x4*)(wgt + i * 384 + part * 128 + cgp * 32);
#pragma unroll
                for (int q4 = 0; q4 < 4; ++q4) { const v4u x = rp[q4]; const f32x4 w0 = wp[2 * q4], w1 = wp[2 * q4 + 1];
                    acc[8 * q4 + 0] += w0.x * bflo(x.x); acc[8 * q4 + 1] += w0.y * bfhi(x.x); acc[8 * q4 + 2] += w0.z * bflo(x.y); acc[8 * q4 + 3] += w0.w * bfhi(x.y);
                    acc[8 * q4 + 4] += w1.x * bflo(x.z); acc[8 * q4 + 5] += w1.y * bfhi(x.z); acc[8 * q4 + 6] += w1.z * bflo(x.w); acc[8 * q4 + 7] += w1.w * bfhi(x.w); }
            }
            float ss = 0.f;
#pragma unroll
            for (int c = 0; c < 32; ++c) { const float v = valid ? siluf_(acc[c]) : 0.f; acc[c] = v; ss += v * v; }
            float scl = 1.f;
            if (part < 2) { ss += __shfl_xor(ss, 1); ss += __shfl_xor(ss, 2); scl = rsqrtf(ss + EPS); if (part == 0) scl *= 0.08838834764831845f; }
            v4u outp[4];
#pragma unroll
            for (int q4 = 0; q4 < 4; ++q4) {
                outp[q4].x = cvtpk(acc[8 * q4 + 0] * scl, acc[8 * q4 + 1] * scl); outp[q4].y = cvtpk(acc[8 * q4 + 2] * scl, acc[8 * q4 + 3] * scl);
                outp[q4].z = cvtpk(acc[8 * q4 + 4] * scl, acc[8 * q4 + 5] * scl); outp[q4].w = cvtpk(acc[8 * q4 + 6] * scl, acc[8 * q4 + 7] * scl); }
            __syncthreads();
#pragma unroll
            for (int q4 = 0; q4 < 4; ++q4) *(LAS v4u*)(reg + t * 136 + cgp * 32 + 8 * q4) = outp[q4];
        }
        if (chunk * 64 + 64 >= T) {
            float* o = (seq < 4) ? OUTB + O_GCP + (size_t)(l * 4 + seq) * 3 * 3072 : OUTB + O_GCS + (size_t)(l * 8 + (seq - 4)) * 3 * 3072;
            for (int e = ht; e < 3 * 384; e += 256) { const int i = e / 384, cc = e % 384, part = cc >> 7, c = cc & 127; const int col = part * 1024 + head * 128 + c;
                o[i * 3072 + col] = bf2f(P[(size_t)(srow0 + T - 3 + i) * PP + C_GQ + col]); }
        }
    }
    __syncthreads();
    {
        v4u* QEf = WSP(v4u, WS_QEF) + (size_t)cid * 1024; v4u* KDf = WSP(v4u, WS_KDF) + (size_t)cid * 1024;
#pragma unroll 1
        for (int f = 0; f < 4; ++f) {
            const int task = ht + 256 * f, frag = task >> 6, ln = task & 63, h = ln >> 5;
            {
                const int ti = frag >> 3, ks = frag & 7, tok = 32 * ti + (ln & 31), dkb = 32 * (ks >> 1) + 16 * (ks & 1) + 4 * h;
                const float sc = s_eg[tok];
                const v2u a = *(const LAS v2u*)(Qimg + tok * 136 + dkb), b = *(const LAS v2u*)(Qimg + tok * 136 + dkb + 8);
                v4u o; o.x = cvtpk(bflo(a.x) * sc, bfhi(a.x) * sc); o.y = cvtpk(bflo(a.y) * sc, bfhi(a.y) * sc); o.z = cvtpk(bflo(b.x) * sc, bfhi(b.x) * sc); o.w = cvtpk(bflo(b.y) * sc, bfhi(b.y) * sc);
                QEf[frag * 64 + ln] = o;
            }
            {
                const int dt = frag >> 2, ks2 = frag & 3, dk = 32 * dt + (ln & 31), tb = 32 * (ks2 >> 1) + 16 * (ks2 & 1) + 4 * h;
                float v[8];
#pragma unroll
                for (int j = 0; j < 8; ++j) { const int tok = tb + 8 * (j >> 2) + (j & 3); v[j] = bf2f(Kimg[tok * 136 + dk]) * __expf(gl - s_gc[tok]); }
                v4u o; o.x = cvtpk(v[0], v[1]); o.y = cvtpk(v[2], v[3]); o.z = cvtpk(v[4], v[5]); o.w = cvtpk(v[6], v[7]);
                KDf[frag * 64 + ln] = o;
            }
        }
    }
    {
        const int wv = ht >> 6, tj = wv >> 1, ti = wv & 1, m = lane & 31, kh = lane >> 5;
        f32x16 akk, aqk;
#pragma unroll
        for (int r = 0; r < 16; ++r) { akk[r] = 0.f; aqk[r] = 0.f; }
#pragma unroll
        for (int ks = 0; ks < 8; ++ks) {
            const bf16x8 a = *(const LAS bf16x8*)(Kimg + (32 * tj + m) * 136 + 16 * ks + 8 * kh);
            const bf16x8 bk = *(const LAS bf16x8*)(Kimg + (32 * ti + m) * 136 + 16 * ks + 8 * kh);
            const bf16x8 bq = *(const LAS bf16x8*)(Qimg + (32 * ti + m) * 136 + 16 * ks + 8 * kh);
            akk = __builtin_amdgcn_mfma_f32_32x32x16_bf16(a, bk, akk, 0, 0, 0);
            aqk = __builtin_amdgcn_mfma_f32_32x32x16_bf16(a, bq, aqk, 0, 0, 0);
        }
        const int i = 32 * ti + m; const float gci = s_gc[i], bi = s_beta[i];
        float lv[16], qv[16];
#pragma unroll
        for (int r = 0; r < 16; ++r) { const int j = 32 * tj + crow(r, kh); const float dec = __expf(fminf(gci - s_gc[j], 0.f));
            lv[r] = (i > j) ? bi * akk[r] * dec : 0.f; qv[r] = (i >= j) ? aqk[r] * dec : 0.f; }
#pragma unroll
        for (int rq = 0; rq < 4; ++rq) { f32x4 o; o.x = lv[4 * rq]; o.y = lv[4 * rq + 1]; o.z = lv[4 * rq + 2]; o.w = lv[4 * rq + 3];
            *(LAS f32x4*)(Lm + i * 68 + 32 * tj + 8 * rq + 4 * kh) = o; }
        v4u* QKf = WSP(v4u, WS_QKF) + (size_t)cid * 512;
#pragma unroll
        for (int s = 0; s < 2; ++s) { v4u o; o.x = cvtpk(qv[8 * s + 0], qv[8 * s + 1]); o.y = cvtpk(qv[8 * s + 2], qv[8 * s + 3]); o.z = cvtpk(qv[8 * s + 4], qv[8 * s + 5]); o.w = cvtpk(qv[8 * s + 6], qv[8 * s + 7]);
            QKf[(ti * 4 + 2 * tj + s) * 64 + lane] = o; }
    }
    __syncthreads();
    {
        const int c = ht;
        float sol[64];
#pragma unroll 1
        for (int r12 = 0; r12 < REPN(12); ++r12) {
        if (c < 128) {
#pragma unroll
            for (int i = 0; i < 64; ++i) sol[i] = bf2f(Vimg[i * 136 + c]) * s_beta[i];
        } else {
#pragma unroll
            for (int i = 0; i < 64; ++i) sol[i] = bf2f(Kimg[i * 136 + (c - 128)]) * (s_beta[i] * s_eg[i]);
        }
#pragma unroll
        for (int i = 1; i < 64; ++i) {
            float s = sol[i];
#pragma unroll
            for (int j4 = 0; j4 <= ((i - 1) >> 2); ++j4) { const f32x4 Lv = *(const LAS f32x4*)(Lm + i * 68 + 4 * j4);
                s -= Lv.x * sol[4 * j4]; if (4 * j4 + 1 < i) s -= Lv.y * sol[4 * j4 + 1]; if (4 * j4 + 2 < i) s -= Lv.z * sol[4 * j4 + 2]; if (4 * j4 + 3 < i) s -= Lv.w * sol[4 * j4 + 3]; }
            sol[i] = s;
        }
        }
        __syncthreads();
        if (c < 128) {
            const int ds = c >> 5, col = c & 31;
            bf16* Uf = WSP(bf16, WS_UF) + (size_t)cid * 8192;
#pragma unroll
            for (int a = 0; a < 8; ++a)
#pragma unroll
                for (int hi = 0; hi < 2; ++hi) { const int ti = a >> 2; v2u o; o.x = cvtpk(sol[8 * a + 4 * hi], sol[8 * a + 4 * hi + 1]); o.y = cvtpk(sol[8 * a + 4 * hi + 2], sol[8 * a + 4 * hi + 3]);
                    *(GAS v2u*)(Uf + ((size_t)((ds * 2 + ti) * 64 + col + 32 * hi)) * 16 + 4 * (a & 3)) = o; }
        } else {
            const int dk = c - 128;
#pragma unroll
            for (int i = 0; i < 64; ++i) Qimg[i * 136 + dk] = f2bf(-sol[i]);
        }
        if (ht == 0) WSP(float, WS_GL)[cid] = __expf(gl);
    }
    __syncthreads();
    {
        v4u* Wf = WSP(v4u, WS_WF) + (size_t)cid * 1024;
#pragma unroll 1
        for (int f = 0; f < 4; ++f) {
            const int task = ht + 256 * f, frag = task >> 6, ln = task & 63, h = ln >> 5;
            const int ti = frag >> 3, ks = frag & 7, tok = 32 * ti + (ln & 31), dkb = 32 * (ks >> 1) + 16 * (ks & 1) + 4 * h;
            const v2u a = *(const LAS v2u*)(Qimg + tok * 136 + dkb), b = *(const LAS v2u*)(Qimg + tok * 136 + dkb + 8);
            v4u o; o.x = a.x; o.y = a.y; o.z = b.x; o.w = b.y;
            Wf[frag * 64 + ln] = o;
        }
    }
    __syncthreads();
}

__device__ __forceinline__ void phase_act(Ctx& C, int l) {
    KA_FRESH(C);
    const bf16* GV = WSP(bf16, WS_GV); bf16* ACT = WSP(bf16, WS_ACT);
    const long gt = (long)C.bid * NTHR + C.tid, NGT = (long)C.G * NTHR;
    const float* cw = C.in(35) + (size_t)l * 3 * DFF; const float* cb = C.in(36) + (size_t)l * DFF;
    for (long it = gt; it < (long)MS * 704; it += NGT) {
        const int row = MP + (int)(it / 704), grp = (int)(it % 704);
        const int j0 = grp * 8; const int gcol = (j0 >> 7) * 256 + (j0 & 127);
        const int s = row_seq(row); const int t = row - seq_row0(s); const int T = 8;
        float x[3][8];
#pragma unroll
        for (int i = 0; i < 3; ++i) {
            const int tt = t - 2 + i;
            if (tt >= 0) { const v4u g = *(const v4u*)(GV + (size_t)(row - 2 + i) * DUP + gcol);
                x[i][0] = bflo(g.x); x[i][1] = bfhi(g.x); x[i][2] = bflo(g.y); x[i][3] = bfhi(g.y); x[i][4] = bflo(g.z); x[i][5] = bfhi(g.z); x[i][6] = bflo(g.w); x[i][7] = bfhi(g.w);
            } else { const float* bp = C.in(11) + ((size_t)(l * 8 + (s - 4)) * 2 + (tt + 2)) * DFF + j0;
#pragma unroll
                for (int e = 0; e < 8; ++e) x[i][e] = bp[e]; }
        }
        const v4u vv = *(const v4u*)(GV + (size_t)row * DUP + gcol + 128);
        const float val[8] = {bflo(vv.x), bfhi(vv.x), bflo(vv.y), bfhi(vv.y), bflo(vv.z), bfhi(vv.z), bflo(vv.w), bfhi(vv.w)};
        float o[8];
#pragma unroll
        for (int e = 0; e < 8; ++e) { const float y = cb[j0 + e] + cw[0 * DFF + j0 + e] * x[0][e] + cw[1 * DFF + j0 + e] * x[1][e] + cw[2 * DFF + j0 + e] * x[2][e]; o[e] = siluf_(y) * val[e]; }
        v4u w; w.x = cvtpk(o[0], o[1]); w.y = cvtpk(o[2], o[3]); w.z = cvtpk(o[4], o[5]); w.w = cvtpk(o[6], o[7]);
        *(GAS v4u*)(ACT + (size_t)row * DFF + j0) = w;
        if (t >= T - 2) {
            float* fo = OUTB + O_FCS + ((size_t)(l * 8 + (s - 4)) * 2 + (t - (T - 2))) * DFF + j0;
#pragma unroll
            for (int e = 0; e < 8; ++e) fo[e] = x[2][e];
        }
    }
    const float* TG = WSP(float, WS_TAILG); const float* HG = WSP(float, WS_HEADG); const float* HV = WSP(float, WS_HEADV);
    for (long it = gt; it < (long)256 * 704; it += NGT) {
        const int rr = (int)(it / 704), grp = (int)(it % 704), rb = rr >> 1, i = rr & 1, j0 = grp * 8;
        const bool first = (rb & 31) == 0;
        float g2[8], g1[8], g0[8], vv[8];
#pragma unroll
        for (int e = 0; e < 8; ++e) {
            const float t0 = first ? 0.f : TG[(size_t)((rb - 1) * 2 + 0) * DFF + j0 + e], t1 = first ? 0.f : TG[(size_t)((rb - 1) * 2 + 1) * DFF + j0 + e];
            const float h0 = HG[(size_t)(rb * 2 + 0) * DFF + j0 + e], h1 = HG[(size_t)(rb * 2 + 1) * DFF + j0 + e];
            g2[e] = i == 0 ? t0 : t1; g1[e] = i == 0 ? t1 : h0; g0[e] = i == 0 ? h0 : h1; vv[e] = HV[(size_t)(rb * 2 + i) * DFF + j0 + e];
        }
        float o[8];
#pragma unroll
        for (int e = 0; e < 8; ++e) { const float y = cb[j0 + e] + cw[0 * DFF + j0 + e] * g2[e] + cw[1 * DFF + j0 + e] * g1[e] + cw[2 * DFF + j0 + e] * g0[e]; o[e] = siluf_(y) * vv[e]; }
        v4u w; w.x = cvtpk(o[0], o[1]); w.y = cvtpk(o[2], o[3]); w.z = cvtpk(o[4], o[5]); w.w = cvtpk(o[6], o[7]);
        *(GAS v4u*)(ACT + (size_t)(rb * 64 + i) * DFF + j0) = w;
        if ((rb & 31) == 31) {
            float* fo = OUTB + O_FCP + ((size_t)(l * 4 + (rb >> 5)) * 2 + i) * DFF + j0;
#pragma unroll
            for (int e = 0; e < 8; ++e) fo[e] = TG[(size_t)(rb * 2 + i) * DFF + j0 + e];
        }
    }
}

struct FinIn { f32x4 hl[2], al[2]; v4u ag, oatt, og[2], z[2]; };
__device__ __forceinline__ void fin_load(Ctx& C, int row, FinIn& in, int lane) {
    const bf16* P = WSP(bf16, WS_PROJ);
    const float* hl = WSP(float, WS_LH) + (size_t)row * 512 + 8 * lane; const float* al = WSP(float, WS_LA) + (size_t)row * 512 + 8 * lane;
    in.hl[0] = *(const f32x4*)hl; in.hl[1] = *(const f32x4*)(hl + 4); in.al[0] = *(const f32x4*)al; in.al[1] = *(const f32x4*)(al + 4);
    in.ag = *(const v4u*)(P + (size_t)row * PP + C_AG + 8 * lane);
    in.oatt = (row < MP) ? *(const v4u*)(WSP(bf16, WS_OATT) + (size_t)row * 512 + 8 * lane) : (v4u){0u, 0u, 0u, 0u};
    const v4u* op = (const v4u*)(WSP(bf16, WS_OGDN) + (size_t)row * 1024 + 16 * lane); in.og[0] = op[0]; in.og[1] = op[1];
    const v4u* zp = (const v4u*)(P + (size_t)row * PP + C_Z + 16 * lane); in.z[0] = zp[0]; in.z[1] = zp[1];
}
__device__ __forceinline__ void phase_finalize(Ctx& C, int l) {
    KA_FRESH(C);
    const int gw = C.bid * NWAVES + C.wave, NGW = C.G * NWAVES, lane = C.lane;
    bf16* MIX = WSP(bf16, WS_MIX);
    float ga[8], gb[8], gc[16];
    {
        const float* pa = C.in(26) + l * 512 + 8 * lane; const float* pb = C.in(27) + l * 512 + 8 * lane; const float* pc = C.in(32) + l * 128 + ((16 * lane) & 127);
#pragma unroll
        for (int e = 0; e < 8; ++e) { ga[e] = pa[e]; gb[e] = pb[e]; }
#pragma unroll
        for (int e = 0; e < 16; ++e) gc[e] = pc[e];
    }
    FinIn in;
    if (gw < MR) fin_load(C, gw, in, lane);
    for (int row = gw; row < MR; row += NGW) {
        const int s = row_seq(row); const int t = row - seq_row0(s);
        const int chunk = t >> 5;
        const float* cr = WSP(float, WS_CARRY) + (size_t)(s * 64 + chunk) * 512 + 8 * lane;
        const f32x4 c0v = *(const f32x4*)cr, c1v = *(const f32x4*)(cr + 4);
        float y[8], o[8], og[16], zz[16];
        {
            const float hv[8] = {in.hl[0].x, in.hl[0].y, in.hl[0].z, in.hl[0].w, in.hl[1].x, in.hl[1].y, in.hl[1].z, in.hl[1].w};
            const float av[8] = {in.al[0].x, in.al[0].y, in.al[0].z, in.al[0].w, in.al[1].x, in.al[1].y, in.al[1].z, in.al[1].w};
            const float cv[8] = {c0v.x, c0v.y, c0v.z, c0v.w, c1v.x, c1v.y, c1v.z, c1v.w};
            const float gv[8] = {bflo(in.ag.x), bfhi(in.ag.x), bflo(in.ag.y), bfhi(in.ag.y), bflo(in.ag.z), bfhi(in.ag.z), bflo(in.ag.w), bfhi(in.ag.w)};
#pragma unroll
            for (int e = 0; e < 8; ++e) { const float h = hv[e] + av[e] * cv[e]; y[e] = h * gelu_tanh(gv[e]); }
            o[0] = bflo(in.oatt.x); o[1] = bfhi(in.oatt.x); o[2] = bflo(in.oatt.y); o[3] = bfhi(in.oatt.y); o[4] = bflo(in.oatt.z); o[5] = bfhi(in.oatt.z); o[6] = bflo(in.oatt.w); o[7] = bfhi(in.oatt.w);
#pragma unroll
            for (int h2 = 0; h2 < 2; ++h2) { const v4u a = in.og[h2], b = in.z[h2];
                og[8 * h2 + 0] = bflo(a.x); og[8 * h2 + 1] = bfhi(a.x); og[8 * h2 + 2] = bflo(a.y); og[8 * h2 + 3] = bfhi(a.y); og[8 * h2 + 4] = bflo(a.z); og[8 * h2 + 5] = bfhi(a.z); og[8 * h2 + 6] = bflo(a.w); og[8 * h2 + 7] = bfhi(a.w);
                zz[8 * h2 + 0] = bflo(b.x); zz[8 * h2 + 1] = bfhi(b.x); zz[8 * h2 + 2] = bflo(b.y); zz[8 * h2 + 3] = bfhi(b.y); zz[8 * h2 + 4] = bflo(b.z); zz[8 * h2 + 5] = bfhi(b.z); zz[8 * h2 + 6] = bflo(b.w); zz[8 * h2 + 7] = bfhi(b.w); }
        }
        asm volatile("" ::: "memory");
        const int nrow = row + NGW;
        if (nrow < MR) fin_load(C, nrow, in, lane);
        {
            float ss = 0.f;
#pragma unroll
            for (int e = 0; e < 8; ++e) ss += y[e] * y[e];
            const float rs = rsqrtf(wave_sum(ss) * (1.f / 512.f) + EPS);
            v4u w; w.x = cvtpk(y[0] * rs * ga[0], y[1] * rs * ga[1]); w.y = cvtpk(y[2] * rs * ga[2], y[3] * rs * ga[3]); w.z = cvtpk(y[4] * rs * ga[4], y[5] * rs * ga[5]); w.w = cvtpk(y[6] * rs * ga[6], y[7] * rs * ga[7]);
            *(GAS v4u*)(MIX + (size_t)row * DM + 8 * lane) = w;
        }
        {
            if (row >= MP) {
                const int b = (row - MP) >> 3, q = (row - MP) & 7, head = lane >> 3, dd = 8 * (lane & 7), bh = b * 8 + head;
                const float* spo = WSP(float, WS_SPO); const float* spt = WSP(float, WS_SPT);
                float R = 1.f;
#pragma unroll
                for (int e = 0; e < 8; ++e) o[e] = 0.f;
                const float* tp = spt + (size_t)(bh * 33) * 8 + q; const float* pb = spo + ((size_t)(bh * 33) * 8 + q) * 64 + dd;
#pragma unroll 1
                for (int rb = 22; rb >= 0; rb -= 11) {
                    float t[11]; f32x4 p0[11], p1[11];
#pragma unroll
                    for (int i = 0; i < 11; ++i) { t[i] = tp[(rb + i) * 8]; p0[i] = *(const f32x4*)(pb + (size_t)(rb + i) * 512); p1[i] = *(const f32x4*)(pb + (size_t)(rb + i) * 512 + 4); }
#pragma unroll
                    for (int i = 10; i >= 0; --i) {
                        o[0] += R * p0[i].x; o[1] += R * p0[i].y; o[2] += R * p0[i].z; o[3] += R * p0[i].w; o[4] += R * p1[i].x; o[5] += R * p1[i].y; o[6] += R * p1[i].z; o[7] += R * p1[i].w;
                        R *= t[i];
                    }
                }
            }
            float ss = 0.f;
#pragma unroll
            for (int e = 0; e < 8; ++e) ss += o[e] * o[e];
            const float rs = rsqrtf(wave_sum(ss) * (1.f / 512.f) + EPS);
            v4u w; w.x = cvtpk(o[0] * rs * gb[0], o[1] * rs * gb[1]); w.y = cvtpk(o[2] * rs * gb[2], o[3] * rs * gb[3]); w.z = cvtpk(o[4] * rs * gb[4], o[5] * rs * gb[5]); w.w = cvtpk(o[6] * rs * gb[6], o[7] * rs * gb[7]);
            *(GAS v4u*)(MIX + (size_t)row * DM + 512 + 8 * lane) = w;
        }
        {
            float ss = 0.f;
#pragma unroll
            for (int e = 0; e < 16; ++e) ss += og[e] * og[e];
            ss += __shfl_xor(ss, 1); ss += __shfl_xor(ss, 2); ss += __shfl_xor(ss, 4);
            const float rs = rsqrtf(ss * (1.f / 128.f) + EPS);
            float yc[16];
#pragma unroll
            for (int e = 0; e < 16; ++e) yc[e] = og[e] * rs * gc[e] * siluf_(zz[e]);
            v4u w0, w1; w0.x = cvtpk(yc[0], yc[1]); w0.y = cvtpk(yc[2], yc[3]); w0.z = cvtpk(yc[4], yc[5]); w0.w = cvtpk(yc[6], yc[7]);
            w1.x = cvtpk(yc[8], yc[9]); w1.y = cvtpk(yc[10], yc[11]); w1.z = cvtpk(yc[12], yc[13]); w1.w = cvtpk(yc[14], yc[15]);
            *(GAS v4u*)(MIX + (size_t)row * DM + 1024 + 16 * lane) = w0; *(GAS v4u*)(MIX + (size_t)row * DM + 1024 + 16 * lane + 8) = w1;
        }
    }
}

template <bool MASK>
__device__ __forceinline__ void sb_core(const bf16x8 (&kf)[4], const bf16x8 (&qf)[4], float bias2, int kbase, int qpos, int hi, float& R, v4u (&pw)[2]) {
    f32x16 p;
#pragma unroll
    for (int r = 0; r < 16; ++r) p[r] = bias2;
#pragma unroll
    for (int ks = 0; ks < 4; ++ks) p = __builtin_amdgcn_mfma_f32_32x32x16_bf16(kf[ks], qf[ks], p, 0, 0, 0);
    float w[16];
    float L = 1.f;
#pragma unroll
    for (int r = 0; r < 16; ++r) {
        float e = __builtin_amdgcn_exp2f(__builtin_amdgcn_fmed3f(p[r], -126.f, 7.f));
        if (MASK) { if (kbase + 16 * hi + r >= qpos) e = 0.f; }
        w[r] = e * L; L *= (1.f + e);
    }
    const float Pr = __builtin_amdgcn_rcpf(L);
    const float other = __shfl_xor(Pr, 32);
    const float F = (hi ? R : R * other) * Pr;
    R = R * Pr * other;
#pragma unroll
    for (int s = 0; s < 2; ++s) {
        pw[s].x = cvtpk(w[8 * s + 0] * F, w[8 * s + 1] * F); pw[s].y = cvtpk(w[8 * s + 2] * F, w[8 * s + 3] * F); pw[s].z = cvtpk(w[8 * s + 4] * F, w[8 * s + 5] * F); pw[s].w = cvtpk(w[8 * s + 6] * F, w[8 * s + 7] * F);
    }
}
__device__ __forceinline__ void sb_pv(f32x16 (&o)[2], const v4u (&pw)[2], const bf16x8 (&vf)[2][2]) {
#pragma unroll
    for (int dt = 0; dt < 2; ++dt)
#pragma unroll
        for (int st = 0; st < 2; ++st) o[dt] = __builtin_amdgcn_mfma_f32_32x32x16_bf16(__builtin_bit_cast(bf16x8, pw[st]), vf[dt][st], o[dt], 0, 0, 0);
}
constexpr int VT_PITCH = 72, VT_BYTES = 2 * 32 * VT_PITCH * 2;
struct RawBf { v4u k[4]; v4u v[4]; };
struct RawF32 { f32x4 k[8]; f32x4 v[8]; };
__device__ __forceinline__ void raw_load_bf16(RawBf& t, const bf16* Kb, const bf16* Vb, int pitch, int tile_base, int maxrow, int lane) {
#pragma unroll
    for (int i = 0; i < 4; ++i) { int row = tile_base + 8 * i + (lane >> 3); row = row > maxrow ? maxrow : row;
        t.k[i] = *(const v4u*)(Kb + (size_t)row * pitch + 8 * (lane & 7)); t.v[i] = *(const v4u*)(Vb + (size_t)row * pitch + 8 * (lane & 7)); }
}
__device__ __forceinline__ void raw_load_f32(RawF32& t, const float* Kt, const float* Vt, int lane) {
#pragma unroll
    for (int i = 0; i < 8; ++i) { t.k[i] = *(const f32x4*)(Kt + (size_t)(4 * i + (lane >> 4)) * 512 + 4 * (lane & 15)); t.v[i] = *(const f32x4*)(Vt + (size_t)(4 * i + (lane >> 4)) * 512 + 4 * (lane & 15)); }
}
__device__ __forceinline__ void vfrags_from_lds(const LAS bf16* vt, bf16x8 (&vf)[2][2], int lane) {
    typedef short s16x4v __attribute__((ext_vector_type(4)));
    const int g16 = lane >> 4, q = (lane & 15) >> 2, p = lane & 3, kh = g16 >> 1, cg = g16 & 1;
    const LAS bf16* base = vt + (16 * kh + q) * VT_PITCH + 16 * cg + 4 * p;
#pragma unroll
    for (int st = 0; st < 2; ++st)
#pragma unroll
        for (int dt = 0; dt < 2; ++dt) {
            const s16x4v lo = __builtin_bit_cast(s16x4v, __builtin_amdgcn_ds_read_tr16_b64_v4i16((LAS s16x4v*)(base + (8 * st + 0) * VT_PITCH + 32 * dt)));
            const s16x4v hi = __builtin_bit_cast(s16x4v, __builtin_amdgcn_ds_read_tr16_b64_v4i16((LAS s16x4v*)(base + (8 * st + 4) * VT_PITCH + 32 * dt)));
            vf[dt][st] = (bf16x8){lo[0], lo[1], lo[2], lo[3], hi[0], hi[1], hi[2], hi[3]};
        }
}
__device__ __forceinline__ void kfrags_from_lds(const LAS bf16* kt, bf16x8 (&kf)[4], int lane) {
    const int m = lane & 31, kh = lane >> 5;
    const LAS bf16* kp = kt + (16 * ((m >> 2) & 1) + (m & 3) + 4 * (m >> 3)) * VT_PITCH + 8 * kh;
#pragma unroll
    for (int ks = 0; ks < 4; ++ks) kf[ks] = *(const LAS bf16x8*)(kp + 16 * ks);
}
__device__ __forceinline__ void stage_bf16(const RawBf& t, LAS bf16* vt, bf16x8 (&kf)[4], int lane) {
    LAS bf16* kt = vt + 32 * VT_PITCH;
#pragma unroll
    for (int i = 0; i < 4; ++i) { *(LAS v4u*)(kt + (8 * i + (lane >> 3)) * VT_PITCH + 8 * (lane & 7)) = t.k[i]; *(LAS v4u*)(vt + (8 * i + (lane >> 3)) * VT_PITCH + 8 * (lane & 7)) = t.v[i]; }
    kfrags_from_lds(kt, kf, lane);
}
__device__ __forceinline__ void stage_f32(const RawF32& t, LAS bf16* vt, bf16x8 (&kf)[4], int lane) {
    LAS bf16* kt = vt + 32 * VT_PITCH;
#pragma unroll
    for (int i = 0; i < 8; ++i) { v2u w; w.x = cvtpk(t.k[i].x, t.k[i].y); w.y = cvtpk(t.k[i].z, t.k[i].w); *(LAS v2u*)(kt + (4 * i + (lane >> 4)) * VT_PITCH + 4 * (lane & 15)) = w;
        v2u u; u.x = cvtpk(t.v[i].x, t.v[i].y); u.y = cvtpk(t.v[i].z, t.v[i].w); *(LAS v2u*)(vt + (4 * i + (lane >> 4)) * VT_PITCH + 4 * (lane & 15)) = u; }
    kfrags_from_lds(kt, kf, lane);
}
template <bool MASK>
__device__ __forceinline__ void sb_compute(const bf16x8 (&kf)[4], const LAS bf16* vt, int tile_base, const bf16x8 (&qf)[4], float bias2, int qpos, int lane, float& R, f32x16 (&o)[2]) {
    v4u pw[2];
    sb_core<MASK>(kf, qf, bias2, tile_base, qpos, lane >> 5, R, pw);
    bf16x8 vf[2][2];
    vfrags_from_lds(vt, vf, lane);
    sb_pv(o, pw, vf);
}

constexpr int NATT_S = 64 * 33, NATT = NATT_S + 2048;
constexpr int SG_BYTES = 2 * 64 * VT_PITCH * 2;
struct RawG { f32x4 k[16]; f32x4 v[16]; };
__device__ __forceinline__ void rawg_load(RawG& t, const float* Kt, const float* Vt, int lane) {
#pragma unroll
    for (int i = 0; i < 16; ++i) { t.k[i] = *(const f32x4*)(Kt + (size_t)(4 * i + (lane >> 4)) * 512 + 4 * (lane & 15)); t.v[i] = *(const f32x4*)(Vt + (size_t)(4 * i + (lane >> 4)) * 512 + 4 * (lane & 15)); }
}
__device__ __forceinline__ void rawg_stage(const RawG& t, LAS bf16* vt, int lane) {
    LAS bf16* kt = vt + 64 * VT_PITCH;
#pragma unroll
    for (int i = 0; i < 16; ++i) { v2u w; w.x = cvtpk(t.k[i].x, t.k[i].y); w.y = cvtpk(t.k[i].z, t.k[i].w); *(LAS v2u*)(kt + (4 * i + (lane >> 4)) * VT_PITCH + 4 * (lane & 15)) = w;
        v2u u; u.x = cvtpk(t.v[i].x, t.v[i].y); u.y = cvtpk(t.v[i].z, t.v[i].w); *(LAS v2u*)(vt + (4 * i + (lane >> 4)) * VT_PITCH + 4 * (lane & 15)) = u; }
}
template <bool MASK>
__device__ __forceinline__ void sb16(const LAS bf16* vth, const LAS bf16* kth, const bf16x8 (&qf)[2], float bias2, int kbase, int qpos, int lane, float& R, f32x4 (&o)[4]) {
    typedef short s16x4v __attribute__((ext_vector_type(4)));
    const int i = lane & 15, g = lane >> 4;
    f32x4 p[2];
    {
        bf16x8 kf[2][2];
        const LAS bf16* kp = kth + (8 * (i >> 2) + (i & 3)) * VT_PITCH + 8 * g;
#pragma unroll
        for (int j2 = 0; j2 < 2; ++j2)
#pragma unroll
            for (int ks = 0; ks < 2; ++ks) kf[j2][ks] = *(const LAS bf16x8*)(kp + 4 * j2 * VT_PITCH + 32 * ks);
#pragma unroll
        for (int j2 = 0; j2 < 2; ++j2) { p[j2] = (f32x4){bias2, bias2, bias2, bias2};
#pragma unroll
            for (int ks = 0; ks < 2; ++ks) p[j2] = __builtin_amdgcn_mfma_f32_16x16x32_bf16(kf[j2][ks], qf[ks], p[j2], 0, 0, 0); }
    }
    float w[8]; float L = 1.f;
#pragma unroll
    for (int x = 0; x < 8; ++x) {
        float e = __builtin_amdgcn_exp2f(__builtin_amdgcn_fmed3f(p[x >> 2][x & 3], -126.f, 7.f));
        if (MASK) { if (kbase + 8 * g + x >= qpos) e = 0.f; }
        w[x] = e * L; L *= (1.f + e);
    }
    const float Pr = __builtin_amdgcn_rcpf(L);
    const float a = __shfl_xor(Pr, 16); const float pp = Pr * a; const float b = __shfl_xor(pp, 32);
    const float suf = (g == 3) ? 1.f : (g == 2) ? a : (g == 1) ? b : a * b;
    const float F = R * suf * Pr;
    R = R * pp * b;
    v4u pw; pw.x = cvtpk(w[0] * F, w[1] * F); pw.y = cvtpk(w[2] * F, w[3] * F); pw.z = cvtpk(w[4] * F, w[5] * F); pw.w = cvtpk(w[6] * F, w[7] * F);
    const LAS bf16* vb = vth + (8 * g + ((lane & 15) >> 2)) * VT_PITCH + 4 * (lane & 3);
#pragma unroll
    for (int dt = 0; dt < 4; ++dt) {
        const s16x4v lo = __builtin_bit_cast(s16x4v, __builtin_amdgcn_ds_read_tr16_b64_v4i16((LAS s16x4v*)(vb + 16 * dt)));
        const s16x4v hi = __builtin_bit_cast(s16x4v, __builtin_amdgcn_ds_read_tr16_b64_v4i16((LAS s16x4v*)(vb + 4 * VT_PITCH + 16 * dt)));
        const bf16x8 vf = (bf16x8){lo[0], lo[1], lo[2], lo[3], hi[0], hi[1], hi[2], hi[3]};
        o[dt] = __builtin_amdgcn_mfma_f32_16x16x32_bf16(vf, __builtin_bit_cast(bf16x8, pw), o[dt], 0, 0, 0);
    }
}
__device__ __forceinline__ void team_barrier(volatile LAS unsigned* tb, unsigned& kb);
__device__ __forceinline__ void attn_unit(Ctx& C, int l, int a, LAS bf16* vt, volatile LAS unsigned* tb, unsigned& kbar) {
    KA_FRESH(C);
    const int lane = C.lane, q = lane & 15, g = lane >> 4;
    const bf16* P = WSP(bf16, WS_PROJ);
    f32x4 o[4];
#pragma unroll
    for (int dt = 0; dt < 4; ++dt) o[dt] = (f32x4){0.f, 0.f, 0.f, 0.f};
    float R = 1.f;
    const int head = a & 7, b = (a >> 3) & 7, rg = a >> 6, bh = b * 8 + head;
    const float bias2 = C.in(28)[l * 8 + head] * LOG2E;
    const int row0 = MP + 8 * b;
    bf16x8 qf[2];
    { const int qr = q < 8 ? q : 7; const bf16* qp = P + (size_t)(row0 + qr) * PP + C_Q + 64 * head + 8 * g;
#pragma unroll
      for (int ks = 0; ks < 2; ++ks) { v4u x = *(const v4u*)(qp + 32 * ks); if (q >= 8) { x.x = 0u; x.y = 0u; x.z = 0u; x.w = 0u; } qf[ks] = __builtin_bit_cast(bf16x8, x); } }
    LAS bf16* kt = vt + 64 * VT_PITCH;
    if (rg < 32) {
        const int* pt = (const int*)C.in(6) + b * 128;
        const float* ck = C.in(4) + (size_t)l * 1280 * 128 * 512 + 64 * head; const float* cv = C.in(5) + (size_t)l * 1280 * 128 * 512 + 64 * head;
        RawG ra;
        const int p0 = __builtin_amdgcn_readfirstlane(pt[4 * rg + 0]), p1 = __builtin_amdgcn_readfirstlane(pt[4 * rg + 1]), p2 = __builtin_amdgcn_readfirstlane(pt[4 * rg + 2]), p3 = __builtin_amdgcn_readfirstlane(pt[4 * rg + 3]);
#define GOFF(j) (((size_t)(((j) >> 1) == 0 ? p0 : ((j) >> 1) == 1 ? p1 : ((j) >> 1) == 2 ? p2 : p3) * 128 + ((j) & 1) * 64) * 512)
        { const size_t off = GOFF(7); rawg_load(ra, ck + off, cv + off, lane); }
#pragma unroll 1
        for (int j = 7; j >= 0; --j) {
            team_barrier(tb, kbar);
            rawg_stage(ra, vt, lane);
            asm volatile("" ::: "memory");
            if (j > 0) { const size_t off = GOFF(j - 1); rawg_load(ra, ck + off, cv + off, lane); }
            sb16<false>(vt + 32 * VT_PITCH, kt + 32 * VT_PITCH, qf, bias2, 0, 0x7fffffff, lane, R, o);
            sb16<false>(vt, kt, qf, bias2, 0, 0x7fffffff, lane, R, o);
        }
#undef GOFF
    } else {
        RawBf cur; raw_load_bf16(cur, P + (size_t)row0 * PP + C_K + 64 * head, P + (size_t)row0 * PP + C_V + 64 * head, PP, 0, 7, lane);
#pragma unroll
        for (int i = 0; i < 4; ++i) { *(LAS v4u*)(kt + (8 * i + (lane >> 3)) * VT_PITCH + 8 * (lane & 7)) = cur.k[i]; *(LAS v4u*)(vt + (8 * i + (lane >> 3)) * VT_PITCH + 8 * (lane & 7)) = cur.v[i]; }
        sb16<true>(vt, kt, qf, bias2, 0, q, lane, R, o);
    }
    float* spo = WSP(float, WS_SPO) + (size_t)(bh * 33 + rg) * 8 * 64; float* spt = WSP(float, WS_SPT) + (size_t)(bh * 33 + rg) * 8;
    if (q < 8) {
#pragma unroll
        for (int dt = 0; dt < 4; ++dt) *(f32x4*)(spo + q * 64 + 16 * dt + 4 * g) = o[dt];
    }
    if (lane < 8) spt[lane] = R;
}

constexpr int PB_SLOT = 2 * 32 * VT_PITCH * 2;
__device__ __forceinline__ void team_barrier(volatile LAS unsigned* tb, unsigned& kb) {
    kb += 1u;
    const unsigned target = 4u * kb;
    const unsigned addr = (unsigned)(uintptr_t)tb;
    unsigned tmp, sc, cnt; unsigned long long sv;
    asm volatile(
        "s_waitcnt lgkmcnt(0)\n\t"
        "s_mov_b64 %[sv], exec\n\t"
        "s_mov_b64 exec, 1\n\t"
        "ds_add_u32 %[addr], %[one]\n\t"
        "s_mov_b64 exec, %[sv]\n\t"
        "s_mov_b32 %[cnt], 0\n\t"
        "1:\n\t"
        "ds_read_b32 %[tmp], %[addr]\n\t"
        "s_waitcnt lgkmcnt(0)\n\t"
        "v_readfirstlane_b32 %[sc], %[tmp]\n\t"
        "s_cmp_ge_u32 %[sc], %[target]\n\t"
        "s_cbranch_scc1 2f\n\t"
        "s_add_u32 %[cnt], %[cnt], 1\n\t"
        "s_cmp_gt_u32 %[cnt], 0x2000000\n\t"
        "s_cbranch_scc1 2f\n\t"
        "s_sleep 1\n\t"
        "s_branch 1b\n\t"
        "2:\n\t"
        : [tmp] "=&v"(tmp), [sc] "=&s"(sc), [cnt] "=&s"(cnt), [sv] "=&s"(sv)
        : [addr] "v"(addr), [one] "v"(1u), [target] "s"(target)
        : "memory", "scc");
}
__device__ __forceinline__ void prompt_team_unit(Ctx& C, int l, int u, LAS bf16* ring, volatile LAS unsigned* tb, unsigned& kb) {
    KA_FRESH(C);
    const int lane = C.lane, m = lane & 31, kh = lane >> 5, w4 = C.wave & 3;
    const int qb = 15 - (u >> 5), sh = u & 31, seq = sh >> 3, head = sh & 7;
    const int g = 4 * qb + w4, T0 = 4 * qb + 3;
    const bf16* P = WSP(bf16, WS_PROJ);
    const float bias2 = C.in(28)[l * 8 + head] * LOG2E;
    const int row0 = seq * 2048;
    bf16x8 qf[4];
    { const bf16* qp = P + (size_t)(row0 + 32 * g + m) * PP + C_Q + 64 * head + 8 * kh;
#pragma unroll
      for (int ks = 0; ks < 4; ++ks) qf[ks] = *(const bf16x8*)(qp + 16 * ks); }
    const int tt = C.tid & 255, lrow = tt >> 3, lch = tt & 7;
    const bf16* srck = P + (size_t)row0 * PP + C_K + 64 * head + 8 * lch; const bf16* srcv = P + (size_t)row0 * PP + C_V + 64 * head + 8 * lch;
    const int ldst = lrow * VT_PITCH + 8 * lch;
    const int qpos = 32 * g + m;
    f32x16 o[2];
#pragma unroll
    for (int r = 0; r < 16; ++r) { o[0][r] = 0.f; o[1][r] = 0.f; }
    float R = 1.f;
#define PT_LDK(t) (*(const v4u*)(srck + (size_t)(32 * ((t) > 0 ? (t) : 0) + lrow) * PP))
#define PT_LDV(t) (*(const v4u*)(srcv + (size_t)(32 * ((t) > 0 ? (t) : 0) + lrow) * PP))
    v4u rak = PT_LDK(T0), rav = PT_LDV(T0), rbk = PT_LDK(T0 - 1), rbv = PT_LDV(T0 - 1);
#pragma unroll 1
    for (int t = T0; t >= 0; t -= 2) {
        *(LAS v4u*)(ring + 32 * VT_PITCH + ldst) = rak; *(LAS v4u*)(ring + ldst) = rav;
        rak = PT_LDK(t - 2); rav = PT_LDV(t - 2);
        team_barrier(tb, kb);
        if (t <= g) {
            LAS bf16* vt = ring; bf16x8 kf[4]; kfrags_from_lds(vt + 32 * VT_PITCH, kf, lane);
            if (t == g) sb_compute<true>(kf, vt, 32 * t, qf, bias2, qpos, lane, R, o); else sb_compute<false>(kf, vt, 32 * t, qf, bias2, qpos, lane, R, o);
        }
        *(LAS v4u*)(ring + PB_SLOT / 2 + 32 * VT_PITCH + ldst) = rbk; *(LAS v4u*)(ring + PB_SLOT / 2 + ldst) = rbv;
        rbk = PT_LDK(t - 3); rbv = PT_LDV(t - 3);
        team_barrier(tb, kb);
        if (t - 1 <= g) {
            LAS bf16* vt = ring + PB_SLOT / 2; bf16x8 kf[4]; kfrags_from_lds(vt + 32 * VT_PITCH, kf, lane);
            if (t - 1 == g) sb_compute<true>(kf, vt, 32 * (t - 1), qf, bias2, qpos, lane, R, o); else sb_compute<false>(kf, vt, 32 * (t - 1), qf, bias2, qpos, lane, R, o);
        }
    }
#undef PT_LDK
#undef PT_LDV
    bf16* oa = WSP(bf16, WS_OATT) + (size_t)(row0 + 32 * g) * 512 + 64 * head;
#pragma unroll
    for (int dt = 0; dt < 2; ++dt)
#pragma unroll
        for (int r = 0; r < 16; ++r) oa[(size_t)crow(r, kh) * 512 + 32 * dt + m] = f2bf(o[dt][r]);
    team_barrier(tb, kb);
}
constexpr int PB_SLOT_FWD = 0;
__device__ __forceinline__ void prompt_block_unit(Ctx& C, int l, int u) {
    KA_FRESH(C);
    const int lane = C.lane, m = lane & 31, kh = lane >> 5, wave = C.wave;
    const int qb = 7 - (u >> 5), sh = u & 31, seq = sh >> 3, head = sh & 7;
    const int g = 8 * qb + wave, T0 = 8 * qb + 7;
    const bf16* P = WSP(bf16, WS_PROJ);
    const float bias2 = C.in(28)[l * 8 + head] * LOG2E;
    const int row0 = seq * 2048;
    bf16x8 qf[4];
    { const bf16* qp = P + (size_t)(row0 + 32 * g + m) * PP + C_Q + 64 * head + 8 * kh;
#pragma unroll
      for (int ks = 0; ks < 4; ++ks) qf[ks] = *(const bf16x8*)(qp + 16 * ks); }
    const int part = C.tid >> 8, lrow = (C.tid & 255) >> 3, lch = C.tid & 7;
    const bf16* src = P + (size_t)row0 * PP + (part == 0 ? C_K : C_V) + 64 * head + 8 * lch;
    const int ldst = (part == 0 ? 32 * VT_PITCH : 0) + lrow * VT_PITCH + 8 * lch;
    LAS bf16* ring = (LAS bf16*)C.lds;
    const int qpos = 32 * g + m;
    f32x16 o[2];
#pragma unroll
    for (int r = 0; r < 16; ++r) { o[0][r] = 0.f; o[1][r] = 0.f; }
    float R = 1.f;
#define PB_LD(t) (*(const v4u*)(src + (size_t)(32 * ((t) > 0 ? (t) : 0) + lrow) * PP))
    v4u ra = PB_LD(T0), rb = PB_LD(T0 - 1);
#pragma unroll 1
    for (int t = T0; t >= 0; t -= 2) {
        *(LAS v4u*)(ring + ldst) = ra;
        ra = PB_LD(t - 2);
        __syncthreads();
        if (t <= g) {
            LAS bf16* vt = ring; bf16x8 kf[4]; kfrags_from_lds(vt + 32 * VT_PITCH, kf, lane);
            if (t == g) sb_compute<true>(kf, vt, 32 * t, qf, bias2, qpos, lane, R, o); else sb_compute<false>(kf, vt, 32 * t, qf, bias2, qpos, lane, R, o);
        }
        *(LAS v4u*)(ring + PB_SLOT / 2 + ldst) = rb;
        rb = PB_LD(t - 3);
        __syncthreads();
        if (t - 1 <= g) {
            LAS bf16* vt = ring + PB_SLOT / 2; bf16x8 kf[4]; kfrags_from_lds(vt + 32 * VT_PITCH, kf, lane);
            if (t - 1 == g) sb_compute<true>(kf, vt, 32 * (t - 1), qf, bias2, qpos, lane, R, o); else sb_compute<false>(kf, vt, 32 * (t - 1), qf, bias2, qpos, lane, R, o);
        }
    }
#undef PB_LD
    bf16* oa = WSP(bf16, WS_OATT) + (size_t)(row0 + 32 * g) * 512 + 64 * head;
#pragma unroll
    for (int dt = 0; dt < 2; ++dt)
#pragma unroll
        for (int r = 0; r < 16; ++r) oa[(size_t)crow(r, kh) * 512 + 32 * dt + m] = f2bf(o[dt][r]);
    __syncthreads();
}

__device__ __forceinline__ bf16x8 pack8(const f32x16& a, int s) {
    v4u w;
    if (s == 0) { w.x = cvtpk(a[0], a[1]); w.y = cvtpk(a[2], a[3]); w.z = cvtpk(a[4], a[5]); w.w = cvtpk(a[6], a[7]); }
    else { w.x = cvtpk(a[8], a[9]); w.y = cvtpk(a[10], a[11]); w.z = cvtpk(a[12], a[13]); w.w = cvtpk(a[14], a[15]); }
    return __builtin_bit_cast(bf16x8, w);
}
__device__ __forceinline__ void bf16x16_to_f32(f32x16& a, const v4u x, const v4u y) {
    a[0] = bflo(x.x); a[1] = bfhi(x.x); a[2] = bflo(x.y); a[3] = bfhi(x.y); a[4] = bflo(x.z); a[5] = bfhi(x.z); a[6] = bflo(x.w); a[7] = bfhi(x.w);
    a[8] = bflo(y.x); a[9] = bfhi(y.x); a[10] = bflo(y.y); a[11] = bfhi(y.y); a[12] = bflo(y.z); a[13] = bfhi(y.z); a[14] = bflo(y.w); a[15] = bfhi(y.w);
}
__device__ __forceinline__ void gdn_scan_unit(Ctx& C, int l, int su) {
    KA_FRESH(C);
    const int lane = C.lane, m = lane & 31, hi = lane >> 5;
    int seq, head, ds, nch, cid0;
    if (su < 128) { const int sh = su >> 2; ds = su & 3; seq = sh >> 3; head = sh & 7; nch = 32; cid0 = sh * 32; }
    else { const int v = su - 128; const int sh = v >> 2; ds = v & 3; seq = 4 + (sh >> 3); head = sh & 7; nch = 1; cid0 = 1024 + sh; }
    const int row0 = seq_row0(seq);
    f32x16 S[4];
    if (seq >= 4) {
        const float* s0 = C.in(10) + ((size_t)(l * 8 + (seq - 4)) * 8 + head) * 16384 + 32 * ds + m;
#pragma unroll
        for (int dt = 0; dt < 4; ++dt)
#pragma unroll
            for (int r = 0; r < 16; ++r) S[dt][r] = s0[(size_t)(32 * dt + crow(r, hi)) * 128];
    } else {
#pragma unroll
        for (int dt = 0; dt < 4; ++dt)
#pragma unroll
            for (int r = 0; r < 16; ++r) S[dt][r] = 0.f;
    }
    bf16* OG = WSP(bf16, WS_OGDN);
#pragma unroll 1
    for (int ch = 0; ch < nch; ++ch) {
        const int cid = cid0 + ch;
        const bf16x8* Wf = (const bf16x8*)(WSP(v4u, WS_WF) + (size_t)cid * 1024) + lane;
        const bf16x8* QEf = (const bf16x8*)(WSP(v4u, WS_QEF) + (size_t)cid * 1024) + lane;
        const bf16x8* KDf = (const bf16x8*)(WSP(v4u, WS_KDF) + (size_t)cid * 1024) + lane;
        const bf16x8* QKf = (const bf16x8*)(WSP(v4u, WS_QKF) + (size_t)cid * 512) + lane;
        const v4u* Uf = (const v4u*)(WSP(bf16, WS_UF) + (size_t)cid * 8192);
        const float egl = WSP(float, WS_GL)[cid];
        bf16x8 Sf[8];
#pragma unroll
        for (int dt = 0; dt < 4; ++dt) { Sf[2 * dt] = pack8(S[dt], 0); Sf[2 * dt + 1] = pack8(S[dt], 1); }
        f32x16 av[2], ao[2];
#pragma unroll
        for (int ti = 0; ti < 2; ++ti) {
            { const v4u* up = Uf + ((ds * 2 + ti) * 64 + lane) * 2; bf16x16_to_f32(av[ti], up[0], up[1]); }
#pragma unroll
            for (int ks = 0; ks < 8; ++ks) av[ti] = __builtin_amdgcn_mfma_f32_32x32x16_bf16(Wf[(ti * 8 + ks) * 64], Sf[ks], av[ti], 0, 0, 0);
#pragma unroll
            for (int r = 0; r < 16; ++r) ao[ti][r] = 0.f;
#pragma unroll
            for (int ks = 0; ks < 8; ++ks) ao[ti] = __builtin_amdgcn_mfma_f32_32x32x16_bf16(QEf[(ti * 8 + ks) * 64], Sf[ks], ao[ti], 0, 0, 0);
        }
        bf16x8 Vf[4];
        Vf[0] = pack8(av[0], 0); Vf[1] = pack8(av[0], 1); Vf[2] = pack8(av[1], 0); Vf[3] = pack8(av[1], 1);
#pragma unroll
        for (int ti = 0; ti < 2; ++ti)
#pragma unroll
            for (int k2 = 0; k2 < 4; ++k2) ao[ti] = __builtin_amdgcn_mfma_f32_32x32x16_bf16(QKf[(ti * 4 + k2) * 64], Vf[k2], ao[ti], 0, 0, 0);
#pragma unroll
        for (int dt = 0; dt < 4; ++dt) {
#pragma unroll
            for (int r = 0; r < 16; ++r) S[dt][r] *= egl;
#pragma unroll
            for (int k2 = 0; k2 < 4; ++k2) S[dt] = __builtin_amdgcn_mfma_f32_32x32x16_bf16(KDf[(dt * 4 + k2) * 64], Vf[k2], S[dt], 0, 0, 0);
        }
        if (seq < 4) {
#pragma unroll
            for (int ti = 0; ti < 2; ++ti)
#pragma unroll
                for (int r = 0; r < 16; ++r) OG[(size_t)(row0 + ch * 64 + 32 * ti + crow(r, hi)) * 1024 + head * 128 + 32 * ds + m] = f2bf(ao[ti][r]);
        } else {
#pragma unroll
            for (int r = 0; r < 4; ++r) OG[(size_t)(row0 + crow(r, hi)) * 1024 + head * 128 + 32 * ds + m] = f2bf(ao[0][r]);
        }
    }
    float* so = (seq < 4) ? OUTB + O_GP + ((size_t)(l * 4 + seq) * 8 + head) * 16384 : OUTB + O_GS + ((size_t)(l * 8 + (seq - 4)) * 8 + head) * 16384;
#pragma unroll
    for (int dt = 0; dt < 4; ++dt)
#pragma unroll
        for (int r = 0; r < 16; ++r) so[(size_t)(32 * dt + crow(r, hi)) * 128 + 32 * ds + m] = S[dt][r];
}

constexpr int SCAN_BUF = 73728;
static_assert(2 * SCAN_BUF <= LDS_MISC, "scan LDS");
__device__ __forceinline__ void scan_load(Ctx& C, int cid, int lt, v4u (&t)[18]) {
#pragma unroll
    for (int i = 0; i < 18; ++i) { const int idx = lt + 256 * i;
        const v4u* src = (i < 4) ? WSP(v4u, WS_WF) + (size_t)cid * 1024 + idx : (i < 8) ? WSP(v4u, WS_QEF) + (size_t)cid * 1024 + (idx - 1024) : (i < 12) ? WSP(v4u, WS_KDF) + (size_t)cid * 1024 + (idx - 2048)
                       : (i < 14) ? WSP(v4u, WS_QKF) + (size_t)cid * 512 + (idx - 3072) : WSP(v4u, WS_UF) + (size_t)cid * 1024 + (idx - 3584);
        t[i] = *src; }
}
__device__ __forceinline__ void scan_store(LAS unsigned char* dst, int lt, const v4u (&t)[18]) {
#pragma unroll
    for (int i = 0; i < 18; ++i) *(LAS v4u*)(dst + (size_t)(lt + 256 * i) * 16) = t[i];
}
__device__ __forceinline__ void gdn_scan_block(Ctx& C, int l, int sh) {
    KA_FRESH(C);
    const int lane = C.lane, m = lane & 31, hi = lane >> 5, wave = C.wave;
    const int seq = sh >> 3, head = sh & 7, ds = wave & 3, cid0 = sh * 32;
    const int row0 = seq * 2048;
    const int lt = C.tid & 255;
    if (wave >= 4) {
        v4u tst[18];
        scan_load(C, cid0, lt, tst); scan_store(C.lds, lt, tst); scan_load(C, cid0 + 1, lt, tst);
        __syncthreads();
#pragma unroll 1
        for (int ch = 0; ch < 32; ++ch) {
            if (ch + 1 < 32) { scan_store(C.lds + ((ch + 1) & 1) * SCAN_BUF, lt, tst); if (ch + 2 < 32) scan_load(C, cid0 + ch + 2, lt, tst); }
            __syncthreads();
        }
    } else {
        const unsigned olane = (unsigned)(4 * hi * 1024 + m);
        f32x16 S[4];
#pragma unroll
        for (int dt = 0; dt < 4; ++dt)
#pragma unroll
            for (int r = 0; r < 16; ++r) S[dt][r] = 0.f;
        bf16* OG = WSP(bf16, WS_OGDN);
        float egl_next = WSP(float, WS_GL)[cid0];
        __syncthreads();
#pragma unroll 1
        for (int ch = 0; ch < 32; ++ch) {
            const int cid = cid0 + ch;
            const LAS bf16x8* Wf = (const LAS bf16x8*)(C.lds + (ch & 1) * SCAN_BUF) + lane;
            const LAS bf16x8* QEf = Wf + 1024; const LAS bf16x8* KDf = Wf + 2048; const LAS bf16x8* QKf = Wf + 3072;
            const LAS v4u* Ub = (const LAS v4u*)(C.lds + (ch & 1) * SCAN_BUF + 57344) + (ds * 2) * 128 + lane * 2;
            const float egl = egl_next; egl_next = WSP(float, WS_GL)[cid0 + (ch + 1 < 32 ? ch + 1 : ch)];
            f32x16 av[2], ao[2];
            bf16x16_to_f32(av[0], Ub[0], Ub[1]); bf16x16_to_f32(av[1], Ub[128], Ub[129]);
#pragma unroll
            for (int r = 0; r < 16; ++r) { ao[0][r] = 0.f; ao[1][r] = 0.f; }
#pragma unroll
            for (int dt = 0; dt < 4; ++dt)
#pragma unroll
                for (int sx = 0; sx < 2; ++sx) { const int ks = 2 * dt + sx; const bf16x8 sf = pack8(S[dt], sx);
                    av[0] = __builtin_amdgcn_mfma_f32_32x32x16_bf16(Wf[(0 * 8 + ks) * 64], sf, av[0], 0, 0, 0);
                    av[1] = __builtin_amdgcn_mfma_f32_32x32x16_bf16(Wf[(1 * 8 + ks) * 64], sf, av[1], 0, 0, 0);
                    ao[0] = __builtin_amdgcn_mfma_f32_32x32x16_bf16(QEf[(0 * 8 + ks) * 64], sf, ao[0], 0, 0, 0);
                    ao[1] = __builtin_amdgcn_mfma_f32_32x32x16_bf16(QEf[(1 * 8 + ks) * 64], sf, ao[1], 0, 0, 0); }
            bf16x8 Vf[4];
            Vf[0] = pack8(av[0], 0); Vf[1] = pack8(av[0], 1); Vf[2] = pack8(av[1], 0); Vf[3] = pack8(av[1], 1);
#pragma unroll
            for (int ti = 0; ti < 2; ++ti)
#pragma unroll
                for (int k2 = 0; k2 < 4; ++k2) ao[ti] = __builtin_amdgcn_mfma_f32_32x32x16_bf16(QKf[(ti * 4 + k2) * 64], Vf[k2], ao[ti], 0, 0, 0);
#pragma unroll
            for (int dt = 0; dt < 4; ++dt) {
#pragma unroll
                for (int r = 0; r < 16; ++r) S[dt][r] *= egl;
#pragma unroll
                for (int k2 = 0; k2 < 4; ++k2) S[dt] = __builtin_amdgcn_mfma_f32_32x32x16_bf16(KDf[(dt * 4 + k2) * 64], Vf[k2], S[dt], 0, 0, 0);
            }
#pragma unroll
            for (int ti = 0; ti < 2; ++ti)
#pragma unroll
                for (int r = 0; r < 16; ++r) { bf16* p = OG + (size_t)(row0 + ch * 64 + 32 * ti + (r & 3) + 8 * (r >> 2)) * 1024 + head * 128 + 32 * ds; p[olane] = f2bf(ao[ti][r]); }
            __syncthreads();
        }
        float* so = OUTB + O_GP + ((size_t)(l * 4 + seq) * 8 + head) * 16384;
#pragma unroll
        for (int dt = 0; dt < 4; ++dt)
#pragma unroll
            for (int r = 0; r < 16; ++r) { float* p = so + (32 * dt + (r & 3) + 8 * (r >> 2)) * 128 + 32 * ds; p[(unsigned)(4 * hi * 128 + m)] = S[dt][r]; }
    }
}

__device__ __forceinline__ void lru_carry_task(Ctx& C, int l, int task) {
    KA_FRESH(C);
    const int s = task >> 3, d = (task & 7) * 64 + C.lane;
    const int nchunk = s < 4 ? 64 : 1, len = s < 4 ? 32 : 8, row0 = seq_row0(s);
    float H = s < 4 ? 0.f : C.in(8)[(size_t)(l * 8 + (s - 4)) * 512 + d];
    const float* HL = WSP(float, WS_LH); const float* AL = WSP(float, WS_LA); float* CR = WSP(float, WS_CARRY);
#pragma unroll 8
    for (int c = 0; c < nchunk; ++c) {
        CR[(size_t)(s * 64 + c) * 512 + d] = H;
        const size_t off = (size_t)(row0 + c * len + len - 1) * 512 + d;
        H = AL[off] * H + HL[off];
    }
    float* o = s < 4 ? OUTB + O_LHP + (size_t)(l * 4 + s) * 512 : OUTB + O_LHS + (size_t)(l * 8 + (s - 4)) * 512;
    o[d] = H;
}

__device__ __forceinline__ void phase_m4(Ctx& C, int l, int rep, unsigned& kbar) {
    if (C.bid >= 160 && C.G == 256) {
        pg8::Gemm g{WSP(bf16, WS_H), WSP(bf16, WS_WIN + l * WIN_L) + (size_t)6144 * DM, MP, 768, DM}; pg8::StaticOrder S; S.init(MP, 768, 96, C.bid - 160);
        EpiBf E{WSP(bf16, WS_PROJ) + 6144, PP};
        pg8::gemm_phase<EpiBf, pg8::StaticOrder, true, true>(C.lds, g, S, E);
    }
    for (int r7 = 0; r7 < REPN(7); ++r7) {
        if (C.bid < 32) gdn_scan_block(C, l, C.bid);
        else if (C.bid < 96) {
            if (C.wave < 4) gdn_scan_unit(C, l, 128 + (C.bid - 32) * 4 + C.wave);
            else if (C.wave < 6) { const int t = (C.bid - 32) * 2 + (C.wave - 4); if (t < 96) lru_carry_task(C, l, t); }
        }
    }
    {
    unsigned* qs = (unsigned*)(C.ws + WS_CTL) + CW_QUEUE + 64 * l;
    unsigned* qp = (unsigned*)(C.ws + WS_CTL) + CW_QUEUE + 64 * (16 + l);
    const int team = C.wave >> 2;
    volatile LAS unsigned* tb = (volatile LAS unsigned*)(C.lds + LDS_MISC) + 32 + 8 * team;
    LAS unsigned char* treg = C.lds + team * 73728;
    __syncthreads();
#pragma unroll 1
    for (int pass = 0; pass < 2; ++pass) {
        const bool prompt_first = (team == 0);
        const bool do_prompt = prompt_first == (pass == 0);
        if (do_prompt) {
            for (;;) {
                if ((C.tid & 255) == 0) tb[2] = __hip_atomic_fetch_add(qp, 1u, __ATOMIC_RELAXED, __HIP_MEMORY_SCOPE_AGENT);
                team_barrier(tb, kbar);
                const unsigned u = (unsigned)__builtin_amdgcn_readfirstlane((int)tb[2]);
                team_barrier(tb, kbar);
                if (u >= 512u) break;
                prompt_team_unit(C, l, (int)u, (LAS bf16*)treg, tb, kbar);
            }
        } else {
            for (;;) {
                if ((C.tid & 255) == 0) tb[2] = __hip_atomic_fetch_add(qs, 1u, __ATOMIC_RELAXED, __HIP_MEMORY_SCOPE_AGENT);
                team_barrier(tb, kbar);
                const unsigned u = (unsigned)__builtin_amdgcn_readfirstlane((int)tb[2]);
                team_barrier(tb, kbar);
                if (u >= (unsigned)(NATT_S / 4)) break;
                attn_unit(C, l, (int)(4u * u) + (C.wave & 3), (LAS bf16*)(treg + (C.wave & 3) * SG_BYTES), tb, kbar);
            }
        }
    }
    }
}

struct Args { const void* in[38]; float* out; unsigned char* ws; int ph_lo, ph_hi; };

__global__ void __launch_bounds__(NTHR, 2) hymba_fwd(Args args) {
    extern __shared__ __attribute__((aligned(16))) unsigned char lds_raw[];
    Ctx C;
    C.kp = (kptr_t)__builtin_amdgcn_kernarg_segment_ptr();
    C.out = (GAS float*)args.out; C.ws = (GAS unsigned char*)args.ws; C.lds = (LAS unsigned char*)lds_raw;
    C.tid = threadIdx.x; C.lane = C.tid & 63; C.wave = __builtin_amdgcn_readfirstlane(C.tid >> 6); C.G = gridDim.x; C.bid = blockIdx.x;
    volatile LAS unsigned* MISC = (volatile LAS unsigned*)(C.lds + LDS_MISC);
    if (C.tid < 64) MISC[C.tid] = 0u;
    __syncthreads();
    unsigned* ctl = (unsigned*)(C.ws + WS_CTL);
    XcdBarrier bar = xcd_barrier_post(ctl + CW_BAR, MISC + 8);
    const int lo = args.ph_lo, hi = args.ph_hi;
#define IN(k) (lo <= (k) && (k) < hi)
#define SEAM(k) do { if (IN(k) && IN((k) + 1)) { xcd_barrier(bar); if (REPN(6) > 1) { xcd_barrier(bar); xcd_barrier(bar); } } } while (0)

        if (IN(0)) { for (int rp = 0; rp < REPN(0); ++rp) { p0_weights(C); p0_ada(C); } } SEAM(0);
    if (IN(1)) { for (int rp = 0; rp < REPN(4); ++rp) p0b_modreduce(C); } SEAM(1);
    if (IN(2)) { for (int rp = 0; rp < REPN(4); ++rp) phase_n1(C); } SEAM(2);
    unsigned kbar = 0u;
#pragma unroll 1
    for (int l = 0; l < 2; ++l) {
        const int pb = 3 + 10 * l;
#define LF ({ int l_ = l; asm volatile("" : "+s"(l_)); l_; })
        if (IN(pb + 0)) {
            const int ll = LF; KA_FRESH(C); pg8::Gemm g{WSP(bf16, WS_H), WSP(bf16, WS_WIN + ll * WIN_L), MP, 6144, DM}; pg8::StaticOrder S; S.init(MP, 6144, C.G, C.bid); S.rep = REPN(1);
            EpiIn E{WSP(bf16, WS_PROJ), OUTB, ll};
            pg8::gemm_phase<EpiIn, pg8::StaticOrder, true, true>(C.lds, g, S, E);
            for (int su = C.bid; su < 216; su += C.G) sample_gemm_unit<0>(C, WSP(bf16, WS_H) + (size_t)MP * DM, WSP(bf16, WS_WIN + ll * WIN_L), DM, su * 32, ll);

        }
        SEAM(pb + 0);
        if (IN(pb + 1)) {
            { const int ll = LF; unsigned* q3 = ctl + CW_QUEUE + 64 * (8 + ll); volatile LAS unsigned* slot = (volatile LAS unsigned*)(C.lds + LDS_MISC) + 16;
              for (;;) {
                  if (C.tid == 0) *slot = __hip_atomic_fetch_add(q3, 1u, __ATOMIC_RELAXED, __HIP_MEMORY_SCOPE_AGENT);
                  __syncthreads();
                  const unsigned u = *slot;
                  __syncthreads();
                  const unsigned NC = (unsigned)conv_units(ll), T = 808u + NC;
                  if (u >= T) break;
                  const unsigned cb = u * NC / T, ca = (u + 1u) * NC / T;
                  if (ca > cb) conv_unit(C, ll, (int)cb);
                  else { const unsigned w = u - cb; if (w < 544u) gdn_prep_unit(C, ll, (int)w); else lru_unit(C, ll, (int)w - 544); }
              }
            }
        }
        SEAM(pb + 1);
        if (IN(pb + 2)) { for (int rp = 0; rp < REPN(3); ++rp) phase_m4(C, LF, rp, kbar); }
        SEAM(pb + 2);
        if (IN(pb + 3)) { for (int rp = 0; rp < REPN(4); ++rp) phase_finalize(C, LF); }
        SEAM(pb + 3);
        if (IN(pb + 4)) {
            const int ll = LF; KA_FRESH(C); pg8::Gemm g{WSP(bf16, WS_MIX), WSP(bf16, WS_WOUT + ll * WOUT_L), MP, DM, DM}; pg8::StaticOrder S; S.init(MP, DM, C.G, C.bid); S.rep = REPN(1);
            EpiBf E{WSP(bf16, WS_MIXO), DM};
            pg8::gemm_phase<EpiBf, pg8::StaticOrder, true, true>(C.lds, g, S, E);
            for (int su = C.bid; su < 64; su += C.G) sample_gemm_unit<1>(C, WSP(bf16, WS_MIX) + (size_t)MP * DM, WSP(bf16, WS_WOUT + ll * WOUT_L), DM, su * 32, ll);
        }
        SEAM(pb + 4);
        if (IN(pb + 5)) { for (int rp = REPN(5) - 1; rp >= 0; --rp) phase_resid(C, LF, 0, rp > 0); }
        SEAM(pb + 5);
        if (IN(pb + 6)) {
            const int ll = LF; KA_FRESH(C); pg8::Gemm g{WSP(bf16, WS_H), WSP(bf16, WS_WUP + ll * WUP_L), MP, DUP, DM}; pg8::StaticOrder S; S.init(MP, DUP, C.G, C.bid); S.rep = REPN(1);
            EpiAct E{WSP(bf16, WS_ACT), WSP(float, WS_TAILG), WSP(float, WS_HEADG), WSP(float, WS_HEADV), C.in(35) + (size_t)ll * 3 * DFF, C.in(36) + (size_t)ll * DFF};
            pg8::gemm_phase<EpiAct, pg8::StaticOrder, true, true>(C.lds, g, S, E);
            if (C.bid >= 128) for (int su = C.bid - 128; su < 352; su += 128) sample_gemm_unit<2>(C, WSP(bf16, WS_H) + (size_t)MP * DM, WSP(bf16, WS_WUP + ll * WUP_L), DM, su * 32, ll);

        }
        SEAM(pb + 6);
        if (IN(pb + 7)) { for (int rp = 0; rp < REPN(4); ++rp) phase_act(C, LF); }
        SEAM(pb + 7);
        if (IN(pb + 8)) {
            const int ll = LF; KA_FRESH(C); pg8::Gemm g{WSP(bf16, WS_ACT), WSP(bf16, WS_WDN + ll * WDN_L), MP, DM, DFF}; pg8::StaticOrder S; S.init(MP, DM, C.G, C.bid); S.rep = REPN(1);
            EpiBf E{WSP(bf16, WS_MIXO), DM};
            pg8::gemm_phase<EpiBf, pg8::StaticOrder, true, true>(C.lds, g, S, E);
            for (int su = C.bid; su < 64; su += C.G) sample_gemm_unit<1>(C, WSP(bf16, WS_ACT) + (size_t)MP * DFF, WSP(bf16, WS_WDN + ll * WDN_L), DFF, su * 32, ll);
        }
        SEAM(pb + 8);
        if (IN(pb + 9)) { for (int rp = REPN(5) - 1; rp >= 0; --rp) phase_resid(C, LF, 1, rp > 0); }
        if (l == 0) SEAM(pb + 9);
    }
#undef IN
#undef SEAM
}

#ifndef MK_PER_PHASE
#define MK_PER_PHASE 0
#endif
extern "C" void kernel_launch(void* const* d_in, const int* in_sizes, int n_in, void* d_out, int out_size, void* d_ws, size_t ws_size, hipStream_t stream) {
    static int grid = 0;
    if (grid == 0) {
        if (n_in != 38 || out_size != (int)O_END || ws_size < WS_END) { fprintf(stderr, "kernel_launch: unexpected shapes: n_in %d out %d ws %zu\n", n_in, out_size, ws_size); grid = -1; return; }
        int dev = 0, cus = 0, per_cu = 0;
        if (hipGetDevice(&dev) != hipSuccess || hipDeviceGetAttribute(&cus, hipDeviceAttributeMultiprocessorCount, dev) != hipSuccess) { grid = -1; return; }
        if (hipFuncSetAttribute((const void*)hymba_fwd, hipFuncAttributeMaxDynamicSharedMemorySize, LDS_BYTES) != hipSuccess) { fprintf(stderr, "kernel_launch: hipFuncSetAttribute failed\n"); grid = -1; return; }
        if (hipOccupancyMaxActiveBlocksPerMultiprocessor(&per_cu, (const void*)hymba_fwd, NTHR, LDS_BYTES) != hipSuccess || per_cu < 1) { fprintf(stderr, "kernel_launch: occupancy query says %d\n", per_cu); }
        (void)hipGetLastError();
        grid = cus;
    }
    if (grid < 0) return;
    (void)hipMemsetAsync((char*)d_ws + WS_CTL, 0, CTL_ZERO_BYTES, stream);
    Args a{};
    for (int i = 0; i < 38; ++i) a.in[i] = d_in[i];
    a.out = (float*)d_out; a.ws = (unsigned char*)d_ws;
#if MK_PER_PHASE
    for (int p = 0; p < NPHASE; ++p) { a.ph_lo = p; a.ph_hi = p + 1; hipLaunchKernelGGL(hymba_fwd, dim3(grid), dim3(NTHR), LDS_BYTES, stream, a); }
#else
    a.ph_lo = 0; a.ph_hi = NPHASE;
    hipLaunchKernelGGL(hymba_fwd, dim3(grid), dim3(NTHR), LDS_BYTES, stream, a);
#endif
    const hipError_t le = hipPeekAtLastError();
    if (le != hipSuccess) fprintf(stderr, "kernel_launch: launch failed: %s\n", hipGetErrorName(le));
}
```
